# Optimizing an MI355X kernel written in HIP

```python
import math, functools
import jax, jax.numpy as jnp
from jax import lax
import numpy as np

D_MODEL = 1024
BATCH = 32
SEQ = 2048
DEPTH = 2

GRID_W = 64
CTX_LEN = 256
HEAD_DIM = 64
D_MIX = D_MODEL
N_GROUPS = 4
GROUP_W = D_MIX // N_GROUPS
N_HEADS_G = GROUP_W // HEAD_DIM
CHUNK = 128
ROPE_PAIRS = HEAD_DIM // 4
ROPE_BASE = 10000.0
RWKV_W_LORA = 32
RWKV_A_LORA = 32
RWKV_G_LORA = 64
RWKV_SHIFT_W = 3 * GROUP_W + RWKV_W_LORA + RWKV_A_LORA + RWKV_G_LORA
RWKV_SPLIT = (GROUP_W, 2 * GROUP_W, 3 * GROUP_W, 3 * GROUP_W + RWKV_W_LORA, 3 * GROUP_W + RWKV_W_LORA + RWKV_A_LORA)
HYENA_EMB = 33
HYENA_BANDS = (HYENA_EMB - 1) // 2
HYENA_FFN = 64
HYENA_ORDER = 2
HYENA_FAST_DECAY = 0.3
HYENA_SLOW_DECAY = 1.5
HYENA_TARGET = 1e-2
D_FF = 2816
DEEPNORM_ALPHA = (2 * DEPTH) ** 0.25
DEEPNORM_BETA = (8 * DEPTH) ** -0.25
LN_EPS = 1e-5
GN_EPS = 1e-5
SPLIT_SIZES = (GROUP_W, GROUP_W, GROUP_W, GROUP_W, 4 * N_HEADS_G,
               GROUP_W, GROUP_W, GROUP_W,
               GROUP_W, GROUP_W, GROUP_W, GROUP_W,
               GROUP_W, GROUP_W, GROUP_W, RWKV_W_LORA, RWKV_A_LORA, RWKV_G_LORA)
D_PROJ = sum(SPLIT_SIZES)
F32 = jnp.float32

kernel_name = 'hybrid_mlstm_hyena_retnet_rwkv7_prefix_dit'


def layer_norm(x, g=None, b=None):
    xf = x.astype(F32)
    mu = jnp.mean(xf, -1, keepdims=True)
    var = jnp.mean(jnp.square(xf - mu), -1, keepdims=True)
    y = (xf - mu) * lax.rsqrt(var + LN_EPS)
    if g is not None:
        y = y * g + b
    return y.astype(x.dtype)


def modulate(u, shift, scale):
    return u * (1 + scale) + shift


def dwconv3(u, w, b):
    up = jnp.pad(u, ((0, 0), (1, 1), (0, 0)))
    return up[:, :-2] * w[0] + up[:, 1:-1] * w[1] + up[:, 2:] * w[2] + b


def token_shift(u, mu):
    up = jnp.pad(u, ((0, 0), (1, 1), (0, 0)))
    return u + mu[0] * (up[:, :-2] - u) + mu[1] * (up[:, 2:] - u)


def to_heads(u):
    B, L, W = u.shape
    return u.reshape(B, L, W // HEAD_DIM, HEAD_DIM).transpose(0, 2, 1, 3)


def from_heads(h):
    B, H, L, d = h.shape
    return h.transpose(0, 2, 1, 3).reshape(B, L, H * d)


def head_group_norm(y, g, b):
    B, L, W = y.shape
    yf = y.astype(F32).reshape(B, L, W // HEAD_DIM, HEAD_DIM)
    mu = jnp.mean(yf, -1, keepdims=True)
    var = jnp.mean(jnp.square(yf - mu), -1, keepdims=True)
    yf = ((yf - mu) * lax.rsqrt(var + GN_EPS)).reshape(B, L, W)
    return yf * g + b


def split_columns(proj):
    return jnp.split(proj, np.cumsum(SPLIT_SIZES)[:-1].tolist(), axis=-1)


def rope_2d(x, ang_row, ang_col):
    def rot(xh, a):
        c, s = jnp.cos(a), jnp.sin(a)
        x1, x2 = xh[..., :ROPE_PAIRS], xh[..., ROPE_PAIRS:]
        return jnp.concatenate([x1 * c - x2 * s, x2 * c + x1 * s], -1)
    half = HEAD_DIM // 2
    return jnp.concatenate([rot(x[..., :half], ang_row), rot(x[..., half:], ang_col)], -1)


def to_chunks(t):
    B, H, L = t.shape[:3]
    t = t.reshape((B, H, L // CHUNK, CHUNK) + t.shape[3:])
    return jnp.moveaxis(t, 2, 0)


def from_chunks(t):
    t = jnp.moveaxis(t, 0, 2)
    B, H, N, T = t.shape[:4]
    return t.reshape((B, H, N * T) + t.shape[4:])


def mlstm_chunk_scan(q, k, v, ig, lf, state):
    causal = jnp.tril(jnp.ones((CHUNK, CHUNK), dtype=bool))

    def step(carry, inp):
        c_mem, n_mem, m_mem = carry
        qc, kc, vc, igc, lfc = inp
        b = jnp.cumsum(lfc, axis=-1)
        dlog = jnp.where(causal, b[..., :, None] - b[..., None, :] + igc[..., None, :], -jnp.inf)
        inter = b + m_mem[..., None]
        m_t = jnp.maximum(inter, jnp.max(dlog, -1))
        s = jnp.einsum('bhid,bhjd->bhij', qc, kc) * jnp.exp(dlog - m_t[..., None])
        w_inter = jnp.exp(inter - m_t)
        num = jnp.einsum('bhij,bhjd->bhid', s, vc) + w_inter[..., None] * jnp.einsum('bhid,bhde->bhie', qc, c_mem)
        den = jnp.sum(s, -1) + w_inter * jnp.einsum('bhid,bhd->bhi', qc, n_mem)
        h = num / jnp.maximum(jnp.abs(den), jnp.exp(-m_t))[..., None]
        b_last = b[..., -1]
        g_log = b_last[..., None] - b + igc
        m_new = jnp.maximum(b_last + m_mem, jnp.max(g_log, -1))
        wk = jnp.exp(g_log - m_new[..., None])
        decay = jnp.exp(b_last + m_mem - m_new)
        c_new = decay[..., None, None] * c_mem + jnp.einsum('bhjd,bhje->bhde', kc * wk[..., None], vc)
        n_new = decay[..., None] * n_mem + jnp.einsum('bhjd,bhj->bhd', kc, wk)
        return (c_new, n_new, m_new), h

    final, h = lax.scan(step, state, tuple(to_chunks(t) for t in (q, k, v, ig, lf)))
    return from_chunks(h), final


def retention_chunk_scan(q, k, v, state, log_gamma):
    idx = jnp.arange(CHUNK, dtype=F32)
    diff = idx[:, None] - idx[None, :]
    causal = diff >= 0
    decay_mask = jnp.where(causal, jnp.exp(jnp.where(causal, diff, 0.0) * log_gamma[:, None, None]), 0.0)
    q_dec = jnp.exp((idx + 1.0) * log_gamma[:, None])
    k_dec = jnp.exp((CHUNK - 1.0 - idx) * log_gamma[:, None])
    chunk_dec = jnp.exp(CHUNK * log_gamma)

    def step(s_mem, inp):
        qc, kc, vc = inp
        s = jnp.einsum('bhid,bhjd->bhij', qc, kc) * decay_mask
        o = jnp.einsum('bhij,bhjd->bhid', s, vc) + jnp.einsum('bhid,bhde->bhie', qc * q_dec[..., None], s_mem)
        s_new = s_mem * chunk_dec[:, None, None] + jnp.einsum('bhjd,bhje->bhde', kc * k_dec[..., None], vc)
        return s_new, o

    final, o = lax.scan(step, state, tuple(to_chunks(t) for t in (q, k, v)))
    return from_chunks(o), final


def rwkv_scan(r, w, k, v, a, b, state):
    def step(s_mem, inp):
        rt, wt, kt, vt, at, bt = inp
        sa = jnp.einsum('bhvk,bhk->bhv', s_mem, at)
        s_new = s_mem * wt[:, :, None, :] + sa[..., None] * bt[:, :, None, :] + vt[..., None] * kt[:, :, None, :]
        return s_new, jnp.einsum('bhvk,bhk->bhv', s_new, rt)

    xs = tuple(jnp.moveaxis(t, 2, 0) for t in (r, w, k, v, a, b))
    final, y = lax.scan(step, state, xs)
    return jnp.moveaxis(y, 0, 2), final


def bidirectional_scan(scan_fw, scan_bw, ctx_fw, ctx_bw, lat_fw, lat_bw, init):
    flip = lambda ts: tuple(jnp.flip(t, axis=2) for t in ts)
    hc_f, st_f = scan_fw(*ctx_fw, init)
    hc_b, st_b = scan_bw(*flip(ctx_bw), init)
    h_f, _ = scan_fw(*lat_fw, st_f)
    h_b, _ = scan_bw(*flip(lat_bw), st_b)
    return h_f + jnp.flip(h_b, axis=2), hc_f + jnp.flip(hc_b, axis=2)


def mlstm_mixer(parts, parts_c, conv_w, conv_b, gate_b, ng, nb):
    def prep(q, k, v, o, gates):
        B, L, _ = q.shape
        qk = jax.nn.silu(dwconv3(jnp.concatenate([q, k], -1), conv_w, conv_b)).astype(F32)
        qh = to_heads(qk[..., :GROUP_W]) * HEAD_DIM ** -0.5
        kh = to_heads(qk[..., GROUP_W:])
        vh = to_heads(v.astype(F32))
        g = (gates.reshape(B, L, 4, N_HEADS_G) + gate_b).astype(F32).transpose(2, 0, 3, 1)
        fw = (qh, kh, vh, g[0], jax.nn.log_sigmoid(g[1]))
        bw = (qh, kh, vh, g[2], jax.nn.log_sigmoid(g[3]))
        return fw, bw

    lat_fw, lat_bw = prep(*parts)
    ctx_fw, ctx_bw = prep(*parts_c)
    B = parts[0].shape[0]
    init = (jnp.zeros((B, N_HEADS_G, HEAD_DIM, HEAD_DIM), F32),
            jnp.zeros((B, N_HEADS_G, HEAD_DIM), F32),
            jnp.zeros((B, N_HEADS_G), F32))
    h, h_c = bidirectional_scan(mlstm_chunk_scan, mlstm_chunk_scan, ctx_fw, ctx_bw, lat_fw, lat_bw, init)
    out = lambda o, hh: jax.nn.sigmoid(o.astype(F32)) * head_group_norm(from_heads(hh), ng, nb)
    return out(parts[3], h), out(parts_c[3], h_c)


def hyena_kernels(L, w1, b1, w2, b2, w3, freq):
    w1, b1, w2, b2, w3, freq = (t.astype(F32) for t in (w1, b1, w2, b2, w3, freq))
    pos = jnp.arange(L, dtype=F32)
    t = jnp.linspace(0.0, 1.0, L, dtype=F32)[:, None]
    ang = 2.0 * math.pi * pos[:, None] / L
    bands = jnp.linspace(1e-4, HYENA_BANDS - 1, HYENA_BANDS, dtype=F32)[None, :]
    feats = jnp.concatenate([t, jnp.cos(bands * ang), -jnp.sin(bands * ang)], -1)
    h = jnp.sin(freq * (feats @ w1 + b1))
    h = jnp.sin(freq * (h @ w2 + b2))
    h = h @ w3
    max_decay = math.log(HYENA_TARGET) / HYENA_FAST_DECAY
    min_decay = math.log(HYENA_TARGET) / HYENA_SLOW_DECAY
    deltas = jnp.abs(jnp.linspace(min_decay, max_decay, GROUP_W, dtype=F32))
    window = jnp.exp(-t * deltas)
    h = h.reshape(L, 2, HYENA_ORDER, GROUP_W) * window[:, None, None, :]
    hf, hb = h[:, 0], h[:, 1]
    return jnp.concatenate([hf[:1] + hb[:1], hf[1:], jnp.zeros_like(hf[:1]), hb[:0:-1]], 0)


def fftconv(u, k_full):
    L = u.shape[1]
    uf = jnp.fft.rfft(u, n=2 * L, axis=1)
    kf = jnp.fft.rfft(k_full, n=2 * L, axis=0)
    return jnp.fft.irfft(uf * kf[None], n=2 * L, axis=1)[:, :L]


def hyena_mixer(parts, parts_c, conv_w, conv_b, w1, b1, w2, b2, w3, freq, d_bias, ng, nb):
    def run(v, x1, x2):
        L = v.shape[1]
        k_full = hyena_kernels(L, w1, b1, w2, b2, w3, freq)
        z = dwconv3(jnp.concatenate([v, x1, x2], -1), conv_w, conv_b).astype(F32)
        v, x1, x2 = jnp.split(z, [GROUP_W, 2 * GROUP_W], axis=-1)
        z2 = x1 * (fftconv(v, k_full[:, 0]) + v * d_bias[0])
        y = x2 * (fftconv(z2, k_full[:, 1]) + z2 * d_bias[1])
        return head_group_norm(y, ng, nb)

    y = run(*parts)
    y_c = run(*parts_c) if parts_c is not None else None
    return y, y_c


def retention_mixer(parts, parts_c, ang, ng, nb):
    lg_f = jnp.log(1.0 - 2.0 ** (-5.0 - jnp.arange(N_HEADS_G, dtype=F32)))
    lg_b = lg_f[::-1]

    def prep(q, k, v, rotate):
        qh = to_heads(q.astype(F32)) * HEAD_DIM ** -0.5
        kh = to_heads(k.astype(F32))
        if rotate:
            qh, kh = rope_2d(qh, *ang), rope_2d(kh, *ang)
        return (qh, kh, to_heads(v.astype(F32)))

    lat = prep(*parts[:3], True)
    ctx = prep(*parts_c[:3], False)
    B = parts[0].shape[0]
    init = jnp.zeros((B, N_HEADS_G, HEAD_DIM, HEAD_DIM), F32)
    h, h_c = bidirectional_scan(functools.partial(retention_chunk_scan, log_gamma=lg_f),
                                functools.partial(retention_chunk_scan, log_gamma=lg_b),
                                ctx, ctx, lat, lat, init)
    out = lambda g, hh: jax.nn.silu(g.astype(F32)) * head_group_norm(from_heads(hh), ng, nb)
    return out(parts[3], h), out(parts_c[3], h_c)


def rwkv_mixer(parts, parts_c, mu, w0, w2, a0, a2, g2, kk_scale, ka, rk, ng, nb):
    def prep(seq_parts):
        z = token_shift(jnp.concatenate(seq_parts, -1).astype(F32), mu)
        r, k, v, wlo, alo, glo = jnp.split(z, list(RWKV_SPLIT), axis=-1)
        g = jax.nn.sigmoid(glo) @ g2
        rh, kh, vh = to_heads(r), to_heads(k), to_heads(v)
        kk = to_heads(k * kk_scale)
        kk = kk * lax.rsqrt(jnp.sum(kk * kk, -1, keepdims=True) + 1e-12)
        dirs = []
        for d in range(2):
            w_pre = w0[d] + jnp.tanh(wlo) @ w2[d]
            decay = jnp.exp(-jnp.exp(-jax.nn.softplus(-w_pre) - 0.5))
            a = jax.nn.sigmoid(a0[d] + alo @ a2[d])
            k_d = k * (1 + (a - 1) * ka)
            dirs.append((rh, to_heads(decay), to_heads(k_d), vh, -kk, kk * to_heads(a)))
        bonus = jnp.sum(rh * kh * rk[None, :, None, :], -1, keepdims=True) * vh
        return dirs[0], dirs[1], bonus, g

    lat_fw, lat_bw, bonus, g = prep(parts)
    ctx_fw, ctx_bw, bonus_c, g_c = prep(parts_c)
    B = parts[0].shape[0]
    init = jnp.zeros((B, N_HEADS_G, HEAD_DIM, HEAD_DIM), F32)
    h, h_c = bidirectional_scan(rwkv_scan, rwkv_scan, ctx_fw, ctx_bw, lat_fw, lat_bw, init)
    out = lambda hh, bon, gg: gg * (head_group_norm(from_heads(hh), ng, nb) + from_heads(bon))
    return out(h, bonus, g), out(h_c, bonus_c, g_c)


def token_mixer(u, uc, p, ang, need_ctx):
    parts = split_columns(u @ p['w_in'])
    parts_c = split_columns(uc @ p['w_in'])
    ng, nb = p['out_norm_g'], p['out_norm_b']
    gs = lambda i, t: t[i * GROUP_W:(i + 1) * GROUP_W]
    ya, ya_c = mlstm_mixer(parts[0:5], parts_c[0:5], p['mlstm_conv_w'], p['mlstm_conv_b'], p['mlstm_gate_b'],
                           gs(0, ng), gs(0, nb))
    yb, yb_c = hyena_mixer(parts[5:8], parts_c[5:8] if need_ctx else None, p['hyena_conv_w'], p['hyena_conv_b'],
                           p['hyena_w1'], p['hyena_b1'], p['hyena_w2'], p['hyena_b2'], p['hyena_w3'],
                           p['hyena_freq'], p['hyena_d'], gs(1, ng), gs(1, nb))
    yr, yr_c = retention_mixer(parts[8:12], parts_c[8:12], ang, gs(2, ng), gs(2, nb))
    yw, yw_c = rwkv_mixer(parts[12:18], parts_c[12:18], p['rwkv_mu'], p['rwkv_w0'], p['rwkv_w2'], p['rwkv_a0'],
                          p['rwkv_a2'], p['rwkv_g2'], p['rwkv_kk'], p['rwkv_ka'], p['rwkv_rk'], gs(3, ng), gs(3, nb))
    y = jnp.concatenate([ya, yb, yr, yw], -1).astype(u.dtype) @ p['w_out']
    if not need_ctx:
        return y, None
    y_c = jnp.concatenate([ya_c, yb_c, yr_c, yw_c], -1).astype(uc.dtype) @ p['w_out']
    return y, y_c


def conv_ffn(u, w_up, conv_w, conv_b, w_down):
    h = u @ w_up
    a, b = jnp.split(h, [D_FF], axis=-1)
    return (jax.nn.silu(dwconv3(a, conv_w, conv_b)) * b) @ w_down


def setup_inputs(seed: int = 0) -> dict:
    key = jax.random.key(seed)
    ks = iter(jax.random.split(key, 48))

    def nrm(shape, std):
        return std * jax.random.normal(next(ks), shape, F32)

    def conv_init(width):
        return nrm((DEPTH, 3, width), 0.3) + jnp.array([0.0, 1.0, 0.0], F32)[None, :, None]

    head_lin = jnp.linspace(3.0, 6.0, N_HEADS_G, dtype=F32)
    f_mask = jnp.array([0.0, 1.0, 0.0, 1.0], F32)[:, None]
    ratio = jnp.arange(GROUP_W, dtype=F32) / (GROUP_W - 1)
    decay_speed = -7.0 + 5.0 * ratio ** 1.35
    return {
        'x': nrm((BATCH, SEQ, D_MODEL), 1.0),
        'c': nrm((BATCH, D_MODEL), 1.0),
        'ctx': nrm((BATCH, CTX_LEN, D_MODEL), 1.0),
        'c_ctx': nrm((D_MODEL,), 1.0),
        'ada_w': nrm((DEPTH, D_MODEL, 6 * D_MODEL), 0.5 * D_MODEL ** -0.5),
        'ada_b': nrm((DEPTH, 6 * D_MODEL), 0.01),
        'w_in': nrm((DEPTH, D_MODEL, D_PROJ), D_MODEL ** -0.5),
        'mlstm_conv_w': conv_init(2 * GROUP_W),
        'mlstm_conv_b': nrm((DEPTH, 2 * GROUP_W), 0.01),
        'mlstm_gate_b': nrm((DEPTH, 4, N_HEADS_G), 0.1) + f_mask * head_lin[None, :],
        'hyena_conv_w': conv_init(3 * GROUP_W),
        'hyena_conv_b': nrm((DEPTH, 3 * GROUP_W), 0.01),
        'hyena_w1': nrm((DEPTH, HYENA_EMB, HYENA_FFN), HYENA_EMB ** -0.5),
        'hyena_b1': nrm((DEPTH, HYENA_FFN), 0.01),
        'hyena_w2': nrm((DEPTH, HYENA_FFN, HYENA_FFN), HYENA_FFN ** -0.5),
        'hyena_b2': nrm((DEPTH, HYENA_FFN), 0.01),
        'hyena_w3': nrm((DEPTH, HYENA_FFN, 2 * HYENA_ORDER * GROUP_W), HYENA_FFN ** -0.5),
        'hyena_freq': 1.0 + nrm((DEPTH, HYENA_FFN), 0.01),
        'hyena_d': nrm((DEPTH, HYENA_ORDER, GROUP_W), 0.5),
        'rwkv_mu': jax.random.uniform(next(ks), (DEPTH, 2, RWKV_SHIFT_W), F32, 0.0, 0.5),
        'rwkv_w0': decay_speed + 0.5 + nrm((DEPTH, 2, GROUP_W), 0.1),
        'rwkv_w2': nrm((DEPTH, 2, RWKV_W_LORA, GROUP_W), 0.1 * RWKV_W_LORA ** -0.5),
        'rwkv_a0': nrm((DEPTH, 2, GROUP_W), 0.1),
        'rwkv_a2': nrm((DEPTH, 2, RWKV_A_LORA, GROUP_W), 0.1 * RWKV_A_LORA ** -0.5),
        'rwkv_g2': nrm((DEPTH, RWKV_G_LORA, GROUP_W), RWKV_G_LORA ** -0.5),
        'rwkv_kk': 0.85 + nrm((DEPTH, GROUP_W), 0.02),
        'rwkv_ka': 1.0 + nrm((DEPTH, GROUP_W), 0.02),
        'rwkv_rk': nrm((DEPTH, N_HEADS_G, HEAD_DIM), 0.1),
        'out_norm_g': 1.0 + nrm((DEPTH, D_MIX), 0.02),
        'out_norm_b': nrm((DEPTH, D_MIX), 0.01),
        'w_out': nrm((DEPTH, D_MIX, D_MODEL), DEEPNORM_BETA * D_MIX ** -0.5),
        'ln1_g': 1.0 + nrm((DEPTH, D_MODEL), 0.02),
        'ln1_b': nrm((DEPTH, D_MODEL), 0.01),
        'ffn_w_up': nrm((DEPTH, D_MODEL, 2 * D_FF), D_MODEL ** -0.5),
        'ffn_conv_w': conv_init(D_FF),
        'ffn_conv_b': nrm((DEPTH, D_FF), 0.01),
        'ffn_w_down': nrm((DEPTH, D_FF, D_MODEL), DEEPNORM_BETA * D_FF ** -0.5),
        'ln2_g': 1.0 + nrm((DEPTH, D_MODEL), 0.02),
        'ln2_b': nrm((DEPTH, D_MODEL), 0.01),
    }


def reference(x, c, ctx, c_ctx, ada_w, ada_b, w_in, mlstm_conv_w, mlstm_conv_b, mlstm_gate_b,
              hyena_conv_w, hyena_conv_b, hyena_w1, hyena_b1, hyena_w2, hyena_b2, hyena_w3, hyena_freq, hyena_d,
              rwkv_mu, rwkv_w0, rwkv_w2, rwkv_a0, rwkv_a2, rwkv_g2, rwkv_kk, rwkv_ka, rwkv_rk,
              out_norm_g, out_norm_b, w_out, ln1_g, ln1_b, ffn_w_up, ffn_conv_w, ffn_conv_b, ffn_w_down,
              ln2_g, ln2_b):
    L = x.shape[1]
    ROWS = L // GRID_W
    freqs = ROPE_BASE ** (-jnp.arange(ROPE_PAIRS, dtype=F32) / ROPE_PAIRS)
    row = jnp.repeat(jnp.arange(ROWS, dtype=F32), GRID_W)
    col = jnp.tile(jnp.arange(GRID_W, dtype=F32), ROWS)
    ang = (row[:, None] * freqs, col[:, None] * freqs)
    xc = ctx
    silu_c = jax.nn.silu(c)
    silu_cc = jax.nn.silu(c_ctx)
    for l in range(DEPTH):
        last = l == DEPTH - 1
        mod = jnp.split((silu_c @ ada_w[l] + ada_b[l])[:, None, :], 6, axis=-1)
        modc = jnp.split(silu_cc @ ada_w[l] + ada_b[l], 6, axis=-1)
        p = {'w_in': w_in[l], 'mlstm_conv_w': mlstm_conv_w[l], 'mlstm_conv_b': mlstm_conv_b[l],
             'mlstm_gate_b': mlstm_gate_b[l], 'hyena_conv_w': hyena_conv_w[l], 'hyena_conv_b': hyena_conv_b[l],
             'hyena_w1': hyena_w1[l], 'hyena_b1': hyena_b1[l], 'hyena_w2': hyena_w2[l], 'hyena_b2': hyena_b2[l],
             'hyena_w3': hyena_w3[l], 'hyena_freq': hyena_freq[l], 'hyena_d': hyena_d[l],
             'rwkv_mu': rwkv_mu[l], 'rwkv_w0': rwkv_w0[l], 'rwkv_w2': rwkv_w2[l], 'rwkv_a0': rwkv_a0[l],
             'rwkv_a2': rwkv_a2[l], 'rwkv_g2': rwkv_g2[l], 'rwkv_kk': rwkv_kk[l], 'rwkv_ka': rwkv_ka[l],
             'rwkv_rk': rwkv_rk[l], 'out_norm_g': out_norm_g[l], 'out_norm_b': out_norm_b[l], 'w_out': w_out[l]}
        u = modulate(layer_norm(x), mod[0], mod[1])
        uc = modulate(layer_norm(xc), modc[0], modc[1])
        y, y_c = token_mixer(u, uc, p, ang, not last)
        x = layer_norm(DEEPNORM_ALPHA * x + mod[2] * y, ln1_g[l], ln1_b[l])
        u = modulate(layer_norm(x), mod[3], mod[4])
        f = conv_ffn(u, ffn_w_up[l], ffn_conv_w[l], ffn_conv_b[l], ffn_w_down[l])
        x = layer_norm(DEEPNORM_ALPHA * x + mod[5] * f, ln2_g[l], ln2_b[l])
        if not last:
            xc = layer_norm(DEEPNORM_ALPHA * xc + modc[2] * y_c, ln1_g[l], ln1_b[l])
            uc = modulate(layer_norm(xc), modc[3], modc[4])
            fc = conv_ffn(uc, ffn_w_up[l], ffn_conv_w[l], ffn_conv_b[l], ffn_w_down[l])
            xc = layer_norm(DEEPNORM_ALPHA * xc + modc[5] * fc, ln2_g[l], ln2_b[l])
    return x
```

```cpp
#ifndef CPU_EMU
#include <hip/hip_runtime.h>
#include <hip/hip_cooperative_groups.h>
#include <cstdio>
namespace cg = cooperative_groups;
#endif
#include <stdint.h>

#ifndef CFG_SMALL
#define DM 1024
#define NB 32
#define SEQ 2048
#define CTX 256
#define DFF 2816
#define SB 8
#else
#define DM 512
#define NB 2
#define SEQ 256
#define CTX 128
#define DFF 192
#define SB 1
#endif
#define DEPTH 2
#define GRIDW 64
#define HD 64
#define GW (DM / 4)
#define NH (GW / HD)
#define DPROJ (14 * GW + 4 * NH + 128)
#define LDP ((DPROJ + 127) / 128 * 128)
#define OFF_ML 0
#define OFF_HY (4 * GW + 4 * NH)
#define OFF_RT (OFF_HY + 3 * GW)
#define OFF_RW (OFF_RT + 4 * GW)
#define RWSH (3 * GW + 128)
#define RPB (CTX + SEQ)
#define RS (SB * RPB)
#define NSLICE (NB / SB)
#define ALPHA 1.41421356237309515f
#define NMOD 33
#ifdef CPU_EMU
#define WL 1
#else
#define WL 64
#endif

typedef unsigned short bf16_t;

struct P {
  const float *x, *c, *ctx, *c_ctx, *ada_w, *ada_b, *w_in, *ml_cw, *ml_cb, *ml_gb, *hy_cw, *hy_cb, *hy_w1, *hy_b1, *hy_w2, *hy_b2, *hy_w3,
      *hy_freq, *hy_d, *rw_mu, *rw_w0, *rw_w2, *rw_a0, *rw_a2, *rw_g2, *rw_kk, *rw_ka, *rw_rk, *ng, *nb, *w_out, *ln1g, *ln1b, *w_up, *f_cw,
      *f_cb, *w_dn, *ln2g, *ln2b;
  float* out;
  bf16_t *wt_in, *wt_out, *wt_up, *wt_dn;
  float *kf_lat, *kf_ctx, *hyh1, *hyh2, *scv, *modtab, *xc;
  bf16_t *U, *PROJ;
  float *MQK, *MG, *RQK, *RW, *HF, *HB, *Z2, *HY;
  float* OUTF;
  bf16_t *HFF, *ACT;
};

__device__ __forceinline__ bf16_t f2bf(float f) {
  unsigned u = __float_as_uint(f);
  u += 0x7fffu + ((u >> 16) & 1u);
  return (bf16_t)(u >> 16);
}
__device__ __forceinline__ unsigned pack_bf16(float lo, float hi) {
#ifndef CPU_EMU
  unsigned r;
  asm volatile("v_cvt_pk_bf16_f32 %0, %1, %2" : "=v"(r) : "v"(lo), "v"(hi));
  return r;
#else
  return f2bf(lo) | ((unsigned)f2bf(hi) << 16);
#endif
}
__device__ __forceinline__ float bf2f(bf16_t h) { return __uint_as_float(((unsigned)h) << 16); }
__device__ __forceinline__ float sigmoidf_(float x) { return 1.0f / (1.0f + expf(-x)); }
__device__ __forceinline__ float siluf_(float x) { return x / (1.0f + expf(-x)); }
__device__ __forceinline__ float softplusf_(float x) { return fmaxf(x, 0.0f) + log1pf(expf(-fabsf(x))); }
__device__ __forceinline__ float logsigmoidf_(float x) { return -softplusf_(-x); }

__device__ __forceinline__ float wave_sum(float v) {
#ifndef CPU_EMU
#pragma unroll
  for (int o = 32; o > 0; o >>= 1) v += __shfl_xor(v, o, 64);
#endif
  return v;
}

__device__ __forceinline__ const float* xsrc_row(const P& p, int l, int b, int pp) {
  if (pp < CTX) return (l == 0 ? p.ctx : p.xc) + ((size_t)b * CTX + pp) * DM;
  return (l == 0 ? p.x : p.out) + ((size_t)b * SEQ + (pp - CTX)) * DM;
}
__device__ __forceinline__ float* xdst_row(const P& p, int b, int pp) {
  if (pp < CTX) return p.xc + ((size_t)b * CTX + pp) * DM;
  return p.out + ((size_t)b * SEQ + (pp - CTX)) * DM;
}
__device__ __forceinline__ bool has_prev(int pp) { return pp != 0 && pp != CTX; }
__device__ __forceinline__ bool has_next(int pp) { return pp != CTX - 1 && pp != RPB - 1; }

__device__ void cvt_weight(const float* W, bf16_t* Wt, int K, int N, int Npad, int gtid, int gsize) {
  const int nk8 = K / 8;
  for (long it = gtid; it < (long)nk8 * Npad; it += gsize) {
    int n = (int)(it % Npad), k8 = (int)(it / Npad);
    bf16_t v[8];
#pragma unroll
    for (int j = 0; j < 8; ++j) v[j] = (n < N) ? f2bf(W[(size_t)(k8 * 8 + j) * N + n]) : (bf16_t)0;
    uint4 o;
    o.x = v[0] | ((unsigned)v[1] << 16); o.y = v[2] | ((unsigned)v[3] << 16);
    o.z = v[4] | ((unsigned)v[5] << 16); o.w = v[6] | ((unsigned)v[7] << 16);
    *(uint4*)(Wt + (size_t)n * K + k8 * 8) = o;
  }
}
__device__ void hy_feat_h1(const P& p, int gtid, int gsize) {
  const int per_l = (SEQ + CTX) * 64;
  for (int it = gtid; it < DEPTH * per_l; it += gsize) {
    int l = it / per_l, r = it % per_l;
    int i, L, seg;
    int j = r % 64; r /= 64;
    if (r < SEQ) { seg = 0; i = r; L = SEQ; } else { seg = 1; i = r - SEQ; L = CTX; }
    const float* w1 = p.hy_w1 + (size_t)l * 33 * 64;
    float t = (float)i / (float)(L - 1);
    float ang = 6.283185307179586f * (float)i / (float)L;
    float acc = t * w1[j];
    for (int b = 0; b < 16; ++b) {
      float band = 1e-4f + (float)b * ((15.0f - 1e-4f) / 15.0f);
      float a = band * ang;
      acc += cosf(a) * w1[(1 + b) * 64 + j];
      acc -= sinf(a) * w1[(17 + b) * 64 + j];
    }
    float h = sinf(p.hy_freq[l * 64 + j] * (acc + p.hy_b1[l * 64 + j]));
    p.hyh1[((size_t)(l * 2 + seg) * SEQ + i) * 64 + j] = h;
  }
}
__device__ void ph_pro_a(const P& p, int gtid, int gsize) {
  for (int l = 0; l < DEPTH; ++l) {
    cvt_weight(p.w_in + (size_t)l * DM * DPROJ, p.wt_in + (size_t)l * LDP * DM, DM, DPROJ, LDP, gtid, gsize);
    cvt_weight(p.w_out + (size_t)l * DM * DM, p.wt_out + (size_t)l * DM * DM, DM, DM, DM, gtid, gsize);
    cvt_weight(p.w_up + (size_t)l * DM * 2 * DFF, p.wt_up + (size_t)l * 2 * DFF * DM, DM, 2 * DFF, 2 * DFF, gtid, gsize);
    cvt_weight(p.w_dn + (size_t)l * DFF * DM, p.wt_dn + (size_t)l * DM * DFF, DFF, DM, DM, gtid, gsize);
  }
  for (int it = gtid; it < NMOD * DM; it += gsize) {
    int r = it / DM, k = it % DM;
    float v = (r < NB) ? p.c[(size_t)r * DM + k] : p.c_ctx[k];
    p.scv[it] = siluf_(v);
  }
  hy_feat_h1(p, gtid, gsize);
}
__device__ void ph_pro_b(const P& p, int gtid, int gsize) {
  for (int it = gtid; it < DEPTH * NMOD * 6 * DM; it += gsize) {
    int j = it % (6 * DM), r = (it / (6 * DM)) % NMOD, l = it / (6 * DM * NMOD);
    const float* w = p.ada_w + (size_t)l * DM * 6 * DM + j;
    const float* sv = p.scv + r * DM;
    float acc = 0.f;
    for (int k = 0; k < DM; ++k) acc += sv[k] * w[(size_t)k * 6 * DM];
    p.modtab[it] = acc + p.ada_b[l * 6 * DM + j];
  }
  const int per_l = (SEQ + CTX) * 64;
  for (int it = gtid; it < DEPTH * per_l; it += gsize) {
    int l = it / per_l, r = it % per_l;
    int j = r % 64; r /= 64;
    int seg = r < SEQ ? 0 : 1, i = r < SEQ ? r : r - SEQ;
    const float* h1 = p.hyh1 + ((size_t)(l * 2 + seg) * SEQ + i) * 64;
    const float* w2 = p.hy_w2 + (size_t)l * 64 * 64;
    float acc = 0.f;
    for (int k = 0; k < 64; ++k) acc += h1[k] * w2[k * 64 + j];
    p.hyh2[((size_t)(l * 2 + seg) * SEQ + i) * 64 + j] = sinf(p.hy_freq[l * 64 + j] * (acc + p.hy_b2[l * 64 + j]));
  }
}
__device__ void ph_pro_c(const P& p, int gtid, int gsize) {
  const int per_l = 2 * (2 * SEQ + 2 * CTX) * GW;
  const float max_decay = -4.605170185988091f / 0.3f, min_decay = -4.605170185988091f / 1.5f;
  for (int it = gtid; it < DEPTH * per_l; it += gsize) {
    int l = it / per_l, r = it % per_l;
    int c = r % GW; r /= GW;
    int ord = r & 1; r >>= 1;
    int seg, idx, L;
    if (r < 2 * SEQ) { seg = 0; idx = r; L = SEQ; } else { seg = 1; idx = r - 2 * SEQ; L = CTX; }
    int d = idx - L;
    float val = 0.f;
    if (idx != 0) {
      int i = d < 0 ? -d : d;
      float ti = (float)i / (float)(L - 1);
      float delta = fabsf(min_decay + (float)c * ((max_decay - min_decay) / (float)(GW - 1)));
      float win = expf(-ti * delta);
      const float* h2 = p.hyh2 + ((size_t)(l * 2 + seg) * SEQ + i) * 64;
      const float* w3 = p.hy_w3 + (size_t)l * 64 * 4 * GW;
      float af = 0.f, ab = 0.f;
      for (int k = 0; k < 64; ++k) {
        float hv = h2[k];
        af += hv * w3[k * 4 * GW + 0 * 2 * GW + ord * GW + c];
        ab += hv * w3[k * 4 * GW + 1 * 2 * GW + ord * GW + c];
      }
      if (d > 0) val = af * win;
      else if (d < 0) val = ab * win;
      else val = (af + ab) * win + p.hy_d[(l * 2 + ord) * GW + c];
    }
    float* kf = seg == 0 ? p.kf_lat + ((size_t)(l * 2 + ord) * 2 * SEQ + idx) * GW : p.kf_ctx + ((size_t)(l * 2 + ord) * 2 * CTX + idx) * GW;
    kf[c] = val;
  }
}

#define NV (DM / WL)
__device__ __forceinline__ void ln_inplace(float* v, int lane) {
  float s = 0.f;
#pragma unroll
  for (int i = 0; i < NV; ++i) s += v[i];
  s = wave_sum(s);
  float mu = s * (1.0f / DM);
  float q = 0.f;
#pragma unroll
  for (int i = 0; i < NV; ++i) { float d = v[i] - mu; q += d * d; }
  q = wave_sum(q);
  float rs = 1.0f / sqrtf(q * (1.0f / DM) + 1e-5f);
#pragma unroll
  for (int i = 0; i < NV; ++i) v[i] = (v[i] - mu) * rs;
}
__device__ void ph_ln0(const P& p, int l, int s, int gtid, int gsize) {
  const int lane = gtid % WL, gw = gtid / WL, nw = gsize / WL;
  for (int row = gw; row < RS; row += nw) {
    int bl = row / RPB, pp = row % RPB, b = s * SB + bl;
    const float* xr = xsrc_row(p, l, b, pp);
    const float* mod = p.modtab + ((size_t)l * NMOD + (pp < CTX ? NB : b)) * 6 * DM;
    float v[NV];
#pragma unroll
    for (int i = 0; i < NV; ++i) v[i] = xr[i * WL + lane];
    ln_inplace(v, lane);
#pragma unroll
    for (int i = 0; i < NV; ++i) {
      int k = i * WL + lane;
      p.U[(size_t)row * DM + k] = f2bf(v[i] * (1.0f + mod[DM + k]) + mod[k]);
    }
  }
}
__device__ void ph_ln1(const P& p, int l, int s, int gtid, int gsize) {
  const int lane = gtid % WL, gw = gtid / WL, nw = gsize / WL;
  const bool last = (l == DEPTH - 1);
  for (int row = gw; row < RS; row += nw) {
    int bl = row / RPB, pp = row % RPB, b = s * SB + bl;
    if (last && pp < CTX) continue;
    const float* xr = xsrc_row(p, l, b, pp);
    float* xd = xdst_row(p, b, pp);
    const float* mod = p.modtab + ((size_t)l * NMOD + (pp < CTX ? NB : b)) * 6 * DM;
    const float* o = p.OUTF + (size_t)row * DM;
    float v[NV];
#pragma unroll
    for (int i = 0; i < NV; ++i) { int k = i * WL + lane; v[i] = ALPHA * xr[k] + mod[2 * DM + k] * o[k]; }
    ln_inplace(v, lane);
#pragma unroll
    for (int i = 0; i < NV; ++i) { int k = i * WL + lane; v[i] = v[i] * p.ln1g[l * DM + k] + p.ln1b[l * DM + k]; xd[k] = v[i]; }
    ln_inplace(v, lane);
#pragma unroll
    for (int i = 0; i < NV; ++i) {
      int k = i * WL + lane;
      p.U[(size_t)row * DM + k] = f2bf(v[i] * (1.0f + mod[4 * DM + k]) + mod[3 * DM + k]);
    }
  }
}
__device__ void ph_ln2(const P& p, int l, int s, int gtid, int gsize) {
  const int lane = gtid % WL, gw = gtid / WL, nw = gsize / WL;
  const bool last = (l == DEPTH - 1);
  for (int row = gw; row < RS; row += nw) {
    int bl = row / RPB, pp = row % RPB, b = s * SB + bl;
    if (last && pp < CTX) continue;
    float* xd = xdst_row(p, b, pp);
    const float* mod = p.modtab + ((size_t)l * NMOD + (pp < CTX ? NB : b)) * 6 * DM;
    const float* o = p.OUTF + (size_t)row * DM;
    float v[NV];
#pragma unroll
    for (int i = 0; i < NV; ++i) { int k = i * WL + lane; v[i] = ALPHA * xd[k] + mod[5 * DM + k] * o[k]; }
    ln_inplace(v, lane);
#pragma unroll
    for (int i = 0; i < NV; ++i) { int k = i * WL + lane; xd[k] = v[i] * p.ln2g[l * DM + k] + p.ln2b[l * DM + k]; }
  }
}

#ifndef CPU_EMU
typedef short bf16x8 __attribute__((ext_vector_type(8)));
typedef float f32x4 __attribute__((ext_vector_type(4)));
typedef unsigned u32x4 __attribute__((ext_vector_type(4)));
#define GBM 128
#define GBN 128
#define GBK 64
#define GLD (GBK + 8)
template <bool OUT_BF16>
__device__ void gemm_phase(const bf16_t* __restrict__ A, const bf16_t* __restrict__ Bt, void* __restrict__ Cv, int M, int N, int K, int ldc,
                           bool skip_ctx, bf16_t* lds) {
  bf16_t* sA = lds;
  bf16_t* sB = lds + GBM * GLD;
  const int tid = threadIdx.x, lane = tid & 63, wave = tid >> 6;
  const int wm = wave >> 1, wn = wave & 1;
  const int ntm = M / GBM, ntn = N / GBN;
  const int KT = K / GBK;
  const int lr = lane & 15, lq = lane >> 4;
  for (int tile = blockIdx.x; tile < ntm * ntn; tile += gridDim.x) {
    const int tm = tile / ntn, tn = tile % ntn;
    if (skip_ctx && (tm % (RPB / GBM)) < (CTX / GBM)) continue;
    const int m0 = tm * GBM, n0 = tn * GBN;
    f32x4 acc[4][4];
#pragma unroll
    for (int i = 0; i < 4; ++i)
#pragma unroll
      for (int j = 0; j < 4; ++j) acc[i][j] = (f32x4){0.f, 0.f, 0.f, 0.f};
    u32x4 ra[4], rb[4];
#pragma unroll
    for (int i = 0; i < 4; ++i) {
      int id = tid + i * 256, r = id >> 3, ch = id & 7;
      ra[i] = *(const u32x4*)(A + (size_t)(m0 + r) * K + ch * 8);
      rb[i] = *(const u32x4*)(Bt + (size_t)(n0 + r) * K + ch * 8);
    }
    for (int kt = 0; kt < KT; ++kt) {
      __syncthreads();
#pragma unroll
      for (int i = 0; i < 4; ++i) {
        int id = tid + i * 256, r = id >> 3, ch = id & 7;
        *(u32x4*)(sA + r * GLD + ch * 8) = ra[i];
        *(u32x4*)(sB + r * GLD + ch * 8) = rb[i];
      }
      __syncthreads();
      if (kt + 1 < KT) {
#pragma unroll
        for (int i = 0; i < 4; ++i) {
          int id = tid + i * 256, r = id >> 3, ch = id & 7;
          ra[i] = *(const u32x4*)(A + (size_t)(m0 + r) * K + (kt + 1) * GBK + ch * 8);
          rb[i] = *(const u32x4*)(Bt + (size_t)(n0 + r) * K + (kt + 1) * GBK + ch * 8);
        }
      }
#pragma unroll
      for (int kk = 0; kk < GBK; kk += 32) {
        bf16x8 fa[4], fb[4];
#pragma unroll
        for (int i = 0; i < 4; ++i) fa[i] = *(const bf16x8*)(sA + (wm * 64 + i * 16 + lr) * GLD + kk + lq * 8);
#pragma unroll
        for (int j = 0; j < 4; ++j) fb[j] = *(const bf16x8*)(sB + (wn * 64 + j * 16 + lr) * GLD + kk + lq * 8);
#pragma unroll
        for (int i = 0; i < 4; ++i)
#pragma unroll
          for (int j = 0; j < 4; ++j) acc[i][j] = __builtin_amdgcn_mfma_f32_16x16x32_bf16(fb[j], fa[i], acc[i][j], 0, 0, 0);
      }
    }
#pragma unroll
    for (int i = 0; i < 4; ++i)
#pragma unroll
      for (int j = 0; j < 4; ++j) {
        size_t off = (size_t)(m0 + wm * 64 + i * 16 + lr) * ldc + n0 + wn * 64 + j * 16 + lq * 4;
        if (OUT_BF16) {
          uint2 o;
          o.x = pack_bf16(acc[i][j][0], acc[i][j][1]);
          o.y = pack_bf16(acc[i][j][2], acc[i][j][3]);
          *(uint2*)((bf16_t*)Cv + off) = o;
        } else {
          *(float4*)((float*)Cv + off) = make_float4(acc[i][j][0], acc[i][j][1], acc[i][j][2], acc[i][j][3]);
        }
      }
  }
}
#else
template <bool OUT_BF16>
void gemm_phase(const bf16_t* A, const bf16_t* Bt, void* Cv, int M, int N, int K, int ldc, bool skip_ctx, bf16_t* lds) {
  int gtid = blockIdx.x * blockDim.x + threadIdx.x, gsize = gridDim.x * blockDim.x;
  for (long it = gtid; it < (long)M * N; it += gsize) {
    int m = (int)(it / N), n = (int)(it % N);
    if (skip_ctx && (m % RPB) < CTX) continue;
    float acc = 0.f;
    for (int k = 0; k < K; ++k) acc += bf2f(A[(size_t)m * K + k]) * bf2f(Bt[(size_t)n * K + k]);
    if (OUT_BF16) ((bf16_t*)Cv)[(size_t)m * ldc + n] = f2bf(acc);
    else ((float*)Cv)[(size_t)m * ldc + n] = acc;
  }
}
#endif

#define PJ(row, col) bf2f(p.PROJ[(size_t)(row) * LDP + (col)])
template <int ORD>
__device__ void hyena_conv_item(const P& p, int l, int it) {
  const bool need_ctx = (l != DEPTH - 1);
  const int ntb = (need_ctx ? CTX / 16 : 0) + SEQ / 16;
  int c = it % GW, r = it / GW;
  int tb = r % ntb, bl = r / ntb;
  int seg0, L, t0;
  const float* kf;
  if (need_ctx && tb < CTX / 16) { seg0 = 0; L = CTX; t0 = tb * 16; kf = p.kf_ctx + (size_t)(l * 2 + ORD) * 2 * CTX * GW; }
  else { int tb2 = tb - (need_ctx ? CTX / 16 : 0); seg0 = CTX; L = SEQ; t0 = tb2 * 16; kf = p.kf_lat + (size_t)(l * 2 + ORD) * 2 * SEQ * GW; }
  const int rowbase = bl * RPB + seg0;
  const float* cw = p.hy_cw + (size_t)l * 3 * 3 * GW;
  const float* cb = p.hy_cb + (size_t)l * 3 * GW;
  float acc[16], F[31], u[16];
#pragma unroll
  for (int i = 0; i < 16; ++i) acc[i] = 0.f;
#pragma unroll
  for (int m = 0; m < 15; ++m) F[m] = kf[(size_t)(L + t0 + 1 + m) * GW + c];
  const float w0 = cw[0 * 3 * GW + c], w1 = cw[1 * 3 * GW + c], w2 = cw[2 * 3 * GW + c], bb = cb[c];
  for (int s0 = 0; s0 < L; s0 += 16) {
#pragma unroll
    for (int m = 14; m >= 0; --m) F[m + 16] = F[m];
#pragma unroll
    for (int m = 0; m < 16; ++m) F[m] = kf[(size_t)(L + t0 - s0 - 15 + m) * GW + c];
    if (ORD == 0) {
      float raw[18];
#pragma unroll
      for (int j = 0; j < 18; ++j) {
        int sp = s0 - 1 + j;
        raw[j] = (sp >= 0 && sp < L) ? PJ(rowbase + sp, OFF_HY + c) : 0.f;
      }
#pragma unroll
      for (int j = 0; j < 16; ++j) u[j] = w0 * raw[j] + w1 * raw[j + 1] + w2 * raw[j + 2] + bb;
    } else {
#pragma unroll
      for (int j = 0; j < 16; ++j) u[j] = p.Z2[(size_t)(rowbase + s0 + j) * GW + c];
    }
#pragma unroll
    for (int j = 0; j < 16; ++j)
#pragma unroll
      for (int i = 0; i < 16; ++i) acc[i] += F[i - j + 15] * u[j];
  }
  const int xc = (ORD == 0 ? GW : 2 * GW) + c;
  const float v0 = cw[0 * 3 * GW + xc], v1 = cw[1 * 3 * GW + xc], v2 = cw[2 * 3 * GW + xc], vb = cb[xc];
#pragma unroll
  for (int i = 0; i < 16; ++i) {
    int t = t0 + i;
    float xm = t > 0 ? PJ(rowbase + t - 1, OFF_HY + xc) : 0.f;
    float x0 = PJ(rowbase + t, OFF_HY + xc);
    float xp = t < L - 1 ? PJ(rowbase + t + 1, OFF_HY + xc) : 0.f;
    float g = v0 * xm + v1 * x0 + v2 * xp + vb;
    float o = g * acc[i];
    if (ORD == 0) p.Z2[(size_t)(rowbase + t) * GW + c] = o;
    else p.HY[(size_t)(rowbase + t) * GW + c] = o;
  }
}
__device__ __forceinline__ int hyena_items(int l) { return SB * ((l != DEPTH - 1 ? CTX / 16 : 0) + SEQ / 16) * GW; }

__device__ __forceinline__ float rw_shift(const P& p, int l, int row, int pp, int j) {
  float x = PJ(row, OFF_RW + j);
  float xp = has_prev(pp) ? PJ(row - 1, OFF_RW + j) : 0.f;
  float xn = has_next(pp) ? PJ(row + 1, OFF_RW + j) : 0.f;
  return x + p.rw_mu[(size_t)(l * 2 + 0) * RWSH + j] * (xp - x) + p.rw_mu[(size_t)(l * 2 + 1) * RWSH + j] * (xn - x);
}
__device__ void ph_prep(const P& p, int l, int s, int gtid, int gsize) {
  for (int it = gtid; it < RS * 2 * GW; it += gsize) {
    int j = it % (2 * GW), row = it / (2 * GW), pp = row % RPB;
    const float* cw = p.ml_cw + (size_t)l * 3 * 2 * GW;
    float xm = has_prev(pp) ? PJ(row - 1, OFF_ML + j) : 0.f;
    float x0 = PJ(row, OFF_ML + j);
    float xp = has_next(pp) ? PJ(row + 1, OFF_ML + j) : 0.f;
    float v = cw[j] * xm + cw[2 * GW + j] * x0 + cw[4 * GW + j] * xp + p.ml_cb[l * 2 * GW + j];
    v = siluf_(v);
    if (j < GW) v *= 0.125f;
    p.MQK[(size_t)row * 2 * GW + j] = v;
  }
  for (int it = gtid; it < RS * 4 * NH; it += gsize) {
    int gj = it % (4 * NH), row = it / (4 * NH);
    float g = PJ(row, OFF_ML + 4 * GW + gj) + p.ml_gb[l * 4 * NH + gj];
    if ((gj / NH) & 1) g = logsigmoidf_(g);
    p.MG[(size_t)row * 4 * NH + gj] = g;
  }
  for (int it = gtid; it < RS * 2 * GW; it += gsize) {
    int j = it % (2 * GW), row = it / (2 * GW), pp = row % RPB;
    int which = j / GW, c = j % GW, dd = c % HD, hb = c - dd;
    int base = OFF_RT + which * GW;
    float x = PJ(row, base + c), o = x;
    if (pp >= CTX) {
      int t = pp - CTX, ri = t / GRIDW, ci = t % GRIDW;
      int half = dd / 32, e = dd % 32, pr = e % 16;
      bool first = e < 16;
      float pos = (float)(half ? ci : ri);
      float fr = powf(10000.0f, -(float)pr / 16.0f);
      float a = pos * fr;
      float xo = PJ(row, base + hb + (first ? dd + 16 : dd - 16));
      float cs = cosf(a), sn = sinf(a);
      o = first ? x * cs - xo * sn : x * cs + xo * sn;
    }
    if (which == 0) o *= 0.125f;
    p.RQK[(size_t)row * 2 * GW + j] = o;
  }
  for (int it = gtid; it < RS * GW; it += gsize) {
    int c = it % GW, row = it / GW, pp = row % RPB;
    int hb = c - c % HD;
    float r = rw_shift(p, l, row, pp, c);
    float k = rw_shift(p, l, row, pp, GW + c);
    float ss = 0.f;
    for (int i = 0; i < HD; ++i) {
      float kk = rw_shift(p, l, row, pp, GW + hb + i) * p.rw_kk[l * GW + hb + i];
      ss += kk * kk;
    }
    float kkv = k * p.rw_kk[l * GW + c] / sqrtf(ss + 1e-12f);
    float wa0 = 0.f, wa1 = 0.f, aa0 = 0.f, aa1 = 0.f;
    for (int i = 0; i < 32; ++i) {
      float tw = tanhf(rw_shift(p, l, row, pp, 3 * GW + i));
      float al = rw_shift(p, l, row, pp, 3 * GW + 32 + i);
      wa0 += tw * p.rw_w2[((size_t)(l * 2 + 0) * 32 + i) * GW + c];
      wa1 += tw * p.rw_w2[((size_t)(l * 2 + 1) * 32 + i) * GW + c];
      aa0 += al * p.rw_a2[((size_t)(l * 2 + 0) * 32 + i) * GW + c];
      aa1 += al * p.rw_a2[((size_t)(l * 2 + 1) * 32 + i) * GW + c];
    }
    const size_t o = (size_t)row * GW + c, AS = (size_t)RS * GW;
    p.RW[0 * AS + o] = r;
    p.RW[1 * AS + o] = kkv;
    const float ka = p.rw_ka[l * GW + c];
#pragma unroll
    for (int d = 0; d < 2; ++d) {
      float wpre = p.rw_w0[(l * 2 + d) * GW + c] + (d ? wa1 : wa0);
      float decay = expf(-expf(-softplusf_(-wpre) - 0.5f));
      float a = sigmoidf_(p.rw_a0[(l * 2 + d) * GW + c] + (d ? aa1 : aa0));
      p.RW[(2 + d) * AS + o] = decay;
      p.RW[(4 + d) * AS + o] = k * (1.0f + (a - 1.0f) * ka);
      p.RW[(6 + d) * AS + o] = kkv * a;
    }
  }
  for (int it = gtid; it < hyena_items(l); it += gsize) hyena_conv_item<0>(p, l, it);
}

__device__ __forceinline__ int scan_pos(int dir, int step) {
  if (!dir) return step;
  return step < CTX ? CTX - 1 - step : RPB - 1 - (step - CTX);
}
__device__ void scan_mlstm(const P& p, int bl, int h, int dir, int e) {
  float C[HD], n[HD];
#pragma unroll
  for (int d = 0; d < HD; ++d) { C[d] = 0.f; n[d] = 0.f; }
  float m = 0.f;
  float* H = dir ? p.HB : p.HF;
  for (int step = 0; step < RPB; ++step) {
    const int row = bl * RPB + scan_pos(dir, step);
    const float* mg = p.MG + (size_t)row * 4 * NH;
    float ig = mg[(dir ? 2 : 0) * NH + h], lf = mg[(dir ? 3 : 1) * NH + h];
    float mn = fmaxf(lf + m, ig);
    float f = expf(lf + m - mn), ii = expf(ig - mn);
    m = mn;
    float v = PJ(row, OFF_ML + 2 * GW + h * HD + e);
    float iv = ii * v;
    const float* q = p.MQK + (size_t)row * 2 * GW + h * HD;
    const float* k = q + GW;
    float num = 0.f, den = 0.f;
#pragma unroll
    for (int d = 0; d < HD; ++d) {
      float kd = k[d], qd = q[d];
      C[d] = fmaf(kd, iv, f * C[d]);
      n[d] = fmaf(kd, ii, f * n[d]);
      num = fmaf(qd, C[d], num);
      den = fmaf(qd, n[d], den);
    }
    H[(size_t)row * 3 * GW + 0 * GW + h * HD + e] = num / fmaxf(fabsf(den), expf(-m));
  }
}
__device__ void scan_ret(const P& p, int bl, int h, int dir, int e) {
  float S[HD];
#pragma unroll
  for (int d = 0; d < HD; ++d) S[d] = 0.f;
  const int hh = dir ? NH - 1 - h : h;
  const float gamma = 1.0f - exp2f(-5.0f - (float)hh);
  float* H = dir ? p.HB : p.HF;
  for (int step = 0; step < RPB; ++step) {
    const int row = bl * RPB + scan_pos(dir, step);
    float v = PJ(row, OFF_RT + 2 * GW + h * HD + e);
    const float* q = p.RQK + (size_t)row * 2 * GW + h * HD;
    const float* k = q + GW;
    float o = 0.f;
#pragma unroll
    for (int d = 0; d < HD; ++d) {
      S[d] = fmaf(S[d], gamma, k[d] * v);
      o = fmaf(q[d], S[d], o);
    }
    H[(size_t)row * 3 * GW + 1 * GW + h * HD + e] = o;
  }
}
__device__ void scan_rwkv(const P& p, int l, int bl, int h, int dir, int e) {
  float S[HD];
#pragma unroll
  for (int d = 0; d < HD; ++d) S[d] = 0.f;
  float* H = dir ? p.HB : p.HF;
  const size_t AS = (size_t)RS * GW;
  const int vc = 2 * GW + h * HD + e;
  const float mu0 = p.rw_mu[(size_t)(l * 2 + 0) * RWSH + vc], mu1 = p.rw_mu[(size_t)(l * 2 + 1) * RWSH + vc];
  for (int step = 0; step < RPB; ++step) {
    const int pp = scan_pos(dir, step);
    const int row = bl * RPB + pp;
    float x = PJ(row, OFF_RW + vc);
    float xp = has_prev(pp) ? PJ(row - 1, OFF_RW + vc) : 0.f;
    float xn = has_next(pp) ? PJ(row + 1, OFF_RW + vc) : 0.f;
    float vv = x + mu0 * (xp - x) + mu1 * (xn - x);
    const size_t o = (size_t)row * GW + h * HD;
    const float* rr = p.RW + 0 * AS + o;
    const float* kk = p.RW + 1 * AS + o;
    const float* ww = p.RW + (2 + dir) * AS + o;
    const float* kd = p.RW + (4 + dir) * AS + o;
    const float* bb = p.RW + (6 + dir) * AS + o;
    float sa = 0.f;
#pragma unroll
    for (int d = 0; d < HD; ++d) sa = fmaf(S[d], kk[d], sa);
    sa = -sa;
    float y = 0.f;
#pragma unroll
    for (int d = 0; d < HD; ++d) {
      S[d] = fmaf(S[d], ww[d], fmaf(sa, bb[d], vv * kd[d]));
      y = fmaf(S[d], rr[d], y);
    }
    H[(size_t)row * 3 * GW + 2 * GW + h * HD + e] = y;
  }
}
#define NSCAN (3 * SB * NH * 2)
__device__ void ph_scan(const P& p, int l, int s, int gtid, int gsize) {
  const int lane = gtid % 64;
  int gw = gtid / 64;
#ifndef CPU_EMU
  gw = __builtin_amdgcn_readfirstlane(gw);
#endif
  const int nw = gsize / 64;
  const int nconv = hyena_items(l) / 64;
  for (int w = gw; w < NSCAN + nconv; w += nw) {
    if (w < NSCAN) {
      int mixer = w / (SB * NH * 2), r = w % (SB * NH * 2);
      int dir = r & 1, h = (r >> 1) % NH, bl = (r >> 1) / NH;
      if (mixer == 0) scan_rwkv(p, l, bl, h, dir, lane);
      else if (mixer == 1) scan_mlstm(p, bl, h, dir, lane);
      else scan_ret(p, bl, h, dir, lane);
    } else {
      hyena_conv_item<1>(p, l, (w - NSCAN) * 64 + lane);
    }
  }
}

__device__ void ph_fin(const P& p, int l, int s, int gtid, int gsize) {
  const bool last = (l == DEPTH - 1);
  for (int it = gtid; it < RS * 4 * NH; it += gsize) {
    int row = it % RS, hg = it / RS, pp = row % RPB;
    if (last && pp < CTX) continue;
    int g = hg / NH, h = hg % NH;
    const int c0 = g * GW + h * HD;
    const float *s1, *s2 = nullptr;
    if (g == 1) s1 = p.HY + (size_t)row * GW + h * HD;
    else {
      int slot = (g == 0) ? 0 : (g == 2 ? 1 : 2);
      s1 = p.HF + (size_t)row * 3 * GW + slot * GW + h * HD;
      s2 = p.HB + (size_t)row * 3 * GW + slot * GW + h * HD;
    }
    float val[HD];
    float sum = 0.f;
#pragma unroll
    for (int i = 0; i < HD; ++i) { float v = s1[i]; if (s2) v += s2[i]; val[i] = v; sum += v; }
    float mu = sum * (1.0f / HD), q = 0.f;
#pragma unroll
    for (int i = 0; i < HD; ++i) { float d = val[i] - mu; q += d * d; }
    float rs = 1.0f / sqrtf(q * (1.0f / HD) + 1e-5f);
    const float* ng = p.ng + l * DM + c0;
    const float* nb = p.nb + l * DM + c0;
#pragma unroll
    for (int i = 0; i < HD; ++i) val[i] = (val[i] - mu) * rs * ng[i] + nb[i];
    bf16_t* y = p.U + (size_t)row * DM + c0;
    if (g == 0) {
#pragma unroll
      for (int i = 0; i < HD; ++i) val[i] *= sigmoidf_(PJ(row, OFF_ML + 3 * GW + h * HD + i));
    } else if (g == 2) {
#pragma unroll
      for (int i = 0; i < HD; ++i) val[i] *= siluf_(PJ(row, OFF_RT + 3 * GW + h * HD + i));
    } else if (g == 3) {
      float bsum = 0.f;
      for (int i = 0; i < HD; ++i)
        bsum += rw_shift(p, l, row, pp, h * HD + i) * rw_shift(p, l, row, pp, GW + h * HD + i) * p.rw_rk[(l * NH + h) * HD + i];
#pragma unroll
      for (int i = 0; i < HD; ++i) val[i] += bsum * rw_shift(p, l, row, pp, 2 * GW + h * HD + i);
      float G[HD];
#pragma unroll
      for (int i = 0; i < HD; ++i) G[i] = 0.f;
      for (int j = 0; j < 64; ++j) {
        float sg = sigmoidf_(rw_shift(p, l, row, pp, 3 * GW + 64 + j));
        const float* g2 = p.rw_g2 + ((size_t)l * 64 + j) * GW + h * HD;
#pragma unroll
        for (int i = 0; i < HD; ++i) G[i] = fmaf(sg, g2[i], G[i]);
      }
#pragma unroll
      for (int i = 0; i < HD; ++i) val[i] *= G[i];
    }
#pragma unroll
    for (int i = 0; i < HD; i += 2) *(unsigned*)(y + i) = f2bf(val[i]) | ((unsigned)f2bf(val[i + 1]) << 16);
  }
}

__device__ void ph_act(const P& p, int l, int s, int gtid, int gsize) {
  const bool last = (l == DEPTH - 1);
  const float* cw = p.f_cw + (size_t)l * 3 * DFF;
  const float* cb = p.f_cb + (size_t)l * DFF;
  for (int it = gtid; it < RS * (DFF / 2); it += gsize) {
    int j = (it % (DFF / 2)) * 2, row = it / (DFF / 2), pp = row % RPB;
    if (last && pp < CTX) continue;
    const bf16_t* hr = p.HFF + (size_t)row * 2 * DFF;
    unsigned am = has_prev(pp) ? *(const unsigned*)(hr - 2 * DFF + j) : 0u;
    unsigned a0 = *(const unsigned*)(hr + j);
    unsigned ap = has_next(pp) ? *(const unsigned*)(hr + 2 * DFF + j) : 0u;
    unsigned bv = *(const unsigned*)(hr + DFF + j);
    float o[2];
#pragma unroll
    for (int e = 0; e < 2; ++e) {
      float xm = bf2f((bf16_t)(am >> (16 * e))), x0 = bf2f((bf16_t)(a0 >> (16 * e))), xp = bf2f((bf16_t)(ap >> (16 * e)));
      float v = cw[j + e] * xm + cw[DFF + j + e] * x0 + cw[2 * DFF + j + e] * xp + cb[j + e];
      o[e] = siluf_(v) * bf2f((bf16_t)(bv >> (16 * e)));
    }
    *(unsigned*)(p.ACT + (size_t)row * DFF + j) = f2bf(o[0]) | ((unsigned)f2bf(o[1]) << 16);
  }
}

enum { PH_PRO_A = 0, PH_PRO_B, PH_PRO_C, PH_LN0, PH_GEMM_IN, PH_PREP, PH_SCAN, PH_FIN, PH_GEMM_OUT, PH_LN1, PH_GEMM_UP, PH_ACT, PH_GEMM_DN, PH_LN2, PH_COUNT };

__device__ void run_phase(const P& p, int ph, int l, int s, bf16_t* lds) {
  const int gtid = blockIdx.x * blockDim.x + threadIdx.x, gsize = gridDim.x * blockDim.x;
  const bool last = (l == DEPTH - 1);
  switch (ph) {
    case PH_PRO_A: ph_pro_a(p, gtid, gsize); break;
    case PH_PRO_B: ph_pro_b(p, gtid, gsize); break;
    case PH_PRO_C: ph_pro_c(p, gtid, gsize); break;
    case PH_LN0: ph_ln0(p, l, s, gtid, gsize); break;
    case PH_GEMM_IN: gemm_phase<true>(p.U, p.wt_in + (size_t)l * LDP * DM, p.PROJ, RS, LDP, DM, LDP, false, lds); break;
    case PH_PREP: ph_prep(p, l, s, gtid, gsize); break;
    case PH_SCAN: ph_scan(p, l, s, gtid, gsize); break;
    case PH_FIN: ph_fin(p, l, s, gtid, gsize); break;
    case PH_GEMM_OUT: gemm_phase<false>(p.U, p.wt_out + (size_t)l * DM * DM, p.OUTF, RS, DM, DM, DM, last, lds); break;
    case PH_LN1: ph_ln1(p, l, s, gtid, gsize); break;
    case PH_GEMM_UP: gemm_phase<true>(p.U, p.wt_up + (size_t)l * 2 * DFF * DM, p.HFF, RS, 2 * DFF, DM, 2 * DFF, last, lds); break;
    case PH_ACT: ph_act(p, l, s, gtid, gsize); break;
    case PH_GEMM_DN: gemm_phase<false>(p.ACT, p.wt_dn + (size_t)l * DM * DFF, p.OUTF, RS, DM, DFF, DM, last, lds); break;
    case PH_LN2: ph_ln2(p, l, s, gtid, gsize); break;
  }
}

#ifndef CPU_EMU
template <int PH>
__global__ void __launch_bounds__(256) k_phase(P p, int l, int s) {
  __shared__ __attribute__((aligned(16))) bf16_t lds[2 * 128 * (64 + 8)];
  run_phase(p, PH, l, s, lds);
}
#endif

static size_t ws_take(size_t& off, size_t bytes) { size_t o = off; off += (bytes + 255) & ~(size_t)255; return o; }

static void build_params(P& p, void* const* d_in, void* d_out, void* d_ws) {
  const float** f = (const float**)&p;
  for (int i = 0; i < 39; ++i) f[i] = (const float*)d_in[i];
  p.out = (float*)d_out;
  char* w = (char*)d_ws;
  size_t off = 0;
  p.wt_in = (bf16_t*)(w + ws_take(off, (size_t)DEPTH * LDP * DM * 2));
  p.wt_out = (bf16_t*)(w + ws_take(off, (size_t)DEPTH * DM * DM * 2));
  p.wt_up = (bf16_t*)(w + ws_take(off, (size_t)DEPTH * 2 * DFF * DM * 2));
  p.wt_dn = (bf16_t*)(w + ws_take(off, (size_t)DEPTH * DM * DFF * 2));
  p.kf_lat = (float*)(w + ws_take(off, (size_t)DEPTH * 2 * 2 * SEQ * GW * 4));
  p.kf_ctx = (float*)(w + ws_take(off, (size_t)DEPTH * 2 * 2 * CTX * GW * 4));
  p.hyh1 = (float*)(w + ws_take(off, (size_t)DEPTH * 2 * SEQ * 64 * 4));
  p.hyh2 = (float*)(w + ws_take(off, (size_t)DEPTH * 2 * SEQ * 64 * 4));
  p.scv = (float*)(w + ws_take(off, (size_t)NMOD * DM * 4));
  p.modtab = (float*)(w + ws_take(off, (size_t)DEPTH * NMOD * 6 * DM * 4));
  p.xc = (float*)(w + ws_take(off, (size_t)NB * CTX * DM * 4));
  p.U = (bf16_t*)(w + ws_take(off, (size_t)RS * DM * 2));
  size_t arena = off;
  p.PROJ = (bf16_t*)(w + ws_take(off, (size_t)RS * LDP * 2));
  p.MQK = (float*)(w + ws_take(off, (size_t)RS * 2 * GW * 4));
  p.MG = (float*)(w + ws_take(off, (size_t)RS * 4 * NH * 4));
  p.RQK = (float*)(w + ws_take(off, (size_t)RS * 2 * GW * 4));
  p.RW = (float*)(w + ws_take(off, (size_t)8 * RS * GW * 4));
  p.HF = (float*)(w + ws_take(off, (size_t)RS * 3 * GW * 4));
  p.HB = (float*)(w + ws_take(off, (size_t)RS * 3 * GW * 4));
  p.Z2 = (float*)(w + ws_take(off, (size_t)RS * GW * 4));
  p.HY = (float*)(w + ws_take(off, (size_t)RS * GW * 4));
  size_t off2 = arena;
  p.OUTF = (float*)(w + ws_take(off2, (size_t)RS * DM * 4));
  p.HFF = (bf16_t*)(w + ws_take(off2, (size_t)RS * 2 * DFF * 2));
  p.ACT = (bf16_t*)(w + ws_take(off2, (size_t)RS * DFF * 2));
}

#ifndef CPU_EMU
template <int PH>
static void launch(const P& p, int l, int s, int blocks, hipStream_t stream) {
  k_phase<PH><<<blocks, 256, 0, stream>>>(p, l, s);
}

extern "C" void kernel_launch(void* const* d_in, const int* in_sizes, int n_in, void* d_out, int out_size, void* d_ws, size_t ws_size,
                              hipStream_t stream) {
  P p;
  build_params(p, d_in, d_out, d_ws);
  const int BIG = 256 * 8;
  launch<PH_PRO_A>(p, 0, 0, BIG, stream);
  launch<PH_PRO_B>(p, 0, 0, BIG, stream);
  launch<PH_PRO_C>(p, 0, 0, BIG, stream);
  for (int l = 0; l < DEPTH; ++l)
    for (int s = 0; s < NSLICE; ++s) {
      launch<PH_LN0>(p, l, s, RS / 4, stream);
      launch<PH_GEMM_IN>(p, l, s, (RS / 128) * (LDP / 128), stream);
      launch<PH_PREP>(p, l, s, BIG * 2, stream);
      launch<PH_SCAN>(p, l, s, (NSCAN + SB * (CTX / 16 + SEQ / 16) * GW / 64 + 3) / 4, stream);
      launch<PH_FIN>(p, l, s, RS * 4 * NH / 256, stream);
      launch<PH_GEMM_OUT>(p, l, s, (RS / 128) * (DM / 128), stream);
      launch<PH_LN1>(p, l, s, RS / 4, stream);
      launch<PH_GEMM_UP>(p, l, s, (RS / 128) * (2 * DFF / 128), stream);
      launch<PH_ACT>(p, l, s, BIG * 2, stream);
      launch<PH_GEMM_DN>(p, l, s, (RS / 128) * (DM / 128), stream);
      launch<PH_LN2>(p, l, s, RS / 4, stream);
    }
}
#endif
```

```cpp
#ifndef CPU_EMU
#include <hip/hip_runtime.h>
#include <hip/hip_cooperative_groups.h>
#include <cstdio>
#include <cstring>
namespace cg = cooperative_groups;
#endif
#include <stdint.h>

#if !defined(CFG_SMALL) && !defined(CFG_CONVTEST)
#define DM 1024
#define NB 32
#define SEQ 2048
#define CTX 256
#define DFF 2816
#define SB 8
#elif defined(CFG_CONVTEST)
#define DM 512
#define NB 8
#define SEQ 256
#define CTX 128
#define DFF 192
#define SB 8
#else
#define DM 512
#define NB 2
#define SEQ 256
#define CTX 128
#define DFF 192
#define SB 1
#endif
#define DEPTH 2
#define GRIDW 64
#define HD 64
#define GW (DM / 4)
#define NH (GW / HD)
#define DPROJ (14 * GW + 4 * NH + 128)
#define LDP ((DPROJ + 127) / 128 * 128)
#define OFF_ML 0
#define OFF_HY (4 * GW + 4 * NH)
#define OFF_RT (OFF_HY + 3 * GW)
#define OFF_RW (OFF_RT + 4 * GW)
#define RWSH (3 * GW + 128)
#define RPB (CTX + SEQ)
#define RS (SB * RPB)
#define NSLICE (NB / SB)
#define ALPHA 1.41421356237309515f
#define NMOD 33
#ifdef CPU_EMU
#define WL 1
#else
#define WL 64
#endif

typedef unsigned short bf16_t;

struct P {
  const float *x, *c, *ctx, *c_ctx, *ada_w, *ada_b, *w_in, *ml_cw, *ml_cb, *ml_gb, *hy_cw, *hy_cb, *hy_w1, *hy_b1, *hy_w2, *hy_b2, *hy_w3,
      *hy_freq, *hy_d, *rw_mu, *rw_w0, *rw_w2, *rw_a0, *rw_a2, *rw_g2, *rw_kk, *rw_ka, *rw_rk, *ng, *nb, *w_out, *ln1g, *ln1b, *w_up, *f_cw,
      *f_cb, *w_dn, *ln2g, *ln2b;
  float* out;
  bf16_t *wt_in, *wt_out, *wt_up, *wt_dn;
  float *kf_lat, *kf_ctx, *hyh1, *hyh2, *scv, *modtab, *xc;
  bf16_t *kt_lat, *kt_ctx;
  bf16_t *U, *PROJ;
  float *MQK, *MG, *RQK, *RW, *HF, *HB, *Z2, *HY, *BON, *GG;
  float* OUTF;
  bf16_t *HFF, *ACT;
  int* ctr;
};

__device__ __forceinline__ bf16_t f2bf(float f) {
  unsigned u = __float_as_uint(f);
  u += 0x7fffu + ((u >> 16) & 1u);
  return (bf16_t)(u >> 16);
}
__device__ __forceinline__ unsigned pack_bf16(float lo, float hi) {
#ifndef CPU_EMU
  unsigned r;
  asm volatile("v_cvt_pk_bf16_f32 %0, %1, %2" : "=v"(r) : "v"(lo), "v"(hi));
  return r;
#else
  return f2bf(lo) | ((unsigned)f2bf(hi) << 16);
#endif
}
__device__ __forceinline__ float bf2f(bf16_t h) { return __uint_as_float(((unsigned)h) << 16); }
__device__ __forceinline__ float sigmoidf_(float x) { return 1.0f / (1.0f + expf(-x)); }
__device__ __forceinline__ float siluf_(float x) { return x / (1.0f + expf(-x)); }
__device__ __forceinline__ float softplusf_(float x) { return fmaxf(x, 0.0f) + log1pf(expf(-fabsf(x))); }
__device__ __forceinline__ float logsigmoidf_(float x) { return -softplusf_(-x); }

__device__ __forceinline__ float wave_sum(float v) {
#ifndef CPU_EMU
#pragma unroll
  for (int o = 32; o > 0; o >>= 1) v += __shfl_xor(v, o, 64);
#endif
  return v;
}

__device__ __forceinline__ const float* xsrc_row(const P& p, int l, int b, int pp) {
  if (pp < CTX) return (l == 0 ? p.ctx : p.xc) + ((size_t)b * CTX + pp) * DM;
  return (l == 0 ? p.x : p.out) + ((size_t)b * SEQ + (pp - CTX)) * DM;
}
__device__ __forceinline__ float* xdst_row(const P& p, int b, int pp) {
  if (pp < CTX) return p.xc + ((size_t)b * CTX + pp) * DM;
  return p.out + ((size_t)b * SEQ + (pp - CTX)) * DM;
}
__device__ __forceinline__ bool has_prev(int pp) { return pp != 0 && pp != CTX; }
__device__ __forceinline__ bool has_next(int pp) { return pp != CTX - 1 && pp != RPB - 1; }

__device__ __forceinline__ void cvt_weight(const float* W, bf16_t* Wt, int K, int N, int Npad, int gtid, int gsize) {
  const int nk8 = K / 8;
  for (long it = gtid; it < (long)nk8 * Npad; it += gsize) {
    int n = (int)(it % Npad), k8 = (int)(it / Npad);
    bf16_t v[8];
#pragma unroll
    for (int j = 0; j < 8; ++j) v[j] = (n < N) ? f2bf(W[(size_t)(k8 * 8 + j) * N + n]) : (bf16_t)0;
    uint4 o;
    o.x = v[0] | ((unsigned)v[1] << 16); o.y = v[2] | ((unsigned)v[3] << 16);
    o.z = v[4] | ((unsigned)v[5] << 16); o.w = v[6] | ((unsigned)v[7] << 16);
    *(uint4*)(Wt + (size_t)n * K + k8 * 8) = o;
  }
}
__device__ __forceinline__ void hy_feat_h1(const P& p, int gtid, int gsize) {
  const int per_l = (SEQ + CTX) * 64;
  for (int it = gtid; it < DEPTH * per_l; it += gsize) {
    int l = it / per_l, r = it % per_l;
    int i, L, seg;
    int j = r % 64; r /= 64;
    if (r < SEQ) { seg = 0; i = r; L = SEQ; } else { seg = 1; i = r - SEQ; L = CTX; }
    const float* w1 = p.hy_w1 + (size_t)l * 33 * 64;
    float t = (float)i / (float)(L - 1);
    float ang = 6.283185307179586f * (float)i / (float)L;
    float acc = t * w1[j];
    for (int b = 0; b < 16; ++b) {
      float band = 1e-4f + (float)b * ((15.0f - 1e-4f) / 15.0f);
      float a = band * ang;
      acc += cosf(a) * w1[(1 + b) * 64 + j];
      acc -= sinf(a) * w1[(17 + b) * 64 + j];
    }
    float h = sinf(p.hy_freq[l * 64 + j] * (acc + p.hy_b1[l * 64 + j]));
    p.hyh1[((size_t)(l * 2 + seg) * SEQ + i) * 64 + j] = h;
  }
}
__device__ __forceinline__ void ph_pro_a(const P& p, int gtid, int gsize) {
  for (int l = 0; l < DEPTH; ++l) {
    cvt_weight(p.w_in + (size_t)l * DM * DPROJ, p.wt_in + (size_t)l * LDP * DM, DM, DPROJ, LDP, gtid, gsize);
    cvt_weight(p.w_out + (size_t)l * DM * DM, p.wt_out + (size_t)l * DM * DM, DM, DM, DM, gtid, gsize);
    cvt_weight(p.w_up + (size_t)l * DM * 2 * DFF, p.wt_up + (size_t)l * 2 * DFF * DM, DM, 2 * DFF, 2 * DFF, gtid, gsize);
    cvt_weight(p.w_dn + (size_t)l * DFF * DM, p.wt_dn + (size_t)l * DM * DFF, DFF, DM, DM, gtid, gsize);
  }
  for (int it = gtid; it < NMOD * DM; it += gsize) {
    int r = it / DM, k = it % DM;
    float v = (r < NB) ? p.c[(size_t)r * DM + k] : p.c_ctx[k];
    p.scv[it] = siluf_(v);
  }
  hy_feat_h1(p, gtid, gsize);
}
__device__ __forceinline__ void ph_pro_b(const P& p, int gtid, int gsize) {
  for (int it = gtid; it < DEPTH * NMOD * 6 * DM; it += gsize) {
    int j = it % (6 * DM), r = (it / (6 * DM)) % NMOD, l = it / (6 * DM * NMOD);
    const float* w = p.ada_w + (size_t)l * DM * 6 * DM + j;
    const float* sv = p.scv + r * DM;
    float acc = 0.f;
    for (int k = 0; k < DM; ++k) acc += sv[k] * w[(size_t)k * 6 * DM];
    p.modtab[it] = acc + p.ada_b[l * 6 * DM + j];
  }
  const int per_l = (SEQ + CTX) * 64;
  for (int it = gtid; it < DEPTH * per_l; it += gsize) {
    int l = it / per_l, r = it % per_l;
    int j = r % 64; r /= 64;
    int seg = r < SEQ ? 0 : 1, i = r < SEQ ? r : r - SEQ;
    const float* h1 = p.hyh1 + ((size_t)(l * 2 + seg) * SEQ + i) * 64;
    const float* w2 = p.hy_w2 + (size_t)l * 64 * 64;
    float acc = 0.f;
    for (int k = 0; k < 64; ++k) acc += h1[k] * w2[k * 64 + j];
    p.hyh2[((size_t)(l * 2 + seg) * SEQ + i) * 64 + j] = sinf(p.hy_freq[l * 64 + j] * (acc + p.hy_b2[l * 64 + j]));
  }
}
__device__ __forceinline__ void ph_pro_c(const P& p, int gtid, int gsize) {
  const int per_l = 2 * (2 * SEQ + 2 * CTX) * GW;
  const float max_decay = -4.605170185988091f / 0.3f, min_decay = -4.605170185988091f / 1.5f;
  for (int it = gtid; it < DEPTH * per_l; it += gsize) {
    int l = it / per_l, r = it % per_l;
    int c = r % GW; r /= GW;
    int ord = r & 1; r >>= 1;
    int seg, idx, L;
    if (r < 2 * SEQ) { seg = 0; idx = r; L = SEQ; } else { seg = 1; idx = r - 2 * SEQ; L = CTX; }
    int d = idx - L;
    float val = 0.f;
    if (idx != 0) {
      int i = d < 0 ? -d : d;
      float ti = (float)i / (float)(L - 1);
      float delta = fabsf(min_decay + (float)c * ((max_decay - min_decay) / (float)(GW - 1)));
      float win = expf(-ti * delta);
      const float* h2 = p.hyh2 + ((size_t)(l * 2 + seg) * SEQ + i) * 64;
      const float* w3 = p.hy_w3 + (size_t)l * 64 * 4 * GW;
      float af = 0.f, ab = 0.f;
      for (int k = 0; k < 64; ++k) {
        float hv = h2[k];
        af += hv * w3[k * 4 * GW + 0 * 2 * GW + ord * GW + c];
        ab += hv * w3[k * 4 * GW + 1 * 2 * GW + ord * GW + c];
      }
      if (d > 0) val = af * win;
      else if (d < 0) val = ab * win;
      else val = (af + ab) * win + p.hy_d[(l * 2 + ord) * GW + c];
    }
    float* kf = seg == 0 ? p.kf_lat + ((size_t)(l * 2 + ord) * 2 * SEQ + idx) * GW : p.kf_ctx + ((size_t)(l * 2 + ord) * 2 * CTX + idx) * GW;
    kf[c] = val;
    if (seg == 0) p.kt_lat[((size_t)(l * 2 + ord) * GW + c) * 2 * SEQ + idx] = f2bf(val);
    else p.kt_ctx[((size_t)(l * 2 + ord) * GW + c) * 2 * CTX + idx] = f2bf(val);
  }
}

#define NV (DM / WL)
__device__ __forceinline__ void ln_inplace(float* v, int lane) {
  float s = 0.f;
#pragma unroll
  for (int i = 0; i < NV; ++i) s += v[i];
  s = wave_sum(s);
  float mu = s * (1.0f / DM);
  float q = 0.f;
#pragma unroll
  for (int i = 0; i < NV; ++i) { float d = v[i] - mu; q += d * d; }
  q = wave_sum(q);
  float rs = 1.0f / sqrtf(q * (1.0f / DM) + 1e-5f);
#pragma unroll
  for (int i = 0; i < NV; ++i) v[i] = (v[i] - mu) * rs;
}
__device__ __forceinline__ void ph_ln0(const P& p, int l, int s, int gtid, int gsize) {
  const int lane = gtid % WL, gw = gtid / WL, nw = gsize / WL;
  if (gtid == 0) *p.ctr = 0;
  for (int row = gw; row < RS; row += nw) {
    int bl = row / RPB, pp = row % RPB, b = s * SB + bl;
    const float* xr = xsrc_row(p, l, b, pp);
    const float* mod = p.modtab + ((size_t)l * NMOD + (pp < CTX ? NB : b)) * 6 * DM;
    float v[NV];
#pragma unroll
    for (int i = 0; i < NV; ++i) v[i] = xr[i * WL + lane];
    ln_inplace(v, lane);
#pragma unroll
    for (int i = 0; i < NV; ++i) {
      int k = i * WL + lane;
      p.U[(size_t)row * DM + k] = f2bf(v[i] * (1.0f + mod[DM + k]) + mod[k]);
    }
  }
}
__device__ __forceinline__ void ph_ln1(const P& p, int l, int s, int gtid, int gsize) {
  const int lane = gtid % WL, gw = gtid / WL, nw = gsize / WL;
  const bool last = (l == DEPTH - 1);
  for (int row = gw; row < RS; row += nw) {
    int bl = row / RPB, pp = row % RPB, b = s * SB + bl;
    if (last && pp < CTX) continue;
    const float* xr = xsrc_row(p, l, b, pp);
    float* xd = xdst_row(p, b, pp);
    const float* mod = p.modtab + ((size_t)l * NMOD + (pp < CTX ? NB : b)) * 6 * DM;
    const float* o = p.OUTF + (size_t)row * DM;
    float v[NV];
#pragma unroll
    for (int i = 0; i < NV; ++i) { int k = i * WL + lane; v[i] = ALPHA * xr[k] + mod[2 * DM + k] * o[k]; }
    ln_inplace(v, lane);
#pragma unroll
    for (int i = 0; i < NV; ++i) { int k = i * WL + lane; v[i] = v[i] * p.ln1g[l * DM + k] + p.ln1b[l * DM + k]; xd[k] = v[i]; }
    ln_inplace(v, lane);
#pragma unroll
    for (int i = 0; i < NV; ++i) {
      int k = i * WL + lane;
      p.U[(size_t)row * DM + k] = f2bf(v[i] * (1.0f + mod[4 * DM + k]) + mod[3 * DM + k]);
    }
  }
}
__device__ __forceinline__ void ph_ln2(const P& p, int l, int s, int gtid, int gsize) {
  const int lane = gtid % WL, gw = gtid / WL, nw = gsize / WL;
  const bool last = (l == DEPTH - 1);
  for (int row = gw; row < RS; row += nw) {
    int bl = row / RPB, pp = row % RPB, b = s * SB + bl;
    if (last && pp < CTX) continue;
    float* xd = xdst_row(p, b, pp);
    const float* mod = p.modtab + ((size_t)l * NMOD + (pp < CTX ? NB : b)) * 6 * DM;
    const float* o = p.OUTF + (size_t)row * DM;
    float v[NV];
#pragma unroll
    for (int i = 0; i < NV; ++i) { int k = i * WL + lane; v[i] = ALPHA * xd[k] + mod[5 * DM + k] * o[k]; }
    ln_inplace(v, lane);
#pragma unroll
    for (int i = 0; i < NV; ++i) { int k = i * WL + lane; xd[k] = v[i] * p.ln2g[l * DM + k] + p.ln2b[l * DM + k]; }
  }
}

#ifndef CPU_EMU
typedef short bf16x8 __attribute__((ext_vector_type(8)));
typedef float f32x4 __attribute__((ext_vector_type(4)));
typedef unsigned u32x4 __attribute__((ext_vector_type(4)));
__device__ __forceinline__ f32x4 mfma16(bf16x8 a, bf16x8 b, f32x4 c) { return __builtin_amdgcn_mfma_f32_16x16x32_bf16(a, b, c, 0, 0, 0); }
#define GBM 128
#define GBN 128
#define GBK 64
#define GLD (GBK + 8)
template <bool OUT_BF16>
__device__ __forceinline__ void gemm_phase(const bf16_t* __restrict__ A, const bf16_t* __restrict__ Bt, void* __restrict__ Cv, int M, int N, int K, int ldc,
                           bool skip_ctx, bf16_t* lds, int tid) {
  bf16_t* sA = lds;
  bf16_t* sB = lds + GBM * GLD;
  const int lane = tid & 63, wave = tid >> 6;
  const int wm = wave >> 1, wn = wave & 1;
  const int ntm = M / GBM, ntn = N / GBN;
  const int KT = K / GBK;
  const int lr = lane & 15, lq = lane >> 4;
  for (int tile = blockIdx.x; tile < ntm * ntn; tile += gridDim.x) {
    const int tm = tile / ntn, tn = tile % ntn;
    if (skip_ctx && (tm % (RPB / GBM)) < (CTX / GBM)) continue;
    const int m0 = tm * GBM, n0 = tn * GBN;
    f32x4 acc[4][4];
#pragma unroll
    for (int i = 0; i < 4; ++i)
#pragma unroll
      for (int j = 0; j < 4; ++j) acc[i][j] = (f32x4){0.f, 0.f, 0.f, 0.f};
    u32x4 ra[4], rb[4];
#pragma unroll
    for (int i = 0; i < 4; ++i) {
      int id = tid + i * 256, r = id >> 3, ch = id & 7;
      ra[i] = *(const u32x4*)(A + (size_t)(m0 + r) * K + ch * 8);
      rb[i] = *(const u32x4*)(Bt + (size_t)(n0 + r) * K + ch * 8);
    }
    for (int kt = 0; kt < KT; ++kt) {
      __syncthreads();
#pragma unroll
      for (int i = 0; i < 4; ++i) {
        int id = tid + i * 256, r = id >> 3, ch = id & 7;
        *(u32x4*)(sA + r * GLD + ch * 8) = ra[i];
        *(u32x4*)(sB + r * GLD + ch * 8) = rb[i];
      }
      __syncthreads();
      if (kt + 1 < KT) {
#pragma unroll
        for (int i = 0; i < 4; ++i) {
          int id = tid + i * 256, r = id >> 3, ch = id & 7;
          ra[i] = *(const u32x4*)(A + (size_t)(m0 + r) * K + (kt + 1) * GBK + ch * 8);
          rb[i] = *(const u32x4*)(Bt + (size_t)(n0 + r) * K + (kt + 1) * GBK + ch * 8);
        }
      }
#pragma unroll
      for (int kk = 0; kk < GBK; kk += 32) {
        bf16x8 fa[4], fb[4];
#pragma unroll
        for (int i = 0; i < 4; ++i) fa[i] = *(const bf16x8*)(sA + (wm * 64 + i * 16 + lr) * GLD + kk + lq * 8);
#pragma unroll
        for (int j = 0; j < 4; ++j) fb[j] = *(const bf16x8*)(sB + (wn * 64 + j * 16 + lr) * GLD + kk + lq * 8);
#pragma unroll
        for (int i = 0; i < 4; ++i)
#pragma unroll
          for (int j = 0; j < 4; ++j) acc[i][j] = __builtin_amdgcn_mfma_f32_16x16x32_bf16(fb[j], fa[i], acc[i][j], 0, 0, 0);
      }
    }
#pragma unroll
    for (int i = 0; i < 4; ++i)
#pragma unroll
      for (int j = 0; j < 4; ++j) {
        size_t off = (size_t)(m0 + wm * 64 + i * 16 + lr) * ldc + n0 + wn * 64 + j * 16 + lq * 4;
        if (OUT_BF16) {
          uint2 o;
          o.x = pack_bf16(acc[i][j][0], acc[i][j][1]);
          o.y = pack_bf16(acc[i][j][2], acc[i][j][3]);
          *(uint2*)((bf16_t*)Cv + off) = o;
        } else {
          *(float4*)((float*)Cv + off) = make_float4(acc[i][j][0], acc[i][j][1], acc[i][j][2], acc[i][j][3]);
        }
      }
  }
}
#else
template <bool OUT_BF16>
void gemm_phase(const bf16_t* A, const bf16_t* Bt, void* Cv, int M, int N, int K, int ldc, bool skip_ctx, bf16_t* lds, int tid) {
  int gtid = blockIdx.x * blockDim.x + threadIdx.x, gsize = gridDim.x * blockDim.x;
  for (long it = gtid; it < (long)M * N; it += gsize) {
    int m = (int)(it / N), n = (int)(it % N);
    if (skip_ctx && (m % RPB) < CTX) continue;
    float acc = 0.f;
    for (int k = 0; k < K; ++k) acc += bf2f(A[(size_t)m * K + k]) * bf2f(Bt[(size_t)n * K + k]);
    if (OUT_BF16) ((bf16_t*)Cv)[(size_t)m * ldc + n] = f2bf(acc);
    else ((float*)Cv)[(size_t)m * ldc + n] = acc;
  }
}
#endif

#define PJ(row, col) bf2f(p.PROJ[(size_t)(row) * LDP + (col)])
template <int ORD>
__device__ __forceinline__ void hyena_conv_item(const P& p, int l, int it) {
  const bool need_ctx = (l != DEPTH - 1);
  const int ntb = (need_ctx ? CTX / 16 : 0) + SEQ / 16;
  int c = it % GW, r = it / GW;
  int tb = r % ntb, bl = r / ntb;
  int seg0, L, t0;
  const float* kf;
  if (need_ctx && tb < CTX / 16) { seg0 = 0; L = CTX; t0 = tb * 16; kf = p.kf_ctx + (size_t)(l * 2 + ORD) * 2 * CTX * GW; }
  else { int tb2 = tb - (need_ctx ? CTX / 16 : 0); seg0 = CTX; L = SEQ; t0 = tb2 * 16; kf = p.kf_lat + (size_t)(l * 2 + ORD) * 2 * SEQ * GW; }
  const int rowbase = bl * RPB + seg0;
  const float* cw = p.hy_cw + (size_t)l * 3 * 3 * GW;
  const float* cb = p.hy_cb + (size_t)l * 3 * GW;
  float acc[16], F[31], u[16];
#pragma unroll
  for (int i = 0; i < 16; ++i) acc[i] = 0.f;
#pragma unroll
  for (int m = 0; m < 15; ++m) F[m] = kf[(size_t)(L + t0 + 1 + m) * GW + c];
  const float w0 = cw[0 * 3 * GW + c], w1 = cw[1 * 3 * GW + c], w2 = cw[2 * 3 * GW + c], bb = cb[c];
  float nF[16], nin[18];
  auto fetch = [&](int s0) {
#pragma unroll
    for (int m = 0; m < 16; ++m) nF[m] = kf[(size_t)(L + t0 - s0 - 15 + m) * GW + c];
    if (ORD == 0) {
#pragma unroll
      for (int j = 0; j < 18; ++j) {
        int sp = s0 - 1 + j;
        nin[j] = (sp >= 0 && sp < L) ? PJ(rowbase + sp, OFF_HY + c) : 0.f;
      }
    } else {
#pragma unroll
      for (int j = 0; j < 16; ++j) nin[j] = p.Z2[(size_t)(rowbase + s0 + j) * GW + c];
    }
  };
  fetch(0);
  for (int s0 = 0; s0 < L; s0 += 16) {
#pragma unroll
    for (int m = 14; m >= 0; --m) F[m + 16] = F[m];
#pragma unroll
    for (int m = 0; m < 16; ++m) F[m] = nF[m];
    if (ORD == 0) {
#pragma unroll
      for (int j = 0; j < 16; ++j) u[j] = w0 * nin[j] + w1 * nin[j + 1] + w2 * nin[j + 2] + bb;
    } else {
#pragma unroll
      for (int j = 0; j < 16; ++j) u[j] = nin[j];
    }
    if (s0 + 16 < L) fetch(s0 + 16);
#pragma unroll
    for (int j = 0; j < 16; ++j)
#pragma unroll
      for (int i = 0; i < 16; ++i) acc[i] += F[i - j + 15] * u[j];
  }
  const int xc = (ORD == 0 ? GW : 2 * GW) + c;
  const float v0 = cw[0 * 3 * GW + xc], v1 = cw[1 * 3 * GW + xc], v2 = cw[2 * 3 * GW + xc], vb = cb[xc];
#pragma unroll
  for (int i = 0; i < 16; ++i) {
    int t = t0 + i;
    float xm = t > 0 ? PJ(rowbase + t - 1, OFF_HY + xc) : 0.f;
    float x0 = PJ(rowbase + t, OFF_HY + xc);
    float xp = t < L - 1 ? PJ(rowbase + t + 1, OFF_HY + xc) : 0.f;
    float g = v0 * xm + v1 * x0 + v2 * xp + vb;
    float o = g * acc[i];
    if (ORD == 0) p.Z2[(size_t)(rowbase + t) * GW + c] = o;
    else p.HY[(size_t)(rowbase + t) * GW + c] = o;
  }
}
__device__ __forceinline__ int hyena_items(int l) { return SB * ((l != DEPTH - 1 ? CTX / 16 : 0) + SEQ / 16) * GW; }

#if SB == 8
#define HC_KOFF (SEQ + 32)
#define HC_KLEN (2 * SEQ + 64)
#define HC_ULS ((SEQ / 16 + 4) * 16)
template <int ORD>
__device__ __forceinline__ void hyena_mfma_item(const P& p, int l, int item, bf16_t* lds, int tid) {
  const int c = item % GW, seg = item / GW;
  const int L = seg ? CTX : SEQ, seg0 = seg ? 0 : CTX, NTB = L / 16;
  const bf16_t* kt = (seg ? p.kt_ctx + ((size_t)(l * 2 + ORD) * GW + c) * 2 * CTX : p.kt_lat + ((size_t)(l * 2 + ORD) * GW + c) * 2 * SEQ);
  bf16_t* KL = lds;
  bf16_t* UL = lds + HC_KLEN;
  const float* cw = p.hy_cw + (size_t)l * 3 * 3 * GW;
  const float* cb = p.hy_cb + (size_t)l * 3 * GW;
  __syncthreads();
  for (int n = -(L + 32) + tid; n < L + 32; n += 256) KL[HC_KOFF + n] = (n > -L && n < L) ? kt[L - n] : (bf16_t)0;
  for (int q = tid; q < SB * 4; q += 256) {
    int b = q >> 2, w = q & 3;
    bf16_t* dst = UL + b * HC_ULS + (w < 2 ? w * 16 : (NTB + w) * 16);
    for (int j = 0; j < 16; ++j) dst[j] = 0;
  }
  {
    const float w0 = cw[0 * 3 * GW + c], w1 = cw[1 * 3 * GW + c], w2 = cw[2 * 3 * GW + c], bb = cb[c];
    for (int q = tid; q < SB * (L / 8); q += 256) {
      const int b = q / (L / 8), s8 = (q % (L / 8)) * 8;
      const int row = b * RPB + seg0 + s8;
      float u[8];
      if (ORD == 0) {
        float raw[10];
#pragma unroll
        for (int j = 0; j < 10; ++j) { int sp = s8 - 1 + j; raw[j] = (sp >= 0 && sp < L) ? PJ(row - 1 + j, OFF_HY + c) : 0.f; }
#pragma unroll
        for (int j = 0; j < 8; ++j) u[j] = w0 * raw[j] + w1 * raw[j + 1] + w2 * raw[j + 2] + bb;
      } else {
#pragma unroll
        for (int j = 0; j < 8; ++j) u[j] = p.Z2[(size_t)(row + j) * GW + c];
      }
      unsigned* dst = (unsigned*)(UL + b * HC_ULS + 32 + s8);
#pragma unroll
      for (int j = 0; j < 4; ++j) dst[j] = pack_bf16(u[2 * j], u[2 * j + 1]);
    }
  }
  __syncthreads();
  const int lane = tid & 63, wave = tid >> 6;
  const int ti = lane & 15, q4 = lane >> 4;
  const int NT = NTB / 2, TPW = NT / 4;
  const int T0 = wave * TPW * 2;
  f32x4 acc[16];
#pragma unroll
  for (int m = 0; m < 16; ++m) acc[m] = (f32x4){0.f, 0.f, 0.f, 0.f};
  const int nK = NTB / 2 + TPW;
  const int colb = (lane & 7) * HC_ULS + (q4 & 1) * 8;
  const int tbsel = (lane >> 3) & 1;
  for (int k = 0; k < nK; ++k) {
    const int dl = T0 - NTB + 2 * k + (q4 >> 1);
    const int nb = HC_KOFF - 16 * dl - ti + 8 * (q4 & 1);
    bf16x8 A;
#pragma unroll
    for (int j = 0; j < 8; ++j) A[j] = (short)KL[nb + j];
#pragma unroll
    for (int m = 0; m < 16; ++m) {
      if (m < TPW && k >= m && k <= m + NTB / 2) {
        const int sb = T0 + 2 * m + tbsel - dl;
        const bf16x8 B = *(const bf16x8*)(UL + colb + (sb + 2) * 16);
        acc[m] = mfma16(A, B, acc[m]);
      }
    }
  }
  const int xc = (ORD == 0 ? GW : 2 * GW) + c;
  const float v0 = cw[0 * 3 * GW + xc], v1 = cw[1 * 3 * GW + xc], v2 = cw[2 * 3 * GW + xc], vb = cb[xc];
  const int bn = lane & 7;
#pragma unroll
  for (int m = 0; m < 16; ++m) {
    if (m < TPW) {
      const int t0 = 16 * (T0 + 2 * m + tbsel) + q4 * 4;
      const int row = bn * RPB + seg0 + t0;
      float raw[6];
#pragma unroll
      for (int j = 0; j < 6; ++j) { int tp = t0 - 1 + j; raw[j] = (tp >= 0 && tp < L) ? PJ(row - 1 + j, OFF_HY + xc) : 0.f; }
#pragma unroll
      for (int r = 0; r < 4; ++r) {
        float g = v0 * raw[r] + v1 * raw[r + 1] + v2 * raw[r + 2] + vb;
        float o = g * acc[m][r];
        if (ORD == 0) p.Z2[(size_t)(row + r) * GW + c] = o;
        else p.HY[(size_t)(row + r) * GW + c] = o;
      }
    }
  }
}
__device__ __forceinline__ int hyena_mfma_items(int l) { return (l != DEPTH - 1 ? 2 : 1) * GW; }
#endif


__device__ __forceinline__ float rw_shift(const P& p, int l, int row, int pp, int j) {
  float x = PJ(row, OFF_RW + j);
  float xp = has_prev(pp) ? PJ(row - 1, OFF_RW + j) : 0.f;
  float xn = has_next(pp) ? PJ(row + 1, OFF_RW + j) : 0.f;
  return x + p.rw_mu[(size_t)(l * 2 + 0) * RWSH + j] * (xp - x) + p.rw_mu[(size_t)(l * 2 + 1) * RWSH + j] * (xn - x);
}
__device__ __forceinline__ void ph_prep(const P& p, int l, int s, int gtid, int gsize, float* lds, int tid) {
  for (int it = gtid; it < RS * 2 * GW; it += gsize) {
    int j = it % (2 * GW), row = it / (2 * GW), pp = row % RPB;
    const float* cw = p.ml_cw + (size_t)l * 3 * 2 * GW;
    float xm = has_prev(pp) ? PJ(row - 1, OFF_ML + j) : 0.f;
    float x0 = PJ(row, OFF_ML + j);
    float xp = has_next(pp) ? PJ(row + 1, OFF_ML + j) : 0.f;
    float v = cw[j] * xm + cw[2 * GW + j] * x0 + cw[4 * GW + j] * xp + p.ml_cb[l * 2 * GW + j];
    v = siluf_(v);
    if (j < GW) v *= 0.125f;
    p.MQK[(size_t)row * 2 * GW + j] = v;
  }
  for (int it = gtid; it < RS * 4 * NH; it += gsize) {
    int gj = it % (4 * NH), row = it / (4 * NH);
    float g = PJ(row, OFF_ML + 4 * GW + gj) + p.ml_gb[l * 4 * NH + gj];
    if ((gj / NH) & 1) g = logsigmoidf_(g);
    p.MG[(size_t)row * 4 * NH + gj] = g;
  }
  for (int it = gtid; it < RS * 2 * GW; it += gsize) {
    int j = it % (2 * GW), row = it / (2 * GW), pp = row % RPB;
    int which = j / GW, c = j % GW, dd = c % HD, hb = c - dd;
    int base = OFF_RT + which * GW;
    float x = PJ(row, base + c), o = x;
    if (pp >= CTX) {
      int t = pp - CTX, ri = t / GRIDW, ci = t % GRIDW;
      int half = dd / 32, e = dd % 32, pr = e % 16;
      bool first = e < 16;
      float pos = (float)(half ? ci : ri);
      float fr = powf(10000.0f, -(float)pr / 16.0f);
      float a = pos * fr;
      float xo = PJ(row, base + hb + (first ? dd + 16 : dd - 16));
      float cs = cosf(a), sn = sinf(a);
      o = first ? x * cs - xo * sn : x * cs + xo * sn;
    }
    if (which == 0) o *= 0.125f;
    p.RQK[(size_t)row * 2 * GW + j] = o;
  }
  {
    float* zs = lds;
    float* part = lds + 8 * RWSH;
    const size_t AS = (size_t)RS * GW;
    for (int tile = blockIdx.x; tile < RS / 8; tile += gridDim.x) {
      const int row0 = tile * 8;
      __syncthreads();
      for (int idx = tid; idx < 8 * RWSH; idx += 256) {
        int r = idx / RWSH, j = idx % RWSH, row = row0 + r;
        float z = rw_shift(p, l, row, row % RPB, j);
        if (j >= 3 * GW && j < 3 * GW + 32) z = tanhf(z);
        else if (j >= 3 * GW + 64) z = sigmoidf_(z);
        zs[idx] = z;
      }
      __syncthreads();
      {
        int pr = tid >> 3, sub = tid & 7;
        if (pr < 8 * NH) {
          int r = pr / NH, h = pr % NH;
          float ss = 0.f, bs = 0.f;
          for (int i = sub * 8; i < sub * 8 + 8; ++i) {
            float kv = zs[r * RWSH + GW + h * HD + i], rv = zs[r * RWSH + h * HD + i];
            float kk = kv * p.rw_kk[l * GW + h * HD + i];
            ss += kk * kk;
            bs += rv * kv * p.rw_rk[(l * NH + h) * HD + i];
          }
          part[pr * 8 + sub] = ss;
          part[256 + pr * 8 + sub] = bs;
        }
      }
      __syncthreads();
      for (int c = tid; c < GW; c += 256) {
        const int h = c / HD;
        float wa0[8], wa1[8], aa0[8], aa1[8], gg[8];
#pragma unroll
        for (int r = 0; r < 8; ++r) { wa0[r] = 0.f; wa1[r] = 0.f; aa0[r] = 0.f; aa1[r] = 0.f; gg[r] = 0.f; }
#pragma nounroll
        for (int i = 0; i < 32; ++i) {
          float w20 = p.rw_w2[((size_t)(l * 2 + 0) * 32 + i) * GW + c], w21 = p.rw_w2[((size_t)(l * 2 + 1) * 32 + i) * GW + c];
          float a20 = p.rw_a2[((size_t)(l * 2 + 0) * 32 + i) * GW + c], a21 = p.rw_a2[((size_t)(l * 2 + 1) * 32 + i) * GW + c];
#pragma unroll
          for (int r = 0; r < 8; ++r) {
            float tw = zs[r * RWSH + 3 * GW + i], al = zs[r * RWSH + 3 * GW + 32 + i];
            wa0[r] = fmaf(tw, w20, wa0[r]); wa1[r] = fmaf(tw, w21, wa1[r]);
            aa0[r] = fmaf(al, a20, aa0[r]); aa1[r] = fmaf(al, a21, aa1[r]);
          }
        }
#pragma nounroll
        for (int j = 0; j < 64; ++j) {
          float g2 = p.rw_g2[((size_t)l * 64 + j) * GW + c];
#pragma unroll
          for (int r = 0; r < 8; ++r) gg[r] = fmaf(zs[r * RWSH + 3 * GW + 64 + j], g2, gg[r]);
        }
        const float ka = p.rw_ka[l * GW + c], kks = p.rw_kk[l * GW + c];
        const float w00 = p.rw_w0[(l * 2 + 0) * GW + c], w01 = p.rw_w0[(l * 2 + 1) * GW + c];
        const float a00 = p.rw_a0[(l * 2 + 0) * GW + c], a01 = p.rw_a0[(l * 2 + 1) * GW + c];
#pragma unroll
        for (int r = 0; r < 8; ++r) {
          const int pr = r * NH + h;
          float ss = 0.f, bs = 0.f;
#pragma unroll
          for (int u = 0; u < 8; ++u) { ss += part[pr * 8 + u]; bs += part[256 + pr * 8 + u]; }
          const float rr = zs[r * RWSH + c], k = zs[r * RWSH + GW + c], v = zs[r * RWSH + 2 * GW + c];
          const float kkv = k * kks / sqrtf(ss + 1e-12f);
          const size_t o = (size_t)(row0 + r) * GW + c;
          p.RW[0 * AS + o] = rr;
          p.RW[1 * AS + o] = kkv;
          p.BON[o] = bs * v;
          p.GG[o] = gg[r];
#pragma unroll
          for (int d = 0; d < 2; ++d) {
            float wpre = (d ? w01 : w00) + (d ? wa1[r] : wa0[r]);
            float decay = expf(-expf(-softplusf_(-wpre) - 0.5f));
            float a = sigmoidf_((d ? a01 : a00) + (d ? aa1[r] : aa0[r]));
            p.RW[(2 + d) * AS + o] = decay;
            p.RW[(4 + d) * AS + o] = k * (1.0f + (a - 1.0f) * ka);
            p.RW[(6 + d) * AS + o] = kkv * a;
          }
        }
      }
    }
    __syncthreads();
  }
#if SB == 8
  for (int it = blockIdx.x; it < hyena_mfma_items(l); it += gridDim.x) hyena_mfma_item<0>(p, l, it, (bf16_t*)lds, tid);
  __syncthreads();
#else
  for (int it = gtid; it < hyena_items(l); it += gsize) hyena_conv_item<0>(p, l, it);
#endif
}

__device__ __forceinline__ int scan_pos(int dir, int step) {
  if (!dir) return step;
  return step < CTX ? CTX - 1 - step : RPB - 1 - (step - CTX);
}
#ifndef CPU_EMU
__device__ __forceinline__ float quad_sum(float v) {
  v += __int_as_float(__builtin_amdgcn_mov_dpp(__float_as_int(v), 0xB1, 0xF, 0xF, true));
  v += __int_as_float(__builtin_amdgcn_mov_dpp(__float_as_int(v), 0x4E, 0xF, 0xF, true));
  return v;
}
#endif
#define SCT 16
#define NCHUNK (RPB / SCT)
#ifndef CPU_EMU
typedef float f4 __attribute__((ext_vector_type(4)));
typedef unsigned u2v __attribute__((ext_vector_type(2)));
__device__ __forceinline__ f4 ld4(const float* a) { return *(const f4*)a; }
__device__ __forceinline__ void st4(float* a, f4 v) { *(f4*)a = v; }
__device__ __forceinline__ f4 ldbf4(const bf16_t* a) {
  u2v u = *(const u2v*)a;
  f4 r;
  r.x = __uint_as_float(u.x << 16); r.y = __uint_as_float(u.x & 0xffff0000u);
  r.z = __uint_as_float(u.y << 16); r.w = __uint_as_float(u.y & 0xffff0000u);
  return r;
}
#else
struct f4 { float x, y, z, w; };
__device__ __forceinline__ f4 ld4(const float* a) { f4 r; r.x = a[0]; r.y = a[1]; r.z = a[2]; r.w = a[3]; return r; }
__device__ __forceinline__ void st4(float* a, f4 v) { a[0] = v.x; a[1] = v.y; a[2] = v.z; a[3] = v.w; }
__device__ __forceinline__ f4 ldbf4(const bf16_t* a) { f4 r; r.x = bf2f(a[0]); r.y = bf2f(a[1]); r.z = bf2f(a[2]); r.w = bf2f(a[3]); return r; }
#endif
__device__ __forceinline__ void ld16(float* dst, const float* src) {
#pragma unroll
  for (int j = 0; j < 4; ++j) { f4 v = ld4(src + 4 * j); dst[4 * j] = v.x; dst[4 * j + 1] = v.y; dst[4 * j + 2] = v.z; dst[4 * j + 3] = v.w; }
}

__device__ __forceinline__ void bscan_rwkv(const P& p, int l, int bl, int h, int dir, float* lds, int tid) {
  const int i = tid >> 2, kq = tid & 3, st = tid >> 4, sp = tid & 15;
  float S[16];
#pragma unroll
  for (int d = 0; d < 16; ++d) S[d] = 0.f;
  float* H = dir ? p.HB : p.HF;
  const size_t AS = (size_t)RS * GW;
  const int vc = 2 * GW + h * HD + sp * 4;
  const f4 mu0 = ld4(p.rw_mu + (size_t)(l * 2 + 0) * RWSH + vc), mu1 = ld4(p.rw_mu + (size_t)(l * 2 + 1) * RWSH + vc);
  f4 rg[5], rv;
  auto load = [&](int c) {
    const int pp = scan_pos(dir, c * SCT + st), row = bl * RPB + pp;
    const size_t o = (size_t)row * GW + h * HD + sp * 4;
    rg[0] = ld4(p.RW + 0 * AS + o);
    rg[1] = ld4(p.RW + 1 * AS + o);
    rg[2] = ld4(p.RW + (size_t)(2 + dir) * AS + o);
    rg[3] = ld4(p.RW + (size_t)(4 + dir) * AS + o);
    rg[4] = ld4(p.RW + (size_t)(6 + dir) * AS + o);
    const bf16_t* pr = p.PROJ + (size_t)row * LDP + OFF_RW + vc;
    f4 x = ldbf4(pr), xm = x, xp = x;
    xm.x = xm.y = xm.z = xm.w = 0.f; xp = xm;
    if (has_prev(pp)) xm = ldbf4(pr - LDP);
    if (has_next(pp)) xp = ldbf4(pr + LDP);
    rv.x = x.x + mu0.x * (xm.x - x.x) + mu1.x * (xp.x - x.x);
    rv.y = x.y + mu0.y * (xm.y - x.y) + mu1.y * (xp.y - x.y);
    rv.z = x.z + mu0.z * (xm.z - x.z) + mu1.z * (xp.z - x.z);
    rv.w = x.w + mu0.w * (xm.w - x.w) + mu1.w * (xp.w - x.w);
  };
  load(0);
  for (int c = 0; c < NCHUNK; ++c) {
    __syncthreads();
#pragma unroll
    for (int a = 0; a < 5; ++a) st4(lds + (st * 6 + a) * 64 + sp * 4, rg[a]);
    st4(lds + (st * 6 + 5) * 64 + sp * 4, rv);
    __syncthreads();
    if (c + 1 < NCHUNK) load(c + 1);
#pragma nounroll
    for (int t = 0; t < SCT; ++t) {
      const float* L = lds + t * 6 * 64 + kq * 16;
      const float vv = lds[(t * 6 + 5) * 64 + i];
      float a_r[16], a_k[16], a_w[16], a_d[16], a_b[16];
      ld16(a_k, L + 1 * 64);
      ld16(a_w, L + 2 * 64);
      ld16(a_d, L + 3 * 64);
      ld16(a_b, L + 4 * 64);
      ld16(a_r, L + 0 * 64);
      float sa = 0.f;
#pragma unroll
      for (int d = 0; d < 16; ++d) sa = fmaf(S[d], a_k[d], sa);
      sa = -quad_sum(sa);
      float y = 0.f;
#pragma unroll
      for (int d = 0; d < 16; ++d) {
        S[d] = fmaf(S[d], a_w[d], fmaf(sa, a_b[d], vv * a_d[d]));
        y = fmaf(S[d], a_r[d], y);
      }
      y = quad_sum(y);
      if (kq == 0) {
        const int row = bl * RPB + scan_pos(dir, c * SCT + t);
        H[(size_t)row * 3 * GW + 2 * GW + h * HD + i] = y;
      }
    }
  }
}
__device__ __forceinline__ void bscan_mlstm(const P& p, int bl, int h, int dir, float* lds, int tid) {
  const int i = tid >> 2, kq = tid & 3, st = tid >> 4, sp = tid & 15;
  float C[16], n[16];
#pragma unroll
  for (int d = 0; d < 16; ++d) { C[d] = 0.f; n[d] = 0.f; }
  float m = 0.f;
  float* H = dir ? p.HB : p.HF;
  f4 rq, rk, rv;
  float g0 = 0.f, g1 = 0.f;
  auto load = [&](int c) {
    const int pp = scan_pos(dir, c * SCT + st), row = bl * RPB + pp;
    const float* q = p.MQK + (size_t)row * 2 * GW + h * HD + sp * 4;
    rq = ld4(q);
    rk = ld4(q + GW);
    rv = ldbf4(p.PROJ + (size_t)row * LDP + OFF_ML + 2 * GW + h * HD + sp * 4);
    if (sp == 0) {
      const float* mg = p.MG + (size_t)row * 4 * NH;
      g0 = mg[(dir ? 2 : 0) * NH + h];
      g1 = mg[(dir ? 3 : 1) * NH + h];
    }
  };
  load(0);
  for (int c = 0; c < NCHUNK; ++c) {
    __syncthreads();
    st4(lds + (st * 4 + 0) * 64 + sp * 4, rq);
    st4(lds + (st * 4 + 1) * 64 + sp * 4, rk);
    st4(lds + (st * 4 + 2) * 64 + sp * 4, rv);
    if (sp == 0) { lds[(st * 4 + 3) * 64 + 0] = g0; lds[(st * 4 + 3) * 64 + 1] = g1; }
    __syncthreads();
    if (c + 1 < NCHUNK) load(c + 1);
#pragma nounroll
    for (int t = 0; t < SCT; ++t) {
      const float* L = lds + t * 4 * 64;
      const float ig = L[3 * 64 + 0], lf = L[3 * 64 + 1];
      const float mn = fmaxf(lf + m, ig);
      const float f = expf(lf + m - mn), ii = expf(ig - mn);
      m = mn;
      const float iv = ii * L[2 * 64 + i];
      float a_q[16], a_k[16];
      ld16(a_q, L + kq * 16);
      ld16(a_k, L + 64 + kq * 16);
      float num = 0.f, den = 0.f;
#pragma unroll
      for (int d = 0; d < 16; ++d) {
        const float kd = a_k[d], qd = a_q[d];
        C[d] = fmaf(kd, iv, f * C[d]);
        n[d] = fmaf(kd, ii, f * n[d]);
        num = fmaf(qd, C[d], num);
        den = fmaf(qd, n[d], den);
      }
      num = quad_sum(num);
      den = quad_sum(den);
      if (kq == 0) {
        const int row = bl * RPB + scan_pos(dir, c * SCT + t);
        H[(size_t)row * 3 * GW + 0 * GW + h * HD + i] = num / fmaxf(fabsf(den), expf(-m));
      }
    }
  }
}
__device__ __forceinline__ void bscan_ret(const P& p, int bl, int h, int dir, float* lds, int tid) {
  const int i = tid >> 2, kq = tid & 3, st = tid >> 4, sp = tid & 15;
  float S[16];
#pragma unroll
  for (int d = 0; d < 16; ++d) S[d] = 0.f;
  const int hh = dir ? NH - 1 - h : h;
  const float gamma = 1.0f - exp2f(-5.0f - (float)hh);
  float* H = dir ? p.HB : p.HF;
  f4 rq, rk, rv;
  auto load = [&](int c) {
    const int pp = scan_pos(dir, c * SCT + st), row = bl * RPB + pp;
    const float* q = p.RQK + (size_t)row * 2 * GW + h * HD + sp * 4;
    rq = ld4(q);
    rk = ld4(q + GW);
    rv = ldbf4(p.PROJ + (size_t)row * LDP + OFF_RT + 2 * GW + h * HD + sp * 4);
  };
  load(0);
  for (int c = 0; c < NCHUNK; ++c) {
    __syncthreads();
    st4(lds + (st * 4 + 0) * 64 + sp * 4, rq);
    st4(lds + (st * 4 + 1) * 64 + sp * 4, rk);
    st4(lds + (st * 4 + 2) * 64 + sp * 4, rv);
    __syncthreads();
    if (c + 1 < NCHUNK) load(c + 1);
#pragma nounroll
    for (int t = 0; t < SCT; ++t) {
      const float* L = lds + t * 4 * 64;
      const float v = L[2 * 64 + i];
      float a_q[16], a_k[16];
      ld16(a_q, L + kq * 16);
      ld16(a_k, L + 64 + kq * 16);
      float o = 0.f;
#pragma unroll
      for (int d = 0; d < 16; ++d) {
        S[d] = fmaf(S[d], gamma, a_k[d] * v);
        o = fmaf(a_q[d], S[d], o);
      }
      o = quad_sum(o);
      if (kq == 0) {
        const int row = bl * RPB + scan_pos(dir, c * SCT + t);
        H[(size_t)row * 3 * GW + 1 * GW + h * HD + i] = o;
      }
    }
  }
}
#define NSCAN (3 * SB * NH * 2)
__device__ __forceinline__ void ph_scan(const P& p, int l, int s, int gtid, int gsize, float* lds, int tid) {
  for (int w = blockIdx.x; w < NSCAN; w += gridDim.x) {
    int mixer = w / (SB * NH * 2), r = w % (SB * NH * 2);
    int dir = r & 1, h = (r >> 1) % NH, bl = (r >> 1) / NH;
    if (mixer == 0) bscan_rwkv(p, l, bl, h, dir, lds, tid);
    else if (mixer == 1) bscan_mlstm(p, bl, h, dir, lds, tid);
    else bscan_ret(p, bl, h, dir, lds, tid);
    __syncthreads();
  }
#if SB == 8
  {
    int* sh = (int*)lds;
    const int nitem = hyena_mfma_items(l);
    for (;;) {
      __syncthreads();
      if (tid == 0) sh[0] = atomicAdd(p.ctr, 1);
      __syncthreads();
      const int it = sh[0];
      if (it >= nitem) break;
      hyena_mfma_item<1>(p, l, it, (bf16_t*)lds, tid);
    }
  }
#else
  for (int it = gtid; it < hyena_items(l); it += gsize) hyena_conv_item<1>(p, l, it);
#endif
}

__device__ __forceinline__ void ph_fin(const P& p, int l, int s, int gtid, int gsize) {
  const bool last = (l == DEPTH - 1);
  for (int it = gtid; it < RS * 4 * NH * 2; it += gsize) {
    int row = it % RS, q = it / RS, pp = row % RPB;
    if (last && pp < CTX) continue;
    int hg = q % (4 * NH), half = q / (4 * NH);
    int g = hg / NH, h = hg % NH;
    const int c0 = g * GW + h * HD;
    const float *s1, *s2;
    if (g == 1) { s1 = p.HY + (size_t)row * GW + h * HD; s2 = nullptr; }
    else {
      int slot = (g == 0) ? 0 : (g == 2 ? 1 : 2);
      s1 = p.HF + (size_t)row * 3 * GW + slot * GW + h * HD;
      s2 = p.HB + (size_t)row * 3 * GW + slot * GW + h * HD;
    }
    float sum = 0.f;
    for (int i = 0; i < HD; i += 4) {
      f4 v = ld4(s1 + i);
      if (s2) { f4 w = ld4(s2 + i); v.x += w.x; v.y += w.y; v.z += w.z; v.w += w.w; }
      sum += (v.x + v.y) + (v.z + v.w);
    }
    const float mu = sum * (1.0f / HD);
    float qq = 0.f;
    for (int i = 0; i < HD; i += 4) {
      f4 v = ld4(s1 + i);
      if (s2) { f4 w = ld4(s2 + i); v.x += w.x; v.y += w.y; v.z += w.z; v.w += w.w; }
      v.x -= mu; v.y -= mu; v.z -= mu; v.w -= mu;
      qq += (v.x * v.x + v.y * v.y) + (v.z * v.z + v.w * v.w);
    }
    const float rs = 1.0f / sqrtf(qq * (1.0f / HD) + 1e-5f);
    const int i0 = half * 32;
    const float* ng = p.ng + l * DM + c0 + i0;
    const float* nb = p.nb + l * DM + c0 + i0;
    float val[32];
#pragma unroll
    for (int i = 0; i < 32; ++i) {
      float v = s1[i0 + i];
      if (s2) v += s2[i0 + i];
      val[i] = (v - mu) * rs * ng[i] + nb[i];
    }
    bf16_t* y = p.U + (size_t)row * DM + c0 + i0;
    if (g == 0) {
#pragma unroll
      for (int i = 0; i < 32; ++i) val[i] *= sigmoidf_(PJ(row, OFF_ML + 3 * GW + h * HD + i0 + i));
    } else if (g == 2) {
#pragma unroll
      for (int i = 0; i < 32; ++i) val[i] *= siluf_(PJ(row, OFF_RT + 3 * GW + h * HD + i0 + i));
    } else if (g == 3) {
      const float* bon = p.BON + (size_t)row * GW + h * HD + i0;
      const float* gg = p.GG + (size_t)row * GW + h * HD + i0;
#pragma unroll
      for (int i = 0; i < 32; ++i) val[i] = gg[i] * (val[i] + bon[i]);
    }
#pragma unroll
    for (int i = 0; i < 32; i += 2) *(unsigned*)(y + i) = pack_bf16(val[i], val[i + 1]);
  }
}

__device__ __forceinline__ void ph_act(const P& p, int l, int s, int gtid, int gsize) {
  const bool last = (l == DEPTH - 1);
  const float* cw = p.f_cw + (size_t)l * 3 * DFF;
  const float* cb = p.f_cb + (size_t)l * DFF;
  for (int it = gtid; it < RS * (DFF / 2); it += gsize) {
    int j = (it % (DFF / 2)) * 2, row = it / (DFF / 2), pp = row % RPB;
    if (last && pp < CTX) continue;
    const bf16_t* hr = p.HFF + (size_t)row * 2 * DFF;
    unsigned am = has_prev(pp) ? *(const unsigned*)(hr - 2 * DFF + j) : 0u;
    unsigned a0 = *(const unsigned*)(hr + j);
    unsigned ap = has_next(pp) ? *(const unsigned*)(hr + 2 * DFF + j) : 0u;
    unsigned bv = *(const unsigned*)(hr + DFF + j);
    float o[2];
#pragma unroll
    for (int e = 0; e < 2; ++e) {
      float xm = bf2f((bf16_t)(am >> (16 * e))), x0 = bf2f((bf16_t)(a0 >> (16 * e))), xp = bf2f((bf16_t)(ap >> (16 * e)));
      float v = cw[j + e] * xm + cw[DFF + j + e] * x0 + cw[2 * DFF + j + e] * xp + cb[j + e];
      o[e] = siluf_(v) * bf2f((bf16_t)(bv >> (16 * e)));
    }
    *(unsigned*)(p.ACT + (size_t)row * DFF + j) = f2bf(o[0]) | ((unsigned)f2bf(o[1]) << 16);
  }
}

enum { PH_PRO_A = 0, PH_PRO_B, PH_PRO_C, PH_LN0, PH_GEMM_IN, PH_PREP, PH_SCAN, PH_FIN, PH_GEMM_OUT, PH_LN1, PH_GEMM_UP, PH_ACT, PH_GEMM_DN, PH_LN2, PH_COUNT };

__device__ __forceinline__ void run_phase(const P& p, int ph, int l, int s, bf16_t* lds) {
  int tid = threadIdx.x;
#ifndef CPU_EMU
  asm volatile("" : "+v"(tid));
#endif
  const int gtid = blockIdx.x * blockDim.x + tid;
  const int gsize = gridDim.x * blockDim.x;
  const bool last = (l == DEPTH - 1);
  switch (ph) {
    case PH_PRO_A: ph_pro_a(p, gtid, gsize); break;
    case PH_PRO_B: ph_pro_b(p, gtid, gsize); break;
    case PH_PRO_C: ph_pro_c(p, gtid, gsize); break;
    case PH_LN0: ph_ln0(p, l, s, gtid, gsize); break;
    case PH_GEMM_IN: gemm_phase<true>(p.U, p.wt_in + (size_t)l * LDP * DM, p.PROJ, RS, LDP, DM, LDP, false, lds, tid); break;
    case PH_PREP: ph_prep(p, l, s, gtid, gsize, (float*)lds, tid); break;
    case PH_SCAN: ph_scan(p, l, s, gtid, gsize, (float*)lds, tid); break;
    case PH_FIN: ph_fin(p, l, s, gtid, gsize); break;
    case PH_GEMM_OUT: gemm_phase<false>(p.U, p.wt_out + (size_t)l * DM * DM, p.OUTF, RS, DM, DM, DM, last, lds, tid); break;
    case PH_LN1: ph_ln1(p, l, s, gtid, gsize); break;
    case PH_GEMM_UP: gemm_phase<true>(p.U, p.wt_up + (size_t)l * 2 * DFF * DM, p.HFF, RS, 2 * DFF, DM, 2 * DFF, last, lds, tid); break;
    case PH_ACT: ph_act(p, l, s, gtid, gsize); break;
    case PH_GEMM_DN: gemm_phase<false>(p.ACT, p.wt_dn + (size_t)l * DM * DFF, p.OUTF, RS, DM, DFF, DM, last, lds, tid); break;
    case PH_LN2: ph_ln2(p, l, s, gtid, gsize); break;
  }
}

#ifndef PROBE_MASK
#define PROBE_MASK 0
#endif
#define RUNPH(ph) do { run_phase(p, ph, l, s, lds); grid.sync(); if (PROBE_MASK & (1 << ph)) { run_phase(p, ph, l, s, lds); grid.sync(); } } while (0)
#ifndef CPU_EMU
__global__ void __launch_bounds__(256) k_mega(P p) {
  __shared__ __attribute__((aligned(16))) bf16_t lds[24576];
  cg::grid_group grid = cg::this_grid();
  run_phase(p, PH_PRO_A, 0, 0, lds);
  grid.sync();
  run_phase(p, PH_PRO_B, 0, 0, lds);
  grid.sync();
  run_phase(p, PH_PRO_C, 0, 0, lds);
  grid.sync();
  for (int l = 0; l < DEPTH; ++l)
    for (int s = 0; s < NSLICE; ++s)
    {
      RUNPH(PH_LN0);
      RUNPH(PH_GEMM_IN);
      RUNPH(PH_PREP);
      RUNPH(PH_SCAN);
      RUNPH(PH_FIN);
      RUNPH(PH_GEMM_OUT);
      RUNPH(PH_LN1);
      RUNPH(PH_GEMM_UP);
      RUNPH(PH_ACT);
      RUNPH(PH_GEMM_DN);
      RUNPH(PH_LN2);
    }
}
#endif

static size_t ws_take(size_t& off, size_t bytes) { size_t o = off; off += (bytes + 255) & ~(size_t)255; return o; }

static void build_params(P& p, void* const* d_in, void* d_out, void* d_ws) {
  const float** f = (const float**)&p;
  for (int i = 0; i < 39; ++i) f[i] = (const float*)d_in[i];
  p.out = (float*)d_out;
  char* w = (char*)d_ws;
  size_t off = 0;
  p.wt_in = (bf16_t*)(w + ws_take(off, (size_t)DEPTH * LDP * DM * 2));
  p.wt_out = (bf16_t*)(w + ws_take(off, (size_t)DEPTH * DM * DM * 2));
  p.wt_up = (bf16_t*)(w + ws_take(off, (size_t)DEPTH * 2 * DFF * DM * 2));
  p.wt_dn = (bf16_t*)(w + ws_take(off, (size_t)DEPTH * DM * DFF * 2));
  p.kf_lat = (float*)(w + ws_take(off, (size_t)DEPTH * 2 * 2 * SEQ * GW * 4));
  p.kf_ctx = (float*)(w + ws_take(off, (size_t)DEPTH * 2 * 2 * CTX * GW * 4));
  p.kt_lat = (bf16_t*)(w + ws_take(off, (size_t)DEPTH * 2 * 2 * SEQ * GW * 2));
  p.kt_ctx = (bf16_t*)(w + ws_take(off, (size_t)DEPTH * 2 * 2 * CTX * GW * 2));
  p.hyh1 = (float*)(w + ws_take(off, (size_t)DEPTH * 2 * SEQ * 64 * 4));
  p.hyh2 = (float*)(w + ws_take(off, (size_t)DEPTH * 2 * SEQ * 64 * 4));
  p.scv = (float*)(w + ws_take(off, (size_t)NMOD * DM * 4));
  p.modtab = (float*)(w + ws_take(off, (size_t)DEPTH * NMOD * 6 * DM * 4));
  p.xc = (float*)(w + ws_take(off, (size_t)NB * CTX * DM * 4));
  p.ctr = (int*)(w + ws_take(off, 256));
  p.U = (bf16_t*)(w + ws_take(off, (size_t)RS * DM * 2));
  size_t arena = off;
  p.PROJ = (bf16_t*)(w + ws_take(off, (size_t)RS * LDP * 2));
  p.MQK = (float*)(w + ws_take(off, (size_t)RS * 2 * GW * 4));
  p.MG = (float*)(w + ws_take(off, (size_t)RS * 4 * NH * 4));
  p.RQK = (float*)(w + ws_take(off, (size_t)RS * 2 * GW * 4));
  p.RW = (float*)(w + ws_take(off, (size_t)8 * RS * GW * 4));
  p.HF = (float*)(w + ws_take(off, (size_t)RS * 3 * GW * 4));
  p.HB = (float*)(w + ws_take(off, (size_t)RS * 3 * GW * 4));
  p.Z2 = (float*)(w + ws_take(off, (size_t)RS * GW * 4));
  p.HY = (float*)(w + ws_take(off, (size_t)RS * GW * 4));
  p.BON = (float*)(w + ws_take(off, (size_t)RS * GW * 4));
  p.GG = (float*)(w + ws_take(off, (size_t)RS * GW * 4));
  size_t off2 = arena;
  p.OUTF = (float*)(w + ws_take(off2, (size_t)RS * DM * 4));
  p.HFF = (bf16_t*)(w + ws_take(off2, (size_t)RS * 2 * DFF * 2));
  p.ACT = (bf16_t*)(w + ws_take(off2, (size_t)RS * DFF * 2));
}

#ifndef CPU_EMU
extern "C" void kernel_launch(void* const* d_in, const int* in_sizes, int n_in, void* d_out, int out_size, void* d_ws, size_t ws_size,
                              hipStream_t stream) {
  static int grid_blocks = 0;
  if (!grid_blocks) {
    int dev = 0, cus = 0, per_cu = 0;
    hipGetDevice(&dev);
    hipDeviceGetAttribute(&cus, hipDeviceAttributeMultiprocessorCount, dev);
    hipOccupancyMaxActiveBlocksPerMultiprocessor(&per_cu, k_mega, 256, 0);
    if (per_cu < 1) per_cu = 1;
    grid_blocks = cus * per_cu;
  }
  P p;
  memset(&p, 0, sizeof(p));
  build_params(p, d_in, d_out, d_ws);
  void* args[] = {&p};
  hipError_t e = hipLaunchCooperativeKernel((void*)k_mega, dim3(grid_blocks), dim3(256), args, 0, stream);
  if (e != hipSuccess) fprintf(stderr, "cooperative launch failed: %s (grid %d)\n", hipGetErrorString(e), grid_blocks);
}
#endif
```

```cpp
#ifndef CPU_EMU
#include <hip/hip_runtime.h>
#include <hip/hip_cooperative_groups.h>
#include <cstdio>
#include <cstring>
namespace cg = cooperative_groups;
#endif
#include <stdint.h>

#if !defined(CFG_SMALL) && !defined(CFG_CONVTEST)
#define DM 1024
#define NB 32
#define SEQ 2048
#define CTX 256
#define DFF 2816
#define SB 8
#elif defined(CFG_CONVTEST)
#define DM 512
#define NB 8
#define SEQ 256
#define CTX 128
#define DFF 192
#define SB 8
#else
#define DM 512
#define NB 2
#define SEQ 256
#define CTX 128
#define DFF 192
#define SB 1
#endif
#define DEPTH 2
#define GRIDW 64
#define HD 64
#define GW (DM / 4)
#define NH (GW / HD)
#define DPROJ (14 * GW + 4 * NH + 128)
#define LDP ((DPROJ + 127) / 128 * 128)
#define OFF_ML 0
#define OFF_HY (4 * GW + 4 * NH)
#define OFF_RT (OFF_HY + 3 * GW)
#define OFF_RW (OFF_RT + 4 * GW)
#define RWSH (3 * GW + 128)
#define RPB (CTX + SEQ)
#define RS (SB * RPB)
#define NSLICE (NB / SB)
#define ALPHA 1.41421356237309515f
#define NMOD 33
#ifdef CPU_EMU
#define WL 1
#else
#define WL 64
#endif

typedef unsigned short bf16_t;

struct P {
  const float *x, *c, *ctx, *c_ctx, *ada_w, *ada_b, *w_in, *ml_cw, *ml_cb, *ml_gb, *hy_cw, *hy_cb, *hy_w1, *hy_b1, *hy_w2, *hy_b2, *hy_w3,
      *hy_freq, *hy_d, *rw_mu, *rw_w0, *rw_w2, *rw_a0, *rw_a2, *rw_g2, *rw_kk, *rw_ka, *rw_rk, *ng, *nb, *w_out, *ln1g, *ln1b, *w_up, *f_cw,
      *f_cb, *w_dn, *ln2g, *ln2b;
  float* out;
  bf16_t *wt_in, *wt_out, *wt_up, *wt_dn;
  float *kf_lat, *kf_ctx, *hyh1, *hyh2, *scv, *modtab, *xc;
  bf16_t *kt_lat, *kt_ctx;
  float *ropec, *ropes;
  bf16_t *U, *PROJ;
  float *MQK, *MG, *RQK, *RW, *HF, *HB, *Z2, *HY, *BON, *GG;
  float* OUTF;
  bf16_t *HFF, *ACT;
  int* ctr;
  unsigned* bar;
};

__device__ __forceinline__ bf16_t f2bf(float f) {
  unsigned u = __float_as_uint(f);
  u += 0x7fffu + ((u >> 16) & 1u);
  return (bf16_t)(u >> 16);
}
#ifndef CPU_EMU
typedef __bf16 bf16v2_t __attribute__((ext_vector_type(2)));
typedef float f32x2_t __attribute__((ext_vector_type(2)));
#endif
__device__ __forceinline__ unsigned pack_bf16(float lo, float hi) {
#ifndef CPU_EMU
  f32x2_t v = {lo, hi};
  bf16v2_t b = __builtin_convertvector(v, bf16v2_t);
  return __builtin_bit_cast(unsigned, b);
#else
  return f2bf(lo) | ((unsigned)f2bf(hi) << 16);
#endif
}
__device__ __forceinline__ float bf2f(bf16_t h) { return __uint_as_float(((unsigned)h) << 16); }
#ifndef CPU_EMU
__device__ __forceinline__ float fexp_(float x) { return __expf(x); }
__device__ __forceinline__ float frcp_(float x) { return __builtin_amdgcn_rcpf(x); }
#else
__device__ __forceinline__ float fexp_(float x) { return expf(x); }
__device__ __forceinline__ float frcp_(float x) { return 1.0f / x; }
#endif
__device__ __forceinline__ float sigmoidf_(float x) { return 1.0f / (1.0f + expf(-x)); }
__device__ __forceinline__ float siluf_(float x) { return x / (1.0f + expf(-x)); }
__device__ __forceinline__ float softplusf_(float x) { return fmaxf(x, 0.0f) + log1pf(expf(-fabsf(x))); }
__device__ __forceinline__ float logsigmoidf_(float x) { return -softplusf_(-x); }

__device__ __forceinline__ float wave_sum(float v) {
#ifndef CPU_EMU
#pragma unroll
  for (int o = 32; o > 0; o >>= 1) v += __shfl_xor(v, o, 64);
#endif
  return v;
}

#ifndef CPU_EMU
typedef float f4 __attribute__((ext_vector_type(4)));
typedef unsigned u2v __attribute__((ext_vector_type(2)));
__device__ __forceinline__ f4 ld4(const float* a) { return *(const f4*)a; }
__device__ __forceinline__ void st4(float* a, f4 v) { *(f4*)a = v; }
__device__ __forceinline__ f4 ldbf4(const bf16_t* a) {
  u2v u = *(const u2v*)a;
  f4 r;
  r.x = __uint_as_float(u.x << 16); r.y = __uint_as_float(u.x & 0xffff0000u);
  r.z = __uint_as_float(u.y << 16); r.w = __uint_as_float(u.y & 0xffff0000u);
  return r;
}
#else
struct f4 { float x, y, z, w; };
__device__ __forceinline__ f4 ld4(const float* a) { f4 r; r.x = a[0]; r.y = a[1]; r.z = a[2]; r.w = a[3]; return r; }
__device__ __forceinline__ void st4(float* a, f4 v) { a[0] = v.x; a[1] = v.y; a[2] = v.z; a[3] = v.w; }
__device__ __forceinline__ f4 ldbf4(const bf16_t* a) { f4 r; r.x = bf2f(a[0]); r.y = bf2f(a[1]); r.z = bf2f(a[2]); r.w = bf2f(a[3]); return r; }
#endif
__device__ __forceinline__ void ld8(float* dst, const float* src) {
#pragma unroll
  for (int j = 0; j < 2; ++j) { f4 v = ld4(src + 4 * j); dst[4 * j] = v.x; dst[4 * j + 1] = v.y; dst[4 * j + 2] = v.z; dst[4 * j + 3] = v.w; }
}
__device__ __forceinline__ void ld16(float* dst, const float* src) {
#pragma unroll
  for (int j = 0; j < 4; ++j) { f4 v = ld4(src + 4 * j); dst[4 * j] = v.x; dst[4 * j + 1] = v.y; dst[4 * j + 2] = v.z; dst[4 * j + 3] = v.w; }
}


__device__ __forceinline__ const float* xsrc_row(const P& p, int l, int b, int pp) {
  if (pp < CTX) return (l == 0 ? p.ctx : p.xc) + ((size_t)b * CTX + pp) * DM;
  return (l == 0 ? p.x : p.out) + ((size_t)b * SEQ + (pp - CTX)) * DM;
}
__device__ __forceinline__ float* xdst_row(const P& p, int b, int pp) {
  if (pp < CTX) return p.xc + ((size_t)b * CTX + pp) * DM;
  return p.out + ((size_t)b * SEQ + (pp - CTX)) * DM;
}
__device__ __forceinline__ bool has_prev(int pp) { return pp != 0 && pp != CTX; }
__device__ __forceinline__ bool has_next(int pp) { return pp != CTX - 1 && pp != RPB - 1; }

__device__ __forceinline__ void cvt_weight(const float* W, bf16_t* Wt, int K, int N, int Npad, int gtid, int gsize) {
  const int nk8 = K / 8;
  for (long it = gtid; it < (long)nk8 * Npad; it += gsize) {
    int n = (int)(it % Npad), k8 = (int)(it / Npad);
    bf16_t v[8];
#pragma unroll
    for (int j = 0; j < 8; ++j) v[j] = (n < N) ? f2bf(W[(size_t)(k8 * 8 + j) * N + n]) : (bf16_t)0;
    uint4 o;
    o.x = v[0] | ((unsigned)v[1] << 16); o.y = v[2] | ((unsigned)v[3] << 16);
    o.z = v[4] | ((unsigned)v[5] << 16); o.w = v[6] | ((unsigned)v[7] << 16);
    *(uint4*)(Wt + (size_t)n * K + k8 * 8) = o;
  }
}
__device__ __forceinline__ void hy_feat_h1(const P& p, int gtid, int gsize) {
  const int per_l = (SEQ + CTX) * 64;
  for (int it = gtid; it < DEPTH * per_l; it += gsize) {
    int l = it / per_l, r = it % per_l;
    int i, L, seg;
    int j = r % 64; r /= 64;
    if (r < SEQ) { seg = 0; i = r; L = SEQ; } else { seg = 1; i = r - SEQ; L = CTX; }
    const float* w1 = p.hy_w1 + (size_t)l * 33 * 64;
    float t = (float)i / (float)(L - 1);
    float ang = 6.283185307179586f * (float)i / (float)L;
    float acc = t * w1[j];
    for (int b = 0; b < 16; ++b) {
      float band = 1e-4f + (float)b * ((15.0f - 1e-4f) / 15.0f);
      float a = band * ang;
      acc += cosf(a) * w1[(1 + b) * 64 + j];
      acc -= sinf(a) * w1[(17 + b) * 64 + j];
    }
    float h = sinf(p.hy_freq[l * 64 + j] * (acc + p.hy_b1[l * 64 + j]));
    p.hyh1[((size_t)(l * 2 + seg) * SEQ + i) * 64 + j] = h;
  }
}
__device__ __forceinline__ void ph_pro_a(const P& p, int gtid, int gsize) {
  for (int l = 0; l < DEPTH; ++l) {
    cvt_weight(p.w_in + (size_t)l * DM * DPROJ, p.wt_in + (size_t)l * LDP * DM, DM, DPROJ, LDP, gtid, gsize);
    cvt_weight(p.w_out + (size_t)l * DM * DM, p.wt_out + (size_t)l * DM * DM, DM, DM, DM, gtid, gsize);
    cvt_weight(p.w_up + (size_t)l * DM * 2 * DFF, p.wt_up + (size_t)l * 2 * DFF * DM, DM, 2 * DFF, 2 * DFF, gtid, gsize);
    cvt_weight(p.w_dn + (size_t)l * DFF * DM, p.wt_dn + (size_t)l * DM * DFF, DFF, DM, DM, gtid, gsize);
  }
  for (int it = gtid; it < NMOD * DM; it += gsize) {
    int r = it / DM, k = it % DM;
    float v = (r < NB) ? p.c[(size_t)r * DM + k] : p.c_ctx[k];
    p.scv[it] = siluf_(v);
  }
  hy_feat_h1(p, gtid, gsize);
  for (int it = gtid; it < 64 * 16; it += gsize) {
    float a = (float)(it / 16) * powf(10000.0f, -(float)(it % 16) / 16.0f);
    p.ropec[it] = cosf(a);
    p.ropes[it] = sinf(a);
  }
}
__device__ __forceinline__ void ph_pro_b(const P& p, int gtid, int gsize) {
  for (int it = gtid; it < DEPTH * NMOD * 6 * DM; it += gsize) {
    int j = it % (6 * DM), r = (it / (6 * DM)) % NMOD, l = it / (6 * DM * NMOD);
    const float* w = p.ada_w + (size_t)l * DM * 6 * DM + j;
    const float* sv = p.scv + r * DM;
    float acc = 0.f;
    for (int k = 0; k < DM; ++k) acc += sv[k] * w[(size_t)k * 6 * DM];
    p.modtab[it] = acc + p.ada_b[l * 6 * DM + j];
  }
  const int per_l = (SEQ + CTX) * 64;
  for (int it = gtid; it < DEPTH * per_l; it += gsize) {
    int l = it / per_l, r = it % per_l;
    int j = r % 64; r /= 64;
    int seg = r < SEQ ? 0 : 1, i = r < SEQ ? r : r - SEQ;
    const float* h1 = p.hyh1 + ((size_t)(l * 2 + seg) * SEQ + i) * 64;
    const float* w2 = p.hy_w2 + (size_t)l * 64 * 64;
    float acc = 0.f;
    for (int k = 0; k < 64; ++k) acc += h1[k] * w2[k * 64 + j];
    p.hyh2[((size_t)(l * 2 + seg) * SEQ + i) * 64 + j] = sinf(p.hy_freq[l * 64 + j] * (acc + p.hy_b2[l * 64 + j]));
  }
}
__device__ __forceinline__ void ph_pro_c(const P& p, int gtid, int gsize) {
  const int per_l = 2 * (2 * SEQ + 2 * CTX) * GW;
  const float max_decay = -4.605170185988091f / 0.3f, min_decay = -4.605170185988091f / 1.5f;
  for (int it = gtid; it < DEPTH * per_l; it += gsize) {
    int l = it / per_l, r = it % per_l;
    int c = r % GW; r /= GW;
    int ord = r & 1; r >>= 1;
    int seg, idx, L;
    if (r < 2 * SEQ) { seg = 0; idx = r; L = SEQ; } else { seg = 1; idx = r - 2 * SEQ; L = CTX; }
    int d = idx - L;
    float val = 0.f;
    if (idx != 0) {
      int i = d < 0 ? -d : d;
      float ti = (float)i / (float)(L - 1);
      float delta = fabsf(min_decay + (float)c * ((max_decay - min_decay) / (float)(GW - 1)));
      float win = expf(-ti * delta);
      const float* h2 = p.hyh2 + ((size_t)(l * 2 + seg) * SEQ + i) * 64;
      const float* w3 = p.hy_w3 + (size_t)l * 64 * 4 * GW;
      float af = 0.f, ab = 0.f;
      for (int k = 0; k < 64; ++k) {
        float hv = h2[k];
        af += hv * w3[k * 4 * GW + 0 * 2 * GW + ord * GW + c];
        ab += hv * w3[k * 4 * GW + 1 * 2 * GW + ord * GW + c];
      }
      if (d > 0) val = af * win;
      else if (d < 0) val = ab * win;
      else val = (af + ab) * win + p.hy_d[(l * 2 + ord) * GW + c];
    }
    float* kf = seg == 0 ? p.kf_lat + ((size_t)(l * 2 + ord) * 2 * SEQ + idx) * GW : p.kf_ctx + ((size_t)(l * 2 + ord) * 2 * CTX + idx) * GW;
    kf[c] = val;
    if (seg == 0) p.kt_lat[((size_t)(l * 2 + ord) * GW + c) * 2 * SEQ + idx] = f2bf(val);
    else p.kt_ctx[((size_t)(l * 2 + ord) * GW + c) * 2 * CTX + idx] = f2bf(val);
  }
}

#define NV (DM / WL)
__device__ __forceinline__ void ln_inplace(float* v, int lane) {
  float s = 0.f;
#pragma unroll
  for (int i = 0; i < NV; ++i) s += v[i];
  s = wave_sum(s);
  float mu = s * (1.0f / DM);
  float q = 0.f;
#pragma unroll
  for (int i = 0; i < NV; ++i) { float d = v[i] - mu; q += d * d; }
  q = wave_sum(q);
  float rs = 1.0f / sqrtf(q * (1.0f / DM) + 1e-5f);
#pragma unroll
  for (int i = 0; i < NV; ++i) v[i] = (v[i] - mu) * rs;
}
__device__ __forceinline__ void ph_ln0(const P& p, int l, int s, int gtid, int gsize) {
  const int lane = gtid % WL, gw = gtid / WL, nw = gsize / WL;
  if (gtid == 0) *p.ctr = 0;
  for (int row = gw; row < RS; row += nw) {
    int bl = row / RPB, pp = row % RPB, b = s * SB + bl;
    const float* xr = xsrc_row(p, l, b, pp);
    const float* mod = p.modtab + ((size_t)l * NMOD + (pp < CTX ? NB : b)) * 6 * DM;
    float v[NV];
#pragma unroll
    for (int i = 0; i < NV; ++i) v[i] = xr[i * WL + lane];
    ln_inplace(v, lane);
#pragma unroll
    for (int i = 0; i < NV; ++i) {
      int k = i * WL + lane;
      p.U[(size_t)row * DM + k] = f2bf(v[i] * (1.0f + mod[DM + k]) + mod[k]);
    }
  }
}
__device__ __forceinline__ void ph_ln1(const P& p, int l, int s, int gtid, int gsize) {
  const int lane = gtid % WL, gw = gtid / WL, nw = gsize / WL;
  const bool last = (l == DEPTH - 1);
  for (int row = gw; row < RS; row += nw) {
    int bl = row / RPB, pp = row % RPB, b = s * SB + bl;
    if (last && pp < CTX) continue;
    const float* xr = xsrc_row(p, l, b, pp);
    float* xd = xdst_row(p, b, pp);
    const float* mod = p.modtab + ((size_t)l * NMOD + (pp < CTX ? NB : b)) * 6 * DM;
    const float* o = p.OUTF + (size_t)row * DM;
    float v[NV];
#pragma unroll
    for (int i = 0; i < NV; ++i) { int k = i * WL + lane; v[i] = ALPHA * xr[k] + mod[2 * DM + k] * o[k]; }
    ln_inplace(v, lane);
#pragma unroll
    for (int i = 0; i < NV; ++i) { int k = i * WL + lane; v[i] = v[i] * p.ln1g[l * DM + k] + p.ln1b[l * DM + k]; xd[k] = v[i]; }
    ln_inplace(v, lane);
#pragma unroll
    for (int i = 0; i < NV; ++i) {
      int k = i * WL + lane;
      p.U[(size_t)row * DM + k] = f2bf(v[i] * (1.0f + mod[4 * DM + k]) + mod[3 * DM + k]);
    }
  }
}
__device__ __forceinline__ void ph_ln2(const P& p, int l, int s, int gtid, int gsize) {
  const int lane = gtid % WL, gw = gtid / WL, nw = gsize / WL;
  const bool last = (l == DEPTH - 1);
  for (int row = gw; row < RS; row += nw) {
    int bl = row / RPB, pp = row % RPB, b = s * SB + bl;
    if (last && pp < CTX) continue;
    float* xd = xdst_row(p, b, pp);
    const float* mod = p.modtab + ((size_t)l * NMOD + (pp < CTX ? NB : b)) * 6 * DM;
    const float* o = p.OUTF + (size_t)row * DM;
    float v[NV];
#pragma unroll
    for (int i = 0; i < NV; ++i) { int k = i * WL + lane; v[i] = ALPHA * xd[k] + mod[5 * DM + k] * o[k]; }
    ln_inplace(v, lane);
#pragma unroll
    for (int i = 0; i < NV; ++i) { int k = i * WL + lane; xd[k] = v[i] * p.ln2g[l * DM + k] + p.ln2b[l * DM + k]; }
  }
}

#ifndef CPU_EMU
typedef short bf16x8 __attribute__((ext_vector_type(8)));
typedef float f32x4 __attribute__((ext_vector_type(4)));
typedef unsigned u32x4 __attribute__((ext_vector_type(4)));
__device__ __forceinline__ f32x4 mfma16(bf16x8 a, bf16x8 b, f32x4 c) { return __builtin_amdgcn_mfma_f32_16x16x32_bf16(a, b, c, 0, 0, 0); }
#define GBM 128
#define GBN 128
#define GBK 64
#define GLD (GBK + 8)
template <bool OUT_BF16>
__device__ __forceinline__ void gemm_phase(const bf16_t* __restrict__ A, const bf16_t* __restrict__ Bt, void* __restrict__ Cv, int M, int N, int K, int ldc,
                           bool skip_ctx, bf16_t* lds, int tid) {
  bf16_t* sA = lds;
  bf16_t* sB = lds + GBM * GLD;
  const int lane = tid & 63, wave = tid >> 6;
  const int wm = wave >> 1, wn = wave & 1;
  const int ntm = M / GBM, ntn = N / GBN;
  const int KT = K / GBK;
  const int lr = lane & 15, lq = lane >> 4;
  for (int tile = blockIdx.x; tile < ntm * ntn; tile += gridDim.x) {
    const int tm = tile / ntn, tn = tile % ntn;
    if (skip_ctx && (tm % (RPB / GBM)) < (CTX / GBM)) continue;
    const int m0 = tm * GBM, n0 = tn * GBN;
    f32x4 acc[4][4];
#pragma unroll
    for (int i = 0; i < 4; ++i)
#pragma unroll
      for (int j = 0; j < 4; ++j) acc[i][j] = (f32x4){0.f, 0.f, 0.f, 0.f};
    u32x4 ra[4], rb[4];
#pragma unroll
    for (int i = 0; i < 4; ++i) {
      int id = tid + i * 256, r = id >> 3, ch = id & 7;
      ra[i] = *(const u32x4*)(A + (size_t)(m0 + r) * K + ch * 8);
      rb[i] = *(const u32x4*)(Bt + (size_t)(n0 + r) * K + ch * 8);
    }
    for (int kt = 0; kt < KT; ++kt) {
      __syncthreads();
#pragma unroll
      for (int i = 0; i < 4; ++i) {
        int id = tid + i * 256, r = id >> 3, ch = id & 7;
        *(u32x4*)(sA + r * GLD + ch * 8) = ra[i];
        *(u32x4*)(sB + r * GLD + ch * 8) = rb[i];
      }
      __syncthreads();
      if (kt + 1 < KT) {
#pragma unroll
        for (int i = 0; i < 4; ++i) {
          int id = tid + i * 256, r = id >> 3, ch = id & 7;
          ra[i] = *(const u32x4*)(A + (size_t)(m0 + r) * K + (kt + 1) * GBK + ch * 8);
          rb[i] = *(const u32x4*)(Bt + (size_t)(n0 + r) * K + (kt + 1) * GBK + ch * 8);
        }
      }
#pragma unroll
      for (int kk = 0; kk < GBK; kk += 32) {
        bf16x8 fa[4], fb[4];
#pragma unroll
        for (int i = 0; i < 4; ++i) fa[i] = *(const bf16x8*)(sA + (wm * 64 + i * 16 + lr) * GLD + kk + lq * 8);
#pragma unroll
        for (int j = 0; j < 4; ++j) fb[j] = *(const bf16x8*)(sB + (wn * 64 + j * 16 + lr) * GLD + kk + lq * 8);
#pragma unroll
        for (int i = 0; i < 4; ++i)
#pragma unroll
          for (int j = 0; j < 4; ++j) acc[i][j] = __builtin_amdgcn_mfma_f32_16x16x32_bf16(fb[j], fa[i], acc[i][j], 0, 0, 0);
      }
    }
#pragma unroll
    for (int i = 0; i < 4; ++i)
#pragma unroll
      for (int j = 0; j < 4; ++j) {
        size_t off = (size_t)(m0 + wm * 64 + i * 16 + lr) * ldc + n0 + wn * 64 + j * 16 + lq * 4;
        if (OUT_BF16) {
          uint2 o;
          o.x = pack_bf16(acc[i][j][0], acc[i][j][1]);
          o.y = pack_bf16(acc[i][j][2], acc[i][j][3]);
          *(uint2*)((bf16_t*)Cv + off) = o;
        } else {
          *(float4*)((float*)Cv + off) = make_float4(acc[i][j][0], acc[i][j][1], acc[i][j][2], acc[i][j][3]);
        }
      }
  }
}
#else
template <bool OUT_BF16>
void gemm_phase(const bf16_t* A, const bf16_t* Bt, void* Cv, int M, int N, int K, int ldc, bool skip_ctx, bf16_t* lds, int tid) {
  int gtid = blockIdx.x * blockDim.x + threadIdx.x, gsize = gridDim.x * blockDim.x;
  for (long it = gtid; it < (long)M * N; it += gsize) {
    int m = (int)(it / N), n = (int)(it % N);
    if (skip_ctx && (m % RPB) < CTX) continue;
    float acc = 0.f;
    for (int k = 0; k < K; ++k) acc += bf2f(A[(size_t)m * K + k]) * bf2f(Bt[(size_t)n * K + k]);
    if (OUT_BF16) ((bf16_t*)Cv)[(size_t)m * ldc + n] = f2bf(acc);
    else ((float*)Cv)[(size_t)m * ldc + n] = acc;
  }
}
#endif

#define PJ(row, col) bf2f(p.PROJ[(size_t)(row) * LDP + (col)])
template <int ORD>
__device__ __forceinline__ void hyena_conv_item(const P& p, int l, int it) {
  const bool need_ctx = (l != DEPTH - 1);
  const int ntb = (need_ctx ? CTX / 16 : 0) + SEQ / 16;
  int c = it % GW, r = it / GW;
  int tb = r % ntb, bl = r / ntb;
  int seg0, L, t0;
  const float* kf;
  if (need_ctx && tb < CTX / 16) { seg0 = 0; L = CTX; t0 = tb * 16; kf = p.kf_ctx + (size_t)(l * 2 + ORD) * 2 * CTX * GW; }
  else { int tb2 = tb - (need_ctx ? CTX / 16 : 0); seg0 = CTX; L = SEQ; t0 = tb2 * 16; kf = p.kf_lat + (size_t)(l * 2 + ORD) * 2 * SEQ * GW; }
  const int rowbase = bl * RPB + seg0;
  const float* cw = p.hy_cw + (size_t)l * 3 * 3 * GW;
  const float* cb = p.hy_cb + (size_t)l * 3 * GW;
  float acc[16], F[31], u[16];
#pragma unroll
  for (int i = 0; i < 16; ++i) acc[i] = 0.f;
#pragma unroll
  for (int m = 0; m < 15; ++m) F[m] = kf[(size_t)(L + t0 + 1 + m) * GW + c];
  const float w0 = cw[0 * 3 * GW + c], w1 = cw[1 * 3 * GW + c], w2 = cw[2 * 3 * GW + c], bb = cb[c];
  float nF[16], nin[18];
  auto fetch = [&](int s0) {
#pragma unroll
    for (int m = 0; m < 16; ++m) nF[m] = kf[(size_t)(L + t0 - s0 - 15 + m) * GW + c];
    if (ORD == 0) {
#pragma unroll
      for (int j = 0; j < 18; ++j) {
        int sp = s0 - 1 + j;
        nin[j] = (sp >= 0 && sp < L) ? PJ(rowbase + sp, OFF_HY + c) : 0.f;
      }
    } else {
#pragma unroll
      for (int j = 0; j < 16; ++j) nin[j] = p.Z2[(size_t)(rowbase + s0 + j) * GW + c];
    }
  };
  fetch(0);
  for (int s0 = 0; s0 < L; s0 += 16) {
#pragma unroll
    for (int m = 14; m >= 0; --m) F[m + 16] = F[m];
#pragma unroll
    for (int m = 0; m < 16; ++m) F[m] = nF[m];
    if (ORD == 0) {
#pragma unroll
      for (int j = 0; j < 16; ++j) u[j] = w0 * nin[j] + w1 * nin[j + 1] + w2 * nin[j + 2] + bb;
    } else {
#pragma unroll
      for (int j = 0; j < 16; ++j) u[j] = nin[j];
    }
    if (s0 + 16 < L) fetch(s0 + 16);
#pragma unroll
    for (int j = 0; j < 16; ++j)
#pragma unroll
      for (int i = 0; i < 16; ++i) acc[i] += F[i - j + 15] * u[j];
  }
  const int xc = (ORD == 0 ? GW : 2 * GW) + c;
  const float v0 = cw[0 * 3 * GW + xc], v1 = cw[1 * 3 * GW + xc], v2 = cw[2 * 3 * GW + xc], vb = cb[xc];
#pragma unroll
  for (int i = 0; i < 16; ++i) {
    int t = t0 + i;
    float xm = t > 0 ? PJ(rowbase + t - 1, OFF_HY + xc) : 0.f;
    float x0 = PJ(rowbase + t, OFF_HY + xc);
    float xp = t < L - 1 ? PJ(rowbase + t + 1, OFF_HY + xc) : 0.f;
    float g = v0 * xm + v1 * x0 + v2 * xp + vb;
    float o = g * acc[i];
    if (ORD == 0) p.Z2[(size_t)(rowbase + t) * GW + c] = o;
    else p.HY[(size_t)(rowbase + t) * GW + c] = o;
  }
}
__device__ __forceinline__ int hyena_items(int l) { return SB * ((l != DEPTH - 1 ? CTX / 16 : 0) + SEQ / 16) * GW; }

#if SB == 8
#define HC_KOFF (SEQ + 32)
#define HC_KLEN (2 * SEQ + 64)
#define HC_ULS ((SEQ / 16 + 4) * 16)
template <int ORD>
__device__ __forceinline__ void hyena_mfma_item(const P& p, int l, int item, bf16_t* lds, int tid) {
  const int c = item % GW, seg = item / GW;
  const int L = seg ? CTX : SEQ, seg0 = seg ? 0 : CTX, NTB = L / 16;
  const bf16_t* kt = (seg ? p.kt_ctx + ((size_t)(l * 2 + ORD) * GW + c) * 2 * CTX : p.kt_lat + ((size_t)(l * 2 + ORD) * GW + c) * 2 * SEQ);
  bf16_t* KL = lds;
  bf16_t* UL = lds + HC_KLEN;
  const float* cw = p.hy_cw + (size_t)l * 3 * 3 * GW;
  const float* cb = p.hy_cb + (size_t)l * 3 * GW;
  __syncthreads();
  for (int n = -(L + 32) + tid; n < L + 32; n += 256) KL[HC_KOFF + n] = (n > -L && n < L) ? kt[L - n] : (bf16_t)0;
  for (int q = tid; q < SB * 4; q += 256) {
    int b = q >> 2, w = q & 3;
    bf16_t* dst = UL + b * HC_ULS + (w < 2 ? w * 16 : (NTB + w) * 16);
    for (int j = 0; j < 16; ++j) dst[j] = 0;
  }
  {
    const float w0 = cw[0 * 3 * GW + c], w1 = cw[1 * 3 * GW + c], w2 = cw[2 * 3 * GW + c], bb = cb[c];
    for (int q = tid; q < SB * (L / 8); q += 256) {
      const int b = q / (L / 8), s8 = (q % (L / 8)) * 8;
      const int row = b * RPB + seg0 + s8;
      float u[8];
      if (ORD == 0) {
        float raw[10];
#pragma unroll
        for (int j = 0; j < 10; ++j) { int sp = s8 - 1 + j; raw[j] = (sp >= 0 && sp < L) ? PJ(row - 1 + j, OFF_HY + c) : 0.f; }
#pragma unroll
        for (int j = 0; j < 8; ++j) u[j] = w0 * raw[j] + w1 * raw[j + 1] + w2 * raw[j + 2] + bb;
      } else {
#pragma unroll
        for (int j = 0; j < 8; ++j) u[j] = p.Z2[(size_t)(row + j) * GW + c];
      }
      unsigned* dst = (unsigned*)(UL + b * HC_ULS + 32 + s8);
#pragma unroll
      for (int j = 0; j < 4; ++j) dst[j] = pack_bf16(u[2 * j], u[2 * j + 1]);
    }
  }
  __syncthreads();
  const int lane = tid & 63, wave = tid >> 6;
  const int ti = lane & 15, q4 = lane >> 4;
  const int NT = NTB / 2, TPW = NT / 4;
  const int T0 = wave * TPW * 2;
  f32x4 acc[16];
#pragma unroll
  for (int m = 0; m < 16; ++m) acc[m] = (f32x4){0.f, 0.f, 0.f, 0.f};
  const int nK = NTB / 2 + TPW;
  const int colb = (lane & 7) * HC_ULS + (q4 & 1) * 8;
  const int tbsel = (lane >> 3) & 1;
  for (int k = 0; k < nK; ++k) {
    const int dl = T0 - NTB + 2 * k + (q4 >> 1);
    const int nb = HC_KOFF - 16 * dl - ti + 8 * (q4 & 1);
    bf16x8 A;
#pragma unroll
    for (int j = 0; j < 8; ++j) A[j] = (short)KL[nb + j];
#pragma unroll
    for (int m = 0; m < 16; ++m) {
      if (m < TPW && k >= m && k <= m + NTB / 2) {
        const int sb = T0 + 2 * m + tbsel - dl;
        const bf16x8 B = *(const bf16x8*)(UL + colb + (sb + 2) * 16);
        acc[m] = mfma16(A, B, acc[m]);
      }
    }
  }
  const int xc = (ORD == 0 ? GW : 2 * GW) + c;
  const float v0 = cw[0 * 3 * GW + xc], v1 = cw[1 * 3 * GW + xc], v2 = cw[2 * 3 * GW + xc], vb = cb[xc];
  const int bn = lane & 7;
#pragma unroll
  for (int m = 0; m < 16; ++m) {
    if (m < TPW) {
      const int t0 = 16 * (T0 + 2 * m + tbsel) + q4 * 4;
      const int row = bn * RPB + seg0 + t0;
      float raw[6];
#pragma unroll
      for (int j = 0; j < 6; ++j) { int tp = t0 - 1 + j; raw[j] = (tp >= 0 && tp < L) ? PJ(row - 1 + j, OFF_HY + xc) : 0.f; }
#pragma unroll
      for (int r = 0; r < 4; ++r) {
        float g = v0 * raw[r] + v1 * raw[r + 1] + v2 * raw[r + 2] + vb;
        float o = g * acc[m][r];
        if (ORD == 0) p.Z2[(size_t)(row + r) * GW + c] = o;
        else p.HY[(size_t)(row + r) * GW + c] = o;
      }
    }
  }
}
__device__ __forceinline__ int hyena_mfma_items(int l) { return (l != DEPTH - 1 ? 2 : 1) * GW; }
#endif


__device__ __forceinline__ float rw_shift(const P& p, int l, int row, int pp, int j) {
  float x = PJ(row, OFF_RW + j);
  float xp = has_prev(pp) ? PJ(row - 1, OFF_RW + j) : 0.f;
  float xn = has_next(pp) ? PJ(row + 1, OFF_RW + j) : 0.f;
  return x + p.rw_mu[(size_t)(l * 2 + 0) * RWSH + j] * (xp - x) + p.rw_mu[(size_t)(l * 2 + 1) * RWSH + j] * (xn - x);
}
__device__ __forceinline__ void ph_prep(const P& p, int l, int s, int gtid, int gsize, float* lds, int tid) {
  for (int it = gtid; it < RS * (2 * GW / 4); it += gsize) {
    const int j = (it % (2 * GW / 4)) * 4, row = it / (2 * GW / 4), pp = row % RPB;
    const float* cw = p.ml_cw + (size_t)l * 3 * 2 * GW + j;
    const bf16_t* pr = p.PROJ + (size_t)row * LDP + OFF_ML + j;
    f4 x0 = ldbf4(pr), xm = x0, xp = x0;
    xm.x = xm.y = xm.z = xm.w = 0.f; xp = xm;
    if (has_prev(pp)) xm = ldbf4(pr - LDP);
    if (has_next(pp)) xp = ldbf4(pr + LDP);
    const f4 c0 = ld4(cw), c1 = ld4(cw + 2 * GW), c2 = ld4(cw + 4 * GW), cb = ld4(p.ml_cb + l * 2 * GW + j);
    const float sc = (j < GW) ? 0.125f : 1.0f;
    f4 o;
    o.x = siluf_(c0.x * xm.x + c1.x * x0.x + c2.x * xp.x + cb.x) * sc;
    o.y = siluf_(c0.y * xm.y + c1.y * x0.y + c2.y * xp.y + cb.y) * sc;
    o.z = siluf_(c0.z * xm.z + c1.z * x0.z + c2.z * xp.z + cb.z) * sc;
    o.w = siluf_(c0.w * xm.w + c1.w * x0.w + c2.w * xp.w + cb.w) * sc;
    st4(p.MQK + (size_t)row * 2 * GW + j, o);
  }
  for (int it = gtid; it < RS * 4 * NH; it += gsize) {
    int gj = it % (4 * NH), row = it / (4 * NH);
    float g = PJ(row, OFF_ML + 4 * GW + gj) + p.ml_gb[l * 4 * NH + gj];
    if ((gj / NH) & 1) g = logsigmoidf_(g);
    p.MG[(size_t)row * 4 * NH + gj] = g;
  }
  for (int it = gtid; it < RS * (2 * GW / 4); it += gsize) {
    const int j = (it % (2 * GW / 4)) * 4, row = it / (2 * GW / 4), pp = row % RPB;
    const int which = j / GW, c = j % GW, dd = c % HD, hb = c - dd;
    const bf16_t* pr = p.PROJ + (size_t)row * LDP + OFF_RT + which * GW;
    const f4 x = ldbf4(pr + c);
    f4 o = x;
    if (pp >= CTX) {
      const int t = pp - CTX, ri = t / GRIDW, ci = t % GRIDW;
      const int half = dd / 32, e = dd % 32, pi = e % 16;
      const bool first = e < 16;
      const int pos = half ? ci : ri;
      const f4 xo = ldbf4(pr + hb + (first ? dd + 16 : dd - 16));
      const f4 cs = ld4(p.ropec + pos * 16 + pi), sn = ld4(p.ropes + pos * 16 + pi);
      const float sg = first ? -1.0f : 1.0f;
      o.x = x.x * cs.x + sg * xo.x * sn.x;
      o.y = x.y * cs.y + sg * xo.y * sn.y;
      o.z = x.z * cs.z + sg * xo.z * sn.z;
      o.w = x.w * cs.w + sg * xo.w * sn.w;
    }
    if (which == 0) { o.x *= 0.125f; o.y *= 0.125f; o.z *= 0.125f; o.w *= 0.125f; }
    st4(p.RQK + (size_t)row * 2 * GW + j, o);
  }
  {
    float* zs = lds;
    float* part = lds + 8 * RWSH;
    const size_t AS = (size_t)RS * GW;
    for (int tile = blockIdx.x; tile < RS / 8; tile += gridDim.x) {
      const int row0 = tile * 8;
      __syncthreads();
      for (int idx = tid; idx < 8 * RWSH; idx += 256) {
        int r = idx / RWSH, j = idx % RWSH, row = row0 + r;
        float z = rw_shift(p, l, row, row % RPB, j);
        if (j >= 3 * GW && j < 3 * GW + 32) z = tanhf(z);
        else if (j >= 3 * GW + 64) z = sigmoidf_(z);
        zs[idx] = z;
      }
      __syncthreads();
      {
        int pr = tid >> 3, sub = tid & 7;
        if (pr < 8 * NH) {
          int r = pr / NH, h = pr % NH;
          float ss = 0.f, bs = 0.f;
          for (int i = sub * 8; i < sub * 8 + 8; ++i) {
            float kv = zs[r * RWSH + GW + h * HD + i], rv = zs[r * RWSH + h * HD + i];
            float kk = kv * p.rw_kk[l * GW + h * HD + i];
            ss += kk * kk;
            bs += rv * kv * p.rw_rk[(l * NH + h) * HD + i];
          }
          part[pr * 8 + sub] = ss;
          part[256 + pr * 8 + sub] = bs;
        }
      }
      __syncthreads();
      for (int c = tid; c < GW; c += 256) {
        const int h = c / HD;
        float wa0[8], wa1[8], aa0[8], aa1[8], gg[8];
#pragma unroll
        for (int r = 0; r < 8; ++r) { wa0[r] = 0.f; wa1[r] = 0.f; aa0[r] = 0.f; aa1[r] = 0.f; gg[r] = 0.f; }
#pragma unroll 8
        for (int i = 0; i < 32; ++i) {
          float w20 = p.rw_w2[((size_t)(l * 2 + 0) * 32 + i) * GW + c], w21 = p.rw_w2[((size_t)(l * 2 + 1) * 32 + i) * GW + c];
          float a20 = p.rw_a2[((size_t)(l * 2 + 0) * 32 + i) * GW + c], a21 = p.rw_a2[((size_t)(l * 2 + 1) * 32 + i) * GW + c];
#pragma unroll
          for (int r = 0; r < 8; ++r) {
            float tw = zs[r * RWSH + 3 * GW + i], al = zs[r * RWSH + 3 * GW + 32 + i];
            wa0[r] = fmaf(tw, w20, wa0[r]); wa1[r] = fmaf(tw, w21, wa1[r]);
            aa0[r] = fmaf(al, a20, aa0[r]); aa1[r] = fmaf(al, a21, aa1[r]);
          }
        }
#pragma unroll 16
        for (int j = 0; j < 64; ++j) {
          float g2 = p.rw_g2[((size_t)l * 64 + j) * GW + c];
#pragma unroll
          for (int r = 0; r < 8; ++r) gg[r] = fmaf(zs[r * RWSH + 3 * GW + 64 + j], g2, gg[r]);
        }
        const float ka = p.rw_ka[l * GW + c], kks = p.rw_kk[l * GW + c];
        const float w00 = p.rw_w0[(l * 2 + 0) * GW + c], w01 = p.rw_w0[(l * 2 + 1) * GW + c];
        const float a00 = p.rw_a0[(l * 2 + 0) * GW + c], a01 = p.rw_a0[(l * 2 + 1) * GW + c];
#pragma unroll
        for (int r = 0; r < 8; ++r) {
          const int pr = r * NH + h;
          float ss = 0.f, bs = 0.f;
#pragma unroll
          for (int u = 0; u < 8; ++u) { ss += part[pr * 8 + u]; bs += part[256 + pr * 8 + u]; }
          const float rr = zs[r * RWSH + c], k = zs[r * RWSH + GW + c], v = zs[r * RWSH + 2 * GW + c];
          const float kkv = k * kks / sqrtf(ss + 1e-12f);
          const size_t o = (size_t)(row0 + r) * GW + c;
          p.RW[0 * AS + o] = rr;
          p.RW[1 * AS + o] = kkv;
          p.BON[o] = bs * v;
          p.GG[o] = gg[r];
#pragma unroll
          for (int d = 0; d < 2; ++d) {
            float wpre = (d ? w01 : w00) + (d ? wa1[r] : wa0[r]);
            float decay = expf(-expf(-softplusf_(-wpre) - 0.5f));
            float a = sigmoidf_((d ? a01 : a00) + (d ? aa1[r] : aa0[r]));
            p.RW[(2 + d) * AS + o] = decay;
            p.RW[(4 + d) * AS + o] = k * (1.0f + (a - 1.0f) * ka);
            p.RW[(6 + d) * AS + o] = kkv * a;
          }
        }
      }
    }
    __syncthreads();
  }
#if SB == 8
  for (int it = blockIdx.x; it < hyena_mfma_items(l); it += gridDim.x) hyena_mfma_item<0>(p, l, it, (bf16_t*)lds, tid);
  __syncthreads();
#else
  for (int it = gtid; it < hyena_items(l); it += gsize) hyena_conv_item<0>(p, l, it);
#endif
}

__device__ __forceinline__ int scan_pos(int dir, int step) {
  if (!dir) return step;
  return step < CTX ? CTX - 1 - step : RPB - 1 - (step - CTX);
}
#ifndef CPU_EMU
__device__ __forceinline__ float quad_sum(float v) {
  v += __int_as_float(__builtin_amdgcn_mov_dpp(__float_as_int(v), 0xB1, 0xF, 0xF, true));
  v += __int_as_float(__builtin_amdgcn_mov_dpp(__float_as_int(v), 0x4E, 0xF, 0xF, true));
  return v;
}
__device__ __forceinline__ float oct_sum(float v) {
  v = quad_sum(v);
  v += __int_as_float(__builtin_amdgcn_mov_dpp(__float_as_int(v), 0x141, 0xF, 0xF, true));
  return v;
}
#endif
#define SCT 16
#define NCHUNK (RPB / SCT)
__device__ __forceinline__ void bscan_rwkv(const P& p, int l, int bl, int h, int dir, int half, float* lds, int tid) {
  const int i = half * 32 + (tid >> 3), kq = tid & 7, st = tid >> 4, sp = tid & 15;
  float S[8];
#pragma unroll
  for (int d = 0; d < 8; ++d) S[d] = 0.f;
  float* H = dir ? p.HB : p.HF;
  const size_t AS = (size_t)RS * GW;
  const int vc = 2 * GW + h * HD + sp * 4;
  const f4 mu0 = ld4(p.rw_mu + (size_t)(l * 2 + 0) * RWSH + vc), mu1 = ld4(p.rw_mu + (size_t)(l * 2 + 1) * RWSH + vc);
  f4 rg[5], rv;
  auto load = [&](int c) {
    const int pp = scan_pos(dir, c * SCT + st), row = bl * RPB + pp;
    const size_t o = (size_t)row * GW + h * HD + sp * 4;
    rg[0] = ld4(p.RW + 0 * AS + o);
    rg[1] = ld4(p.RW + 1 * AS + o);
    rg[2] = ld4(p.RW + (size_t)(2 + dir) * AS + o);
    rg[3] = ld4(p.RW + (size_t)(4 + dir) * AS + o);
    rg[4] = ld4(p.RW + (size_t)(6 + dir) * AS + o);
    const bf16_t* pr = p.PROJ + (size_t)row * LDP + OFF_RW + vc;
    f4 x = ldbf4(pr), xm = x, xp = x;
    xm.x = xm.y = xm.z = xm.w = 0.f; xp = xm;
    if (has_prev(pp)) xm = ldbf4(pr - LDP);
    if (has_next(pp)) xp = ldbf4(pr + LDP);
    rv.x = x.x + mu0.x * (xm.x - x.x) + mu1.x * (xp.x - x.x);
    rv.y = x.y + mu0.y * (xm.y - x.y) + mu1.y * (xp.y - x.y);
    rv.z = x.z + mu0.z * (xm.z - x.z) + mu1.z * (xp.z - x.z);
    rv.w = x.w + mu0.w * (xm.w - x.w) + mu1.w * (xp.w - x.w);
  };
  load(0);
  for (int c = 0; c < NCHUNK; ++c) {
    __syncthreads();
#pragma unroll
    for (int a = 0; a < 5; ++a) st4(lds + (st * 6 + a) * 64 + sp * 4, rg[a]);
    st4(lds + (st * 6 + 5) * 64 + sp * 4, rv);
    __syncthreads();
    if (c + 1 < NCHUNK) load(c + 1);
#pragma nounroll
    for (int t = 0; t < SCT; ++t) {
      const float* L = lds + t * 6 * 64 + kq * 8;
      const float vv = lds[(t * 6 + 5) * 64 + i];
      float a_r[8], a_k[8], a_w[8], a_d[8], a_b[8];
      ld8(a_k, L + 1 * 64);
      ld8(a_w, L + 2 * 64);
      ld8(a_d, L + 3 * 64);
      ld8(a_b, L + 4 * 64);
      ld8(a_r, L + 0 * 64);
      float sa4[4] = {0.f, 0.f, 0.f, 0.f};
#pragma unroll
      for (int d = 0; d < 8; ++d) sa4[d & 3] = fmaf(S[d], a_k[d], sa4[d & 3]);
      const float sa = -oct_sum((sa4[0] + sa4[1]) + (sa4[2] + sa4[3]));
      float y4[4] = {0.f, 0.f, 0.f, 0.f};
#pragma unroll
      for (int d = 0; d < 8; ++d) {
        S[d] = fmaf(S[d], a_w[d], fmaf(sa, a_b[d], vv * a_d[d]));
        y4[d & 3] = fmaf(S[d], a_r[d], y4[d & 3]);
      }
      const float y = oct_sum((y4[0] + y4[1]) + (y4[2] + y4[3]));
      if (kq == 0) {
        const int row = bl * RPB + scan_pos(dir, c * SCT + t);
        H[(size_t)row * 3 * GW + 2 * GW + h * HD + i] = y;
      }
    }
  }
}
__device__ __forceinline__ void bscan_mlstm(const P& p, int bl, int h, int dir, int half, float* lds, int tid) {
  const int i = half * 32 + (tid >> 3), kq = tid & 7, st = tid >> 4, sp = tid & 15;
  float C[8], n[8];
#pragma unroll
  for (int d = 0; d < 8; ++d) { C[d] = 0.f; n[d] = 0.f; }
  float m = 0.f;
  float* H = dir ? p.HB : p.HF;
  f4 rq, rk, rv;
  float g0 = 0.f, g1 = 0.f;
  auto load = [&](int c) {
    const int pp = scan_pos(dir, c * SCT + st), row = bl * RPB + pp;
    const float* q = p.MQK + (size_t)row * 2 * GW + h * HD + sp * 4;
    rq = ld4(q);
    rk = ld4(q + GW);
    rv = ldbf4(p.PROJ + (size_t)row * LDP + OFF_ML + 2 * GW + h * HD + sp * 4);
    if (sp == 0) {
      const float* mg = p.MG + (size_t)row * 4 * NH;
      g0 = mg[(dir ? 2 : 0) * NH + h];
      g1 = mg[(dir ? 3 : 1) * NH + h];
    }
  };
  load(0);
  for (int c = 0; c < NCHUNK; ++c) {
    __syncthreads();
    st4(lds + (st * 4 + 0) * 64 + sp * 4, rq);
    st4(lds + (st * 4 + 1) * 64 + sp * 4, rk);
    st4(lds + (st * 4 + 2) * 64 + sp * 4, rv);
    if (sp == 0) { lds[(st * 4 + 3) * 64 + 0] = g0; lds[(st * 4 + 3) * 64 + 1] = g1; }
    __syncthreads();
    if (c + 1 < NCHUNK) load(c + 1);
#pragma nounroll
    for (int t = 0; t < SCT; ++t) {
      const float* L = lds + t * 4 * 64;
      const float ig = L[3 * 64 + 0], lf = L[3 * 64 + 1];
      const float mn = fmaxf(lf + m, ig);
      const float f = fexp_(lf + m - mn), ii = fexp_(ig - mn), em = fexp_(-mn);
      m = mn;
      const float iv = ii * L[2 * 64 + i];
      float a_q[8], a_k[8];
      ld8(a_q, L + kq * 8);
      ld8(a_k, L + 64 + kq * 8);
      float num4[4] = {0.f, 0.f, 0.f, 0.f}, den4[4] = {0.f, 0.f, 0.f, 0.f};
#pragma unroll
      for (int d = 0; d < 8; ++d) {
        const float kd = a_k[d], qd = a_q[d];
        C[d] = fmaf(kd, iv, f * C[d]);
        n[d] = fmaf(kd, ii, f * n[d]);
        num4[d & 3] = fmaf(qd, C[d], num4[d & 3]);
        den4[d & 3] = fmaf(qd, n[d], den4[d & 3]);
      }
      const float num = oct_sum((num4[0] + num4[1]) + (num4[2] + num4[3]));
      const float den = oct_sum((den4[0] + den4[1]) + (den4[2] + den4[3]));
      if (kq == 0) {
        const int row = bl * RPB + scan_pos(dir, c * SCT + t);
        H[(size_t)row * 3 * GW + 0 * GW + h * HD + i] = num * frcp_(fmaxf(fabsf(den), em));
      }
    }
  }
}
__device__ __forceinline__ void bscan_ret(const P& p, int bl, int h, int dir, int half, float* lds, int tid) {
  const int i = half * 32 + (tid >> 3), kq = tid & 7, st = tid >> 4, sp = tid & 15;
  float S[8];
#pragma unroll
  for (int d = 0; d < 8; ++d) S[d] = 0.f;
  const int hh = dir ? NH - 1 - h : h;
  const float gamma = 1.0f - exp2f(-5.0f - (float)hh);
  float* H = dir ? p.HB : p.HF;
  f4 rq, rk, rv;
  auto load = [&](int c) {
    const int pp = scan_pos(dir, c * SCT + st), row = bl * RPB + pp;
    const float* q = p.RQK + (size_t)row * 2 * GW + h * HD + sp * 4;
    rq = ld4(q);
    rk = ld4(q + GW);
    rv = ldbf4(p.PROJ + (size_t)row * LDP + OFF_RT + 2 * GW + h * HD + sp * 4);
  };
  load(0);
  for (int c = 0; c < NCHUNK; ++c) {
    __syncthreads();
    st4(lds + (st * 4 + 0) * 64 + sp * 4, rq);
    st4(lds + (st * 4 + 1) * 64 + sp * 4, rk);
    st4(lds + (st * 4 + 2) * 64 + sp * 4, rv);
    __syncthreads();
    if (c + 1 < NCHUNK) load(c + 1);
#pragma nounroll
    for (int t = 0; t < SCT; ++t) {
      const float* L = lds + t * 4 * 64;
      const float v = L[2 * 64 + i];
      float a_q[8], a_k[8];
      ld8(a_q, L + kq * 8);
      ld8(a_k, L + 64 + kq * 8);
      float o4[4] = {0.f, 0.f, 0.f, 0.f};
#pragma unroll
      for (int d = 0; d < 8; ++d) {
        S[d] = fmaf(S[d], gamma, a_k[d] * v);
        o4[d & 3] = fmaf(a_q[d], S[d], o4[d & 3]);
      }
      const float o = oct_sum((o4[0] + o4[1]) + (o4[2] + o4[3]));
      if (kq == 0) {
        const int row = bl * RPB + scan_pos(dir, c * SCT + t);
        H[(size_t)row * 3 * GW + 1 * GW + h * HD + i] = o;
      }
    }
  }
}
#define NSCAN (3 * SB * NH * 2 * 2)
__device__ __forceinline__ void ph_scan(const P& p, int l, int s, int gtid, int gsize, float* lds, int tid) {
  for (int w = blockIdx.x; w < NSCAN; w += gridDim.x) {
    int mixer = w / (SB * NH * 4), r = w % (SB * NH * 4);
    int half = r & 1, dir = (r >> 1) & 1, h = (r >> 2) % NH, bl = (r >> 2) / NH;
    if (mixer == 0) bscan_rwkv(p, l, bl, h, dir, half, lds, tid);
    else if (mixer == 1) bscan_mlstm(p, bl, h, dir, half, lds, tid);
    else bscan_ret(p, bl, h, dir, half, lds, tid);
    __syncthreads();
  }
#if SB == 8
  {
    int* sh = (int*)lds;
    const int nitem = hyena_mfma_items(l);
    for (;;) {
      __syncthreads();
      if (tid == 0) sh[0] = atomicAdd(p.ctr, 1);
      __syncthreads();
      const int it = sh[0];
      if (it >= nitem) break;
      hyena_mfma_item<1>(p, l, it, (bf16_t*)lds, tid);
    }
  }
#else
  for (int it = gtid; it < hyena_items(l); it += gsize) hyena_conv_item<1>(p, l, it);
#endif
}

#define NE (HD / WL)
__device__ __forceinline__ void ph_fin(const P& p, int l, int s, int gtid, int gsize) {
  const bool last = (l == DEPTH - 1);
  const int lane = gtid % WL, gw = gtid / WL, nw = gsize / WL;
  for (int item = gw; item < (RS / 4) * 4 * NH; item += nw) {
    const int hg = item % (4 * NH), row0 = (item / (4 * NH)) * 4, pp0 = row0 % RPB;
    if (last && pp0 < CTX) continue;
    const int g = hg / NH, h = hg % NH;
    const int c0 = g * GW + h * HD;
    float val[4][NE];
#pragma unroll
    for (int r = 0; r < 4; ++r) {
      const int row = row0 + r;
#pragma unroll
      for (int e = 0; e < NE; ++e) {
        const int i = e * WL + lane;
        float v;
        if (g == 1) v = p.HY[(size_t)row * GW + h * HD + i];
        else {
          const int slot = (g == 0) ? 0 : (g == 2 ? 1 : 2);
          const size_t o = (size_t)row * 3 * GW + slot * GW + h * HD + i;
          v = p.HF[o] + p.HB[o];
        }
        val[r][e] = v;
      }
    }
    float mu[4], rs[4];
#pragma unroll
    for (int r = 0; r < 4; ++r) {
      float sm = 0.f;
#pragma unroll
      for (int e = 0; e < NE; ++e) sm += val[r][e];
      mu[r] = wave_sum(sm) * (1.0f / HD);
    }
#pragma unroll
    for (int r = 0; r < 4; ++r) {
      float q = 0.f;
#pragma unroll
      for (int e = 0; e < NE; ++e) { float d = val[r][e] - mu[r]; q += d * d; }
      rs[r] = 1.0f / sqrtf(wave_sum(q) * (1.0f / HD) + 1e-5f);
    }
#pragma unroll
    for (int r = 0; r < 4; ++r) {
      const int row = row0 + r;
#pragma unroll
      for (int e = 0; e < NE; ++e) {
        const int i = e * WL + lane;
        float v = (val[r][e] - mu[r]) * rs[r] * p.ng[l * DM + c0 + i] + p.nb[l * DM + c0 + i];
        if (g == 0) v *= sigmoidf_(PJ(row, OFF_ML + 3 * GW + h * HD + i));
        else if (g == 2) v *= siluf_(PJ(row, OFF_RT + 3 * GW + h * HD + i));
        else if (g == 3) v = p.GG[(size_t)row * GW + h * HD + i] * (v + p.BON[(size_t)row * GW + h * HD + i]);
        p.U[(size_t)row * DM + c0 + i] = f2bf(v);
      }
    }
  }
}

__device__ __forceinline__ void ph_act(const P& p, int l, int s, int gtid, int gsize) {
  const bool last = (l == DEPTH - 1);
  const float* cw = p.f_cw + (size_t)l * 3 * DFF;
  const float* cb = p.f_cb + (size_t)l * DFF;
  for (int it = gtid; it < RS * (DFF / 8); it += gsize) {
    const int j = (it % (DFF / 8)) * 8, row = it / (DFF / 8), pp = row % RPB;
    if (last && pp < CTX) continue;
    const bf16_t* hr = p.HFF + (size_t)row * 2 * DFF;
    unsigned am[4] = {0u, 0u, 0u, 0u}, a0[4], ap[4] = {0u, 0u, 0u, 0u}, bv[4], ov[4];
#pragma unroll
    for (int e = 0; e < 4; ++e) { a0[e] = ((const unsigned*)(hr + j))[e]; bv[e] = ((const unsigned*)(hr + DFF + j))[e]; }
    if (has_prev(pp)) {
#pragma unroll
      for (int e = 0; e < 4; ++e) am[e] = ((const unsigned*)(hr - 2 * DFF + j))[e];
    }
    if (has_next(pp)) {
#pragma unroll
      for (int e = 0; e < 4; ++e) ap[e] = ((const unsigned*)(hr + 2 * DFF + j))[e];
    }
#pragma unroll
    for (int e = 0; e < 4; ++e) {
      float o[2];
#pragma unroll
      for (int hh = 0; hh < 2; ++hh) {
        const int jj = j + 2 * e + hh;
        float xm = bf2f((bf16_t)(am[e] >> (16 * hh))), x0 = bf2f((bf16_t)(a0[e] >> (16 * hh))), xp = bf2f((bf16_t)(ap[e] >> (16 * hh)));
        float v = cw[jj] * xm + cw[DFF + jj] * x0 + cw[2 * DFF + jj] * xp + cb[jj];
        o[hh] = siluf_(v) * bf2f((bf16_t)(bv[e] >> (16 * hh)));
      }
      ov[e] = pack_bf16(o[0], o[1]);
    }
#pragma unroll
    for (int e = 0; e < 4; ++e) ((unsigned*)(p.ACT + (size_t)row * DFF + j))[e] = ov[e];
  }
}

enum { PH_PRO_A = 0, PH_PRO_B, PH_PRO_C, PH_LN0, PH_GEMM_IN, PH_PREP, PH_SCAN, PH_FIN, PH_GEMM_OUT, PH_LN1, PH_GEMM_UP, PH_ACT, PH_GEMM_DN, PH_LN2, PH_COUNT };

__device__ __forceinline__ void run_phase(const P& p, int ph, int l, int s, bf16_t* lds) {
  int tid = threadIdx.x;
#ifndef CPU_EMU
  asm volatile("" : "+v"(tid));
#endif
  const int gtid = blockIdx.x * blockDim.x + tid;
  const int gsize = gridDim.x * blockDim.x;
  const bool last = (l == DEPTH - 1);
  switch (ph) {
    case PH_PRO_A: ph_pro_a(p, gtid, gsize); break;
    case PH_PRO_B: ph_pro_b(p, gtid, gsize); break;
    case PH_PRO_C: ph_pro_c(p, gtid, gsize); break;
    case PH_LN0: ph_ln0(p, l, s, gtid, gsize); break;
    case PH_GEMM_IN: gemm_phase<true>(p.U, p.wt_in + (size_t)l * LDP * DM, p.PROJ, RS, LDP, DM, LDP, false, lds, tid); break;
    case PH_PREP: ph_prep(p, l, s, gtid, gsize, (float*)lds, tid); break;
    case PH_SCAN: ph_scan(p, l, s, gtid, gsize, (float*)lds, tid); break;
    case PH_FIN: ph_fin(p, l, s, gtid, gsize); break;
    case PH_GEMM_OUT: gemm_phase<false>(p.U, p.wt_out + (size_t)l * DM * DM, p.OUTF, RS, DM, DM, DM, last, lds, tid); break;
    case PH_LN1: ph_ln1(p, l, s, gtid, gsize); break;
    case PH_GEMM_UP: gemm_phase<true>(p.U, p.wt_up + (size_t)l * 2 * DFF * DM, p.HFF, RS, 2 * DFF, DM, 2 * DFF, last, lds, tid); break;
    case PH_ACT: ph_act(p, l, s, gtid, gsize); break;
    case PH_GEMM_DN: gemm_phase<false>(p.ACT, p.wt_dn + (size_t)l * DM * DFF, p.OUTF, RS, DM, DFF, DM, last, lds, tid); break;
    case PH_LN2: ph_ln2(p, l, s, gtid, gsize); break;
  }
}

#ifndef CPU_EMU
#define XB_TMO      128
#define XB_XCNT(j)  (256  + 64 * (j))
#define XB_XSUB(j)  (1280 + 64 * (j))
#define XB_XGEN(j)  (2304 + 64 * (j))
#define XB_TOP      3328
#define XB_TOPGEN   3392
#define XCD_BAR_WORDS 3456
#define XB_SPIN_CAP (1u << 22)
#define LAS __attribute__((address_space(3)))

__device__ __forceinline__ unsigned xb_ld(unsigned* p)              { return __hip_atomic_load(p, __ATOMIC_RELAXED, __HIP_MEMORY_SCOPE_AGENT); }
__device__ __forceinline__ unsigned xb_add(unsigned* p, unsigned v) { return __hip_atomic_fetch_add(p, v, __ATOMIC_RELAXED, __HIP_MEMORY_SCOPE_AGENT); }
__device__ __forceinline__ unsigned xb_xcc_id() { return (unsigned)__builtin_amdgcn_s_getreg((3 << 11) | 20) & 0xFu; }
#define XB_SPIN(cond, bar) do { unsigned _sp = 0; while (cond) { __builtin_amdgcn_s_sleep(1); \
    if ((++_sp & 255u) == 0u) { if (xb_ld(&(bar)[XB_TMO])) break; if (_sp > XB_SPIN_CAP) { atomicAdd(&(bar)[XB_TMO], 1u); break; } } } } while (0)

struct XcdBarrier {
    unsigned* bar; unsigned x;
    volatile LAS unsigned* st;
};

__device__ __forceinline__ XcdBarrier xcd_barrier_post(unsigned* bar, volatile LAS unsigned* st) {
    XcdBarrier b; b.bar = bar; b.x = xb_xcc_id(); b.st = st;
    if (threadIdx.x == 0) (void)xb_add(&bar[XB_XCNT(b.x)], 1u);
    return b;
}
__device__ __forceinline__ void xcd_barrier_complete(unsigned* bar, unsigned x, unsigned& nloc, unsigned& nx) {
    const unsigned G = gridDim.x * gridDim.y * gridDim.z;
    unsigned sum, cnt, mine, sp = 0u;
    for (;;) {
        sum = 0u; cnt = 0u; mine = 0u;
#pragma unroll
        for (unsigned j = 0; j < 16; ++j) { const unsigned c = xb_ld(&bar[XB_XCNT(j)]); sum += c; cnt += (c > 0u) ? 1u : 0u; mine = (j == x) ? c : mine; }
        if (sum == G) break;
        __builtin_amdgcn_s_sleep(1);
        if ((++sp & 255u) == 0u) { if (xb_ld(&bar[XB_TMO])) break; if (sp > XB_SPIN_CAP) { atomicAdd(&bar[XB_TMO], 1u); break; } }
    }
    nloc = mine > 0u ? mine : 1u; nx = cnt > 0u ? cnt : 1u;
}

__device__ __forceinline__ void xcd_barrier(const XcdBarrier& b) {
    asm volatile("s_waitcnt vmcnt(0)" ::: "memory");
    __syncthreads();
    if (threadIdx.x == 0) {
        unsigned* bar = b.bar;
        __builtin_amdgcn_s_waitcnt(0);
        unsigned nloc = b.st[0], nx = b.st[1];
        if (nloc == 0u) { xcd_barrier_complete(bar, b.x, nloc, nx); b.st[0] = nloc; b.st[1] = nx; }
        const unsigned old = xb_add(&bar[XB_XSUB(b.x)], 1u);
        const unsigned gen = old / nloc;
        if (old + 1u == (gen + 1u) * nloc) {
            __builtin_amdgcn_fence(__ATOMIC_RELEASE, "agent");
            asm volatile("s_waitcnt vmcnt(0)" ::: "memory");
            const unsigned og = xb_add(&bar[XB_TOP], 1u);
            const unsigned tg = og / nx;
            if (og + 1u == (tg + 1u) * nx) xb_add(&bar[XB_TOPGEN], 1u);
            else XB_SPIN(xb_ld(&bar[XB_TOPGEN]) == tg, bar);
            __builtin_amdgcn_fence(__ATOMIC_ACQUIRE, "agent");
            xb_add(&bar[XB_XGEN(b.x)], 1u);
            asm volatile("s_waitcnt vmcnt(0)" ::: "memory");
        } else {
            XB_SPIN(xb_ld(&bar[XB_XGEN(b.x)]) == gen, bar);
            __builtin_amdgcn_fence(__ATOMIC_ACQUIRE, "agent");
            asm volatile("s_waitcnt vmcnt(0)" ::: "memory");
        }
    }
    __syncthreads();
}

#endif

#ifndef PROBE_MASK
#define PROBE_MASK 0
#endif
#if PROBE_MASK
#define RUNPH(ph) do { int reps_ = 1 + ((PROBE_MASK >> ph) & 1); asm volatile("" : "+s"(reps_)); for (int q_ = 0; q_ < reps_; ++q_) { run_phase(p, ph, l, s, lds); GSYNC(); } } while (0)
#else
#define RUNPH(ph) do { run_phase(p, ph, l, s, lds); GSYNC(); } while (0)
#endif
#ifndef CPU_EMU
__global__ void __launch_bounds__(256, 2) k_mega(P p) {
  __shared__ __attribute__((aligned(16))) bf16_t lds[24576];
  __shared__ uint4 xb_words;
  cg::grid_group grid = cg::this_grid();
  if (threadIdx.x == 0) xb_words = make_uint4(0u, 0u, 0u, 0u);
  __syncthreads();
  XcdBarrier xb = xcd_barrier_post(p.bar, (volatile LAS unsigned*)&xb_words);
#define GSYNC() xcd_barrier(xb)
  run_phase(p, PH_PRO_A, 0, 0, lds);
  grid.sync();
  run_phase(p, PH_PRO_B, 0, 0, lds);
  GSYNC();
  run_phase(p, PH_PRO_C, 0, 0, lds);
  GSYNC();
  for (int l = 0; l < DEPTH; ++l)
    for (int s = 0; s < NSLICE; ++s)
    {
      RUNPH(PH_LN0);
      RUNPH(PH_GEMM_IN);
      RUNPH(PH_PREP);
      RUNPH(PH_SCAN);
      RUNPH(PH_FIN);
      RUNPH(PH_GEMM_OUT);
      RUNPH(PH_LN1);
      RUNPH(PH_GEMM_UP);
      RUNPH(PH_ACT);
      RUNPH(PH_GEMM_DN);
      RUNPH(PH_LN2);
    }
}
#endif

static size_t ws_take(size_t& off, size_t bytes) { size_t o = off; off += (bytes + 255) & ~(size_t)255; return o; }

static void build_params(P& p, void* const* d_in, void* d_out, void* d_ws) {
  const float** f = (const float**)&p;
  for (int i = 0; i < 39; ++i) f[i] = (const float*)d_in[i];
  p.out = (float*)d_out;
  char* w = (char*)d_ws;
  size_t off = 0;
  p.wt_in = (bf16_t*)(w + ws_take(off, (size_t)DEPTH * LDP * DM * 2));
  p.wt_out = (bf16_t*)(w + ws_take(off, (size_t)DEPTH * DM * DM * 2));
  p.wt_up = (bf16_t*)(w + ws_take(off, (size_t)DEPTH * 2 * DFF * DM * 2));
  p.wt_dn = (bf16_t*)(w + ws_take(off, (size_t)DEPTH * DM * DFF * 2));
  p.kf_lat = (float*)(w + ws_take(off, (size_t)DEPTH * 2 * 2 * SEQ * GW * 4));
  p.kf_ctx = (float*)(w + ws_take(off, (size_t)DEPTH * 2 * 2 * CTX * GW * 4));
  p.kt_lat = (bf16_t*)(w + ws_take(off, (size_t)DEPTH * 2 * 2 * SEQ * GW * 2));
  p.kt_ctx = (bf16_t*)(w + ws_take(off, (size_t)DEPTH * 2 * 2 * CTX * GW * 2));
  p.ropec = (float*)(w + ws_take(off, 64 * 16 * 4));
  p.ropes = (float*)(w + ws_take(off, 64 * 16 * 4));
  p.hyh1 = (float*)(w + ws_take(off, (size_t)DEPTH * 2 * SEQ * 64 * 4));
  p.hyh2 = (float*)(w + ws_take(off, (size_t)DEPTH * 2 * SEQ * 64 * 4));
  p.scv = (float*)(w + ws_take(off, (size_t)NMOD * DM * 4));
  p.modtab = (float*)(w + ws_take(off, (size_t)DEPTH * NMOD * 6 * DM * 4));
  p.xc = (float*)(w + ws_take(off, (size_t)NB * CTX * DM * 4));
  p.ctr = (int*)(w + ws_take(off, 256));
  p.bar = (unsigned*)(w + ws_take(off, 16384));
  p.U = (bf16_t*)(w + ws_take(off, (size_t)RS * DM * 2));
  size_t arena = off;
  p.PROJ = (bf16_t*)(w + ws_take(off, (size_t)RS * LDP * 2));
  p.MQK = (float*)(w + ws_take(off, (size_t)RS * 2 * GW * 4));
  p.MG = (float*)(w + ws_take(off, (size_t)RS * 4 * NH * 4));
  p.RQK = (float*)(w + ws_take(off, (size_t)RS * 2 * GW * 4));
  p.RW = (float*)(w + ws_take(off, (size_t)8 * RS * GW * 4));
  p.HF = (float*)(w + ws_take(off, (size_t)RS * 3 * GW * 4));
  p.HB = (float*)(w + ws_take(off, (size_t)RS * 3 * GW * 4));
  p.Z2 = (float*)(w + ws_take(off, (size_t)RS * GW * 4));
  p.HY = (float*)(w + ws_take(off, (size_t)RS * GW * 4));
  p.BON = (float*)(w + ws_take(off, (size_t)RS * GW * 4));
  p.GG = (float*)(w + ws_take(off, (size_t)RS * GW * 4));
  size_t off2 = arena;
  p.OUTF = (float*)(w + ws_take(off2, (size_t)RS * DM * 4));
  p.HFF = (bf16_t*)(w + ws_take(off2, (size_t)RS * 2 * DFF * 2));
  p.ACT = (bf16_t*)(w + ws_take(off2, (size_t)RS * DFF * 2));
}

#ifndef CPU_EMU
extern "C" void kernel_launch(void* const* d_in, const int* in_sizes, int n_in, void* d_out, int out_size, void* d_ws, size_t ws_size,
                              hipStream_t stream) {
  static int grid_blocks = 0;
  if (!grid_blocks) {
    int dev = 0, cus = 0, per_cu = 0;
    hipGetDevice(&dev);
    hipDeviceGetAttribute(&cus, hipDeviceAttributeMultiprocessorCount, dev);
    hipOccupancyMaxActiveBlocksPerMultiprocessor(&per_cu, k_mega, 256, 0);
    if (per_cu < 1) per_cu = 1;
    grid_blocks = cus * per_cu;
  }
  P p;
  memset(&p, 0, sizeof(p));
  build_params(p, d_in, d_out, d_ws);
  hipMemsetAsync(p.bar, 0, XCD_BAR_WORDS * sizeof(unsigned), stream);
  void* args[] = {&p};
  hipError_t e = hipLaunchCooperativeKernel((void*)k_mega, dim3(grid_blocks), dim3(256), args, 0, stream);
  if (e != hipSuccess) fprintf(stderr, "cooperative launch failed: %s (grid %d)\n", hipGetErrorString(e), grid_blocks);
}
#endif
```

```cpp
#ifndef CPU_EMU
#include <hip/hip_runtime.h>
#include <hip/hip_cooperative_groups.h>
#include <cstdio>
#include <cstring>
namespace cg = cooperative_groups;
#endif
#include <stdint.h>

#if !defined(CFG_SMALL) && !defined(CFG_CONVTEST)
#define DM 1024
#define NB 32
#define SEQ 2048
#define CTX 256
#define DFF 2816
#define SB 8
#elif defined(CFG_CONVTEST)
#define DM 512
#define NB 8
#define SEQ 256
#define CTX 128
#define DFF 192
#define SB 8
#else
#define DM 512
#define NB 2
#define SEQ 256
#define CTX 128
#define DFF 192
#define SB 1
#endif
#define DEPTH 2
#define GRIDW 64
#define HD 64
#define GW (DM / 4)
#define NH (GW / HD)
#define DPROJ (14 * GW + 4 * NH + 128)
#define LDP ((DPROJ + 127) / 128 * 128)
#define OFF_ML 0
#define OFF_HY (4 * GW + 4 * NH)
#define OFF_RT (OFF_HY + 3 * GW)
#define OFF_RW (OFF_RT + 4 * GW)
#define RWSH (3 * GW + 128)
#define RPB (CTX + SEQ)
#define RS (SB * RPB)
#define NSLICE (NB / SB)
#define ALPHA 1.41421356237309515f
#define NMOD 33
#ifdef CPU_EMU
#define WL 1
#else
#define WL 64
#endif

typedef unsigned short bf16_t;

struct P {
  const float *x, *c, *ctx, *c_ctx, *ada_w, *ada_b, *w_in, *ml_cw, *ml_cb, *ml_gb, *hy_cw, *hy_cb, *hy_w1, *hy_b1, *hy_w2, *hy_b2, *hy_w3,
      *hy_freq, *hy_d, *rw_mu, *rw_w0, *rw_w2, *rw_a0, *rw_a2, *rw_g2, *rw_kk, *rw_ka, *rw_rk, *ng, *nb, *w_out, *ln1g, *ln1b, *w_up, *f_cw,
      *f_cb, *w_dn, *ln2g, *ln2b;
  float* out;
  bf16_t *wt_in, *wt_out, *wt_up, *wt_dn;
  float *kf_lat, *kf_ctx, *hyh1, *hyh2, *scv, *modtab, *xc;
  bf16_t *kt_lat, *kt_ctx;
  float *ropec, *ropes;
  bf16_t *U, *PROJ;
  float *MQK, *MG, *RQK, *RW, *HF, *HB, *Z2, *HY, *BON, *GG;
  float* OUTF;
  bf16_t *HFF, *ACT;
  int* ctr;
  unsigned* bar;
};

__device__ __forceinline__ bf16_t f2bf(float f) {
  unsigned u = __float_as_uint(f);
  u += 0x7fffu + ((u >> 16) & 1u);
  return (bf16_t)(u >> 16);
}
#ifndef CPU_EMU
typedef __bf16 bf16v2_t __attribute__((ext_vector_type(2)));
typedef float f32x2_t __attribute__((ext_vector_type(2)));
#endif
__device__ __forceinline__ unsigned pack_bf16(float lo, float hi) {
#ifndef CPU_EMU
  f32x2_t v = {lo, hi};
  bf16v2_t b = __builtin_convertvector(v, bf16v2_t);
  return __builtin_bit_cast(unsigned, b);
#else
  return f2bf(lo) | ((unsigned)f2bf(hi) << 16);
#endif
}
__device__ __forceinline__ float bf2f(bf16_t h) { return __uint_as_float(((unsigned)h) << 16); }
#ifndef CPU_EMU
__device__ __forceinline__ float fexp_(float x) { return __expf(x); }
__device__ __forceinline__ float frcp_(float x) { return __builtin_amdgcn_rcpf(x); }
#else
__device__ __forceinline__ float fexp_(float x) { return expf(x); }
__device__ __forceinline__ float frcp_(float x) { return 1.0f / x; }
#endif
#ifndef CPU_EMU
__device__ __forceinline__ float sigmoidf_(float x) { return frcp_(1.0f + fexp_(-x)); }
__device__ __forceinline__ float siluf_(float x) { return x * frcp_(1.0f + fexp_(-x)); }
__device__ __forceinline__ float softplusf_(float x) { return fmaxf(x, 0.0f) + log1pf(expf(-fabsf(x))); }
__device__ __forceinline__ float tanhf_(float x) { return 1.0f - 2.0f * frcp_(1.0f + fexp_(2.0f * x)); }
#else
__device__ __forceinline__ float sigmoidf_(float x) { return 1.0f / (1.0f + expf(-x)); }
__device__ __forceinline__ float siluf_(float x) { return x / (1.0f + expf(-x)); }
__device__ __forceinline__ float softplusf_(float x) { return fmaxf(x, 0.0f) + log1pf(expf(-fabsf(x))); }
__device__ __forceinline__ float tanhf_(float x) { return tanhf(x); }
#endif
__device__ __forceinline__ float logsigmoidf_(float x) { return -softplusf_(-x); }

__device__ __forceinline__ float wave_sum(float v) {
#ifndef CPU_EMU
#pragma unroll
  for (int o = 32; o > 0; o >>= 1) v += __shfl_xor(v, o, 64);
#endif
  return v;
}

#ifndef CPU_EMU
typedef float f4 __attribute__((ext_vector_type(4)));
typedef unsigned u2v __attribute__((ext_vector_type(2)));
__device__ __forceinline__ f4 ld4(const float* a) { return *(const f4*)a; }
__device__ __forceinline__ void st4(float* a, f4 v) { *(f4*)a = v; }
__device__ __forceinline__ f4 ldbf4(const bf16_t* a) {
  u2v u = *(const u2v*)a;
  f4 r;
  r.x = __uint_as_float(u.x << 16); r.y = __uint_as_float(u.x & 0xffff0000u);
  r.z = __uint_as_float(u.y << 16); r.w = __uint_as_float(u.y & 0xffff0000u);
  return r;
}
#else
struct f4 { float x, y, z, w; };
__device__ __forceinline__ f4 ld4(const float* a) { f4 r; r.x = a[0]; r.y = a[1]; r.z = a[2]; r.w = a[3]; return r; }
__device__ __forceinline__ void st4(float* a, f4 v) { a[0] = v.x; a[1] = v.y; a[2] = v.z; a[3] = v.w; }
__device__ __forceinline__ f4 ldbf4(const bf16_t* a) { f4 r; r.x = bf2f(a[0]); r.y = bf2f(a[1]); r.z = bf2f(a[2]); r.w = bf2f(a[3]); return r; }
#endif
__device__ __forceinline__ void ld8(float* dst, const float* src) {
#pragma unroll
  for (int j = 0; j < 2; ++j) { f4 v = ld4(src + 4 * j); dst[4 * j] = v.x; dst[4 * j + 1] = v.y; dst[4 * j + 2] = v.z; dst[4 * j + 3] = v.w; }
}
__device__ __forceinline__ void ld16(float* dst, const float* src) {
#pragma unroll
  for (int j = 0; j < 4; ++j) { f4 v = ld4(src + 4 * j); dst[4 * j] = v.x; dst[4 * j + 1] = v.y; dst[4 * j + 2] = v.z; dst[4 * j + 3] = v.w; }
}


__device__ __forceinline__ const float* xsrc_row(const P& p, int l, int b, int pp) {
  if (pp < CTX) return (l == 0 ? p.ctx : p.xc) + ((size_t)b * CTX + pp) * DM;
  return (l == 0 ? p.x : p.out) + ((size_t)b * SEQ + (pp - CTX)) * DM;
}
__device__ __forceinline__ float* xdst_row(const P& p, int b, int pp) {
  if (pp < CTX) return p.xc + ((size_t)b * CTX + pp) * DM;
  return p.out + ((size_t)b * SEQ + (pp - CTX)) * DM;
}
__device__ __forceinline__ bool has_prev(int pp) { return pp != 0 && pp != CTX; }
__device__ __forceinline__ bool has_next(int pp) { return pp != CTX - 1 && pp != RPB - 1; }

__device__ __forceinline__ void cvt_weight(const float* W, bf16_t* Wt, int K, int N, int Npad, int gtid, int gsize) {
  const int nk8 = K / 8;
  for (long it = gtid; it < (long)nk8 * Npad; it += gsize) {
    int n = (int)(it % Npad), k8 = (int)(it / Npad);
    bf16_t v[8];
#pragma unroll
    for (int j = 0; j < 8; ++j) v[j] = (n < N) ? f2bf(W[(size_t)(k8 * 8 + j) * N + n]) : (bf16_t)0;
    uint4 o;
    o.x = v[0] | ((unsigned)v[1] << 16); o.y = v[2] | ((unsigned)v[3] << 16);
    o.z = v[4] | ((unsigned)v[5] << 16); o.w = v[6] | ((unsigned)v[7] << 16);
    *(uint4*)(Wt + (size_t)n * K + k8 * 8) = o;
  }
}
__device__ __forceinline__ void hy_feat_h1(const P& p, int gtid, int gsize) {
  const int per_l = (SEQ + CTX) * 64;
  for (int it = gtid; it < DEPTH * per_l; it += gsize) {
    int l = it / per_l, r = it % per_l;
    int i, L, seg;
    int j = r % 64; r /= 64;
    if (r < SEQ) { seg = 0; i = r; L = SEQ; } else { seg = 1; i = r - SEQ; L = CTX; }
    const float* w1 = p.hy_w1 + (size_t)l * 33 * 64;
    float t = (float)i / (float)(L - 1);
    float ang = 6.283185307179586f * (float)i / (float)L;
    float acc = t * w1[j];
    for (int b = 0; b < 16; ++b) {
      float band = 1e-4f + (float)b * ((15.0f - 1e-4f) / 15.0f);
      float a = band * ang;
      acc += cosf(a) * w1[(1 + b) * 64 + j];
      acc -= sinf(a) * w1[(17 + b) * 64 + j];
    }
    float h = sinf(p.hy_freq[l * 64 + j] * (acc + p.hy_b1[l * 64 + j]));
    p.hyh1[((size_t)(l * 2 + seg) * SEQ + i) * 64 + j] = h;
  }
}
__device__ __forceinline__ void ph_pro_a(const P& p, int gtid, int gsize) {
  for (int l = 0; l < DEPTH; ++l) {
    cvt_weight(p.w_in + (size_t)l * DM * DPROJ, p.wt_in + (size_t)l * LDP * DM, DM, DPROJ, LDP, gtid, gsize);
    cvt_weight(p.w_out + (size_t)l * DM * DM, p.wt_out + (size_t)l * DM * DM, DM, DM, DM, gtid, gsize);
    cvt_weight(p.w_up + (size_t)l * DM * 2 * DFF, p.wt_up + (size_t)l * 2 * DFF * DM, DM, 2 * DFF, 2 * DFF, gtid, gsize);
    cvt_weight(p.w_dn + (size_t)l * DFF * DM, p.wt_dn + (size_t)l * DM * DFF, DFF, DM, DM, gtid, gsize);
  }
  for (int it = gtid; it < NMOD * DM; it += gsize) {
    int r = it / DM, k = it % DM;
    float v = (r < NB) ? p.c[(size_t)r * DM + k] : p.c_ctx[k];
    p.scv[it] = siluf_(v);
  }
  hy_feat_h1(p, gtid, gsize);
  for (int it = gtid; it < 64 * 16; it += gsize) {
    float a = (float)(it / 16) * powf(10000.0f, -(float)(it % 16) / 16.0f);
    p.ropec[it] = cosf(a);
    p.ropes[it] = sinf(a);
  }
}
__device__ __forceinline__ void ph_pro_b(const P& p, int gtid, int gsize) {
  for (int it = gtid; it < DEPTH * NMOD * 6 * DM; it += gsize) {
    int j = it % (6 * DM), r = (it / (6 * DM)) % NMOD, l = it / (6 * DM * NMOD);
    const float* w = p.ada_w + (size_t)l * DM * 6 * DM + j;
    const float* sv = p.scv + r * DM;
    float acc = 0.f;
    for (int k = 0; k < DM; ++k) acc += sv[k] * w[(size_t)k * 6 * DM];
    p.modtab[it] = acc + p.ada_b[l * 6 * DM + j];
  }
  const int per_l = (SEQ + CTX) * 64;
  for (int it = gtid; it < DEPTH * per_l; it += gsize) {
    int l = it / per_l, r = it % per_l;
    int j = r % 64; r /= 64;
    int seg = r < SEQ ? 0 : 1, i = r < SEQ ? r : r - SEQ;
    const float* h1 = p.hyh1 + ((size_t)(l * 2 + seg) * SEQ + i) * 64;
    const float* w2 = p.hy_w2 + (size_t)l * 64 * 64;
    float acc = 0.f;
    for (int k = 0; k < 64; ++k) acc += h1[k] * w2[k * 64 + j];
    p.hyh2[((size_t)(l * 2 + seg) * SEQ + i) * 64 + j] = sinf(p.hy_freq[l * 64 + j] * (acc + p.hy_b2[l * 64 + j]));
  }
}
__device__ __forceinline__ void ph_pro_c(const P& p, int gtid, int gsize) {
  const int per_l = 2 * (2 * SEQ + 2 * CTX) * GW;
  const float max_decay = -4.605170185988091f / 0.3f, min_decay = -4.605170185988091f / 1.5f;
  for (int it = gtid; it < DEPTH * per_l; it += gsize) {
    int l = it / per_l, r = it % per_l;
    int c = r % GW; r /= GW;
    int ord = r & 1; r >>= 1;
    int seg, idx, L;
    if (r < 2 * SEQ) { seg = 0; idx = r; L = SEQ; } else { seg = 1; idx = r - 2 * SEQ; L = CTX; }
    int d = idx - L;
    float val = 0.f;
    if (idx != 0) {
      int i = d < 0 ? -d : d;
      float ti = (float)i / (float)(L - 1);
      float delta = fabsf(min_decay + (float)c * ((max_decay - min_decay) / (float)(GW - 1)));
      float win = expf(-ti * delta);
      const float* h2 = p.hyh2 + ((size_t)(l * 2 + seg) * SEQ + i) * 64;
      const float* w3 = p.hy_w3 + (size_t)l * 64 * 4 * GW;
      float af = 0.f, ab = 0.f;
      for (int k = 0; k < 64; ++k) {
        float hv = h2[k];
        af += hv * w3[k * 4 * GW + 0 * 2 * GW + ord * GW + c];
        ab += hv * w3[k * 4 * GW + 1 * 2 * GW + ord * GW + c];
      }
      if (d > 0) val = af * win;
      else if (d < 0) val = ab * win;
      else val = (af + ab) * win + p.hy_d[(l * 2 + ord) * GW + c];
    }
    float* kf = seg == 0 ? p.kf_lat + ((size_t)(l * 2 + ord) * 2 * SEQ + idx) * GW : p.kf_ctx + ((size_t)(l * 2 + ord) * 2 * CTX + idx) * GW;
    kf[c] = val;
    if (seg == 0) p.kt_lat[((size_t)(l * 2 + ord) * GW + c) * 2 * SEQ + idx] = f2bf(val);
    else p.kt_ctx[((size_t)(l * 2 + ord) * GW + c) * 2 * CTX + idx] = f2bf(val);
  }
}

#define NV (DM / WL)
__device__ __forceinline__ void ln_inplace(float* v, int lane) {
  float s = 0.f;
#pragma unroll
  for (int i = 0; i < NV; ++i) s += v[i];
  s = wave_sum(s);
  float mu = s * (1.0f / DM);
  float q = 0.f;
#pragma unroll
  for (int i = 0; i < NV; ++i) { float d = v[i] - mu; q += d * d; }
  q = wave_sum(q);
  float rs = 1.0f / sqrtf(q * (1.0f / DM) + 1e-5f);
#pragma unroll
  for (int i = 0; i < NV; ++i) v[i] = (v[i] - mu) * rs;
}
__device__ __forceinline__ void ph_ln0(const P& p, int l, int s, int gtid, int gsize) {
  const int lane = gtid % WL, gw = gtid / WL, nw = gsize / WL;
  if (gtid == 0) *p.ctr = 0;
  for (int row = gw; row < RS; row += nw) {
    int bl = row / RPB, pp = row % RPB, b = s * SB + bl;
    const float* xr = xsrc_row(p, l, b, pp);
    const float* mod = p.modtab + ((size_t)l * NMOD + (pp < CTX ? NB : b)) * 6 * DM;
    float v[NV];
#pragma unroll
    for (int i = 0; i < NV; ++i) v[i] = xr[i * WL + lane];
    ln_inplace(v, lane);
#pragma unroll
    for (int i = 0; i < NV; ++i) {
      int k = i * WL + lane;
      p.U[(size_t)row * DM + k] = f2bf(v[i] * (1.0f + mod[DM + k]) + mod[k]);
    }
  }
}
__device__ __forceinline__ void ph_ln1(const P& p, int l, int s, int gtid, int gsize) {
  const int lane = gtid % WL, gw = gtid / WL, nw = gsize / WL;
  const bool last = (l == DEPTH - 1);
  for (int row = gw; row < RS; row += nw) {
    int bl = row / RPB, pp = row % RPB, b = s * SB + bl;
    if (last && pp < CTX) continue;
    const float* xr = xsrc_row(p, l, b, pp);
    float* xd = xdst_row(p, b, pp);
    const float* mod = p.modtab + ((size_t)l * NMOD + (pp < CTX ? NB : b)) * 6 * DM;
    const float* o = p.OUTF + (size_t)row * DM;
    float v[NV];
#pragma unroll
    for (int i = 0; i < NV; ++i) { int k = i * WL + lane; v[i] = ALPHA * xr[k] + mod[2 * DM + k] * o[k]; }
    ln_inplace(v, lane);
#pragma unroll
    for (int i = 0; i < NV; ++i) { int k = i * WL + lane; v[i] = v[i] * p.ln1g[l * DM + k] + p.ln1b[l * DM + k]; xd[k] = v[i]; }
    ln_inplace(v, lane);
#pragma unroll
    for (int i = 0; i < NV; ++i) {
      int k = i * WL + lane;
      p.U[(size_t)row * DM + k] = f2bf(v[i] * (1.0f + mod[4 * DM + k]) + mod[3 * DM + k]);
    }
  }
}
__device__ __forceinline__ void ph_ln2(const P& p, int l, int s, int gtid, int gsize) {
  const int lane = gtid % WL, gw = gtid / WL, nw = gsize / WL;
  const bool last = (l == DEPTH - 1);
  for (int row = gw; row < RS; row += nw) {
    int bl = row / RPB, pp = row % RPB, b = s * SB + bl;
    if (last && pp < CTX) continue;
    float* xd = xdst_row(p, b, pp);
    const float* mod = p.modtab + ((size_t)l * NMOD + (pp < CTX ? NB : b)) * 6 * DM;
    const float* o = p.OUTF + (size_t)row * DM;
    float v[NV];
#pragma unroll
    for (int i = 0; i < NV; ++i) { int k = i * WL + lane; v[i] = ALPHA * xd[k] + mod[5 * DM + k] * o[k]; }
    ln_inplace(v, lane);
#pragma unroll
    for (int i = 0; i < NV; ++i) { int k = i * WL + lane; xd[k] = v[i] * p.ln2g[l * DM + k] + p.ln2b[l * DM + k]; }
  }
}

#ifndef CPU_EMU
typedef short bf16x8 __attribute__((ext_vector_type(8)));
typedef float f32x4 __attribute__((ext_vector_type(4)));
typedef unsigned u32x4 __attribute__((ext_vector_type(4)));
__device__ __forceinline__ f32x4 mfma16(bf16x8 a, bf16x8 b, f32x4 c) { return __builtin_amdgcn_mfma_f32_16x16x32_bf16(a, b, c, 0, 0, 0); }
#define GBM 128
#define GBN 128
#define GBK 64
#define GLD (GBK + 8)
template <bool OUT_BF16>
__device__ __forceinline__ void gemm_phase(const bf16_t* __restrict__ A, const bf16_t* __restrict__ Bt, void* __restrict__ Cv, int M, int N, int K, int ldc,
                           bool skip_ctx, bf16_t* lds, int tid) {
  bf16_t* sA = lds;
  bf16_t* sB = lds + GBM * GLD;
  const int lane = tid & 63, wave = tid >> 6;
  const int wm = wave >> 1, wn = wave & 1;
  const int ntm = M / GBM, ntn = N / GBN;
  const int KT = K / GBK;
  const int lr = lane & 15, lq = lane >> 4;
  for (int tile = blockIdx.x; tile < ntm * ntn; tile += gridDim.x) {
    const int tm = tile / ntn, tn = tile % ntn;
    if (skip_ctx && (tm % (RPB / GBM)) < (CTX / GBM)) continue;
    const int m0 = tm * GBM, n0 = tn * GBN;
    f32x4 acc[4][4];
#pragma unroll
    for (int i = 0; i < 4; ++i)
#pragma unroll
      for (int j = 0; j < 4; ++j) acc[i][j] = (f32x4){0.f, 0.f, 0.f, 0.f};
    u32x4 ra[4], rb[4];
#pragma unroll
    for (int i = 0; i < 4; ++i) {
      int id = tid + i * 256, r = id >> 3, ch = id & 7;
      ra[i] = *(const u32x4*)(A + (size_t)(m0 + r) * K + ch * 8);
      rb[i] = *(const u32x4*)(Bt + (size_t)(n0 + r) * K + ch * 8);
    }
    for (int kt = 0; kt < KT; ++kt) {
      __syncthreads();
#pragma unroll
      for (int i = 0; i < 4; ++i) {
        int id = tid + i * 256, r = id >> 3, ch = id & 7;
        *(u32x4*)(sA + r * GLD + ch * 8) = ra[i];
        *(u32x4*)(sB + r * GLD + ch * 8) = rb[i];
      }
      __syncthreads();
      if (kt + 1 < KT) {
#pragma unroll
        for (int i = 0; i < 4; ++i) {
          int id = tid + i * 256, r = id >> 3, ch = id & 7;
          ra[i] = *(const u32x4*)(A + (size_t)(m0 + r) * K + (kt + 1) * GBK + ch * 8);
          rb[i] = *(const u32x4*)(Bt + (size_t)(n0 + r) * K + (kt + 1) * GBK + ch * 8);
        }
      }
#pragma unroll
      for (int kk = 0; kk < GBK; kk += 32) {
        bf16x8 fa[4], fb[4];
#pragma unroll
        for (int i = 0; i < 4; ++i) fa[i] = *(const bf16x8*)(sA + (wm * 64 + i * 16 + lr) * GLD + kk + lq * 8);
#pragma unroll
        for (int j = 0; j < 4; ++j) fb[j] = *(const bf16x8*)(sB + (wn * 64 + j * 16 + lr) * GLD + kk + lq * 8);
#pragma unroll
        for (int i = 0; i < 4; ++i)
#pragma unroll
          for (int j = 0; j < 4; ++j) acc[i][j] = __builtin_amdgcn_mfma_f32_16x16x32_bf16(fb[j], fa[i], acc[i][j], 0, 0, 0);
      }
    }
#pragma unroll
    for (int i = 0; i < 4; ++i)
#pragma unroll
      for (int j = 0; j < 4; ++j) {
        size_t off = (size_t)(m0 + wm * 64 + i * 16 + lr) * ldc + n0 + wn * 64 + j * 16 + lq * 4;
        if (OUT_BF16) {
          uint2 o;
          o.x = pack_bf16(acc[i][j][0], acc[i][j][1]);
          o.y = pack_bf16(acc[i][j][2], acc[i][j][3]);
          *(uint2*)((bf16_t*)Cv + off) = o;
        } else {
          *(float4*)((float*)Cv + off) = make_float4(acc[i][j][0], acc[i][j][1], acc[i][j][2], acc[i][j][3]);
        }
      }
  }
}
#else
template <bool OUT_BF16>
void gemm_phase(const bf16_t* A, const bf16_t* Bt, void* Cv, int M, int N, int K, int ldc, bool skip_ctx, bf16_t* lds, int tid) {
  int gtid = blockIdx.x * blockDim.x + threadIdx.x, gsize = gridDim.x * blockDim.x;
  for (long it = gtid; it < (long)M * N; it += gsize) {
    int m = (int)(it / N), n = (int)(it % N);
    if (skip_ctx && (m % RPB) < CTX) continue;
    float acc = 0.f;
    for (int k = 0; k < K; ++k) acc += bf2f(A[(size_t)m * K + k]) * bf2f(Bt[(size_t)n * K + k]);
    if (OUT_BF16) ((bf16_t*)Cv)[(size_t)m * ldc + n] = f2bf(acc);
    else ((float*)Cv)[(size_t)m * ldc + n] = acc;
  }
}
#endif

#define PJ(row, col) bf2f(p.PROJ[(size_t)(row) * LDP + (col)])
template <int ORD>
__device__ __forceinline__ void hyena_conv_item(const P& p, int l, int it) {
  const bool need_ctx = (l != DEPTH - 1);
  const int ntb = (need_ctx ? CTX / 16 : 0) + SEQ / 16;
  int c = it % GW, r = it / GW;
  int tb = r % ntb, bl = r / ntb;
  int seg0, L, t0;
  const float* kf;
  if (need_ctx && tb < CTX / 16) { seg0 = 0; L = CTX; t0 = tb * 16; kf = p.kf_ctx + (size_t)(l * 2 + ORD) * 2 * CTX * GW; }
  else { int tb2 = tb - (need_ctx ? CTX / 16 : 0); seg0 = CTX; L = SEQ; t0 = tb2 * 16; kf = p.kf_lat + (size_t)(l * 2 + ORD) * 2 * SEQ * GW; }
  const int rowbase = bl * RPB + seg0;
  const float* cw = p.hy_cw + (size_t)l * 3 * 3 * GW;
  const float* cb = p.hy_cb + (size_t)l * 3 * GW;
  float acc[16], F[31], u[16];
#pragma unroll
  for (int i = 0; i < 16; ++i) acc[i] = 0.f;
#pragma unroll
  for (int m = 0; m < 15; ++m) F[m] = kf[(size_t)(L + t0 + 1 + m) * GW + c];
  const float w0 = cw[0 * 3 * GW + c], w1 = cw[1 * 3 * GW + c], w2 = cw[2 * 3 * GW + c], bb = cb[c];
  float nF[16], nin[18];
  auto fetch = [&](int s0) {
#pragma unroll
    for (int m = 0; m < 16; ++m) nF[m] = kf[(size_t)(L + t0 - s0 - 15 + m) * GW + c];
    if (ORD == 0) {
#pragma unroll
      for (int j = 0; j < 18; ++j) {
        int sp = s0 - 1 + j;
        nin[j] = (sp >= 0 && sp < L) ? PJ(rowbase + sp, OFF_HY + c) : 0.f;
      }
    } else {
#pragma unroll
      for (int j = 0; j < 16; ++j) nin[j] = p.Z2[(size_t)(rowbase + s0 + j) * GW + c];
    }
  };
  fetch(0);
  for (int s0 = 0; s0 < L; s0 += 16) {
#pragma unroll
    for (int m = 14; m >= 0; --m) F[m + 16] = F[m];
#pragma unroll
    for (int m = 0; m < 16; ++m) F[m] = nF[m];
    if (ORD == 0) {
#pragma unroll
      for (int j = 0; j < 16; ++j) u[j] = w0 * nin[j] + w1 * nin[j + 1] + w2 * nin[j + 2] + bb;
    } else {
#pragma unroll
      for (int j = 0; j < 16; ++j) u[j] = nin[j];
    }
    if (s0 + 16 < L) fetch(s0 + 16);
#pragma unroll
    for (int j = 0; j < 16; ++j)
#pragma unroll
      for (int i = 0; i < 16; ++i) acc[i] += F[i - j + 15] * u[j];
  }
  const int xc = (ORD == 0 ? GW : 2 * GW) + c;
  const float v0 = cw[0 * 3 * GW + xc], v1 = cw[1 * 3 * GW + xc], v2 = cw[2 * 3 * GW + xc], vb = cb[xc];
#pragma unroll
  for (int i = 0; i < 16; ++i) {
    int t = t0 + i;
    float xm = t > 0 ? PJ(rowbase + t - 1, OFF_HY + xc) : 0.f;
    float x0 = PJ(rowbase + t, OFF_HY + xc);
    float xp = t < L - 1 ? PJ(rowbase + t + 1, OFF_HY + xc) : 0.f;
    float g = v0 * xm + v1 * x0 + v2 * xp + vb;
    float o = g * acc[i];
    if (ORD == 0) p.Z2[(size_t)(rowbase + t) * GW + c] = o;
    else p.HY[(size_t)(rowbase + t) * GW + c] = o;
  }
}
__device__ __forceinline__ int hyena_items(int l) { return SB * ((l != DEPTH - 1 ? CTX / 16 : 0) + SEQ / 16) * GW; }

#if SB == 8
#define HC_KOFF (SEQ + 32)
#define HC_KLEN (2 * SEQ + 64)
#define HC_ULS ((SEQ / 16 + 4) * 16)
template <int ORD>
__device__ __forceinline__ void hyena_mfma_item(const P& p, int l, int item, bf16_t* lds, int tid) {
  const int c = item % GW, seg = item / GW;
  const int L = seg ? CTX : SEQ, seg0 = seg ? 0 : CTX, NTB = L / 16;
  const bf16_t* kt = (seg ? p.kt_ctx + ((size_t)(l * 2 + ORD) * GW + c) * 2 * CTX : p.kt_lat + ((size_t)(l * 2 + ORD) * GW + c) * 2 * SEQ);
  bf16_t* KL = lds;
  bf16_t* UL = lds + HC_KLEN;
  const float* cw = p.hy_cw + (size_t)l * 3 * 3 * GW;
  const float* cb = p.hy_cb + (size_t)l * 3 * GW;
  __syncthreads();
  for (int n = -(L + 32) + tid; n < L + 32; n += 256) KL[HC_KOFF + n] = (n > -L && n < L) ? kt[L - n] : (bf16_t)0;
  for (int q = tid; q < SB * 4; q += 256) {
    int b = q >> 2, w = q & 3;
    bf16_t* dst = UL + b * HC_ULS + (w < 2 ? w * 16 : (NTB + w) * 16);
    for (int j = 0; j < 16; ++j) dst[j] = 0;
  }
  {
    const float w0 = cw[0 * 3 * GW + c], w1 = cw[1 * 3 * GW + c], w2 = cw[2 * 3 * GW + c], bb = cb[c];
    for (int q = tid; q < SB * (L / 8); q += 256) {
      const int b = q / (L / 8), s8 = (q % (L / 8)) * 8;
      const int row = b * RPB + seg0 + s8;
      float u[8];
      if (ORD == 0) {
        float raw[10];
#pragma unroll
        for (int j = 0; j < 10; ++j) { int sp = s8 - 1 + j; raw[j] = (sp >= 0 && sp < L) ? PJ(row - 1 + j, OFF_HY + c) : 0.f; }
#pragma unroll
        for (int j = 0; j < 8; ++j) u[j] = w0 * raw[j] + w1 * raw[j + 1] + w2 * raw[j + 2] + bb;
      } else {
#pragma unroll
        for (int j = 0; j < 8; ++j) u[j] = p.Z2[(size_t)(row + j) * GW + c];
      }
      unsigned* dst = (unsigned*)(UL + b * HC_ULS + 32 + s8);
#pragma unroll
      for (int j = 0; j < 4; ++j) dst[j] = pack_bf16(u[2 * j], u[2 * j + 1]);
    }
  }
  __syncthreads();
  const int lane = tid & 63, wave = tid >> 6;
  const int ti = lane & 15, q4 = lane >> 4;
  const int NT = NTB / 2, TPW = NT / 4;
  const int T0 = wave * TPW * 2;
  f32x4 acc[16];
#pragma unroll
  for (int m = 0; m < 16; ++m) acc[m] = (f32x4){0.f, 0.f, 0.f, 0.f};
  const int nK = NTB / 2 + TPW;
  const int colb = (lane & 7) * HC_ULS + (q4 & 1) * 8;
  const int tbsel = (lane >> 3) & 1;
  for (int k = 0; k < nK; ++k) {
    const int dl = T0 - NTB + 2 * k + (q4 >> 1);
    const int nb = HC_KOFF - 16 * dl - ti + 8 * (q4 & 1);
    bf16x8 A;
#pragma unroll
    for (int j = 0; j < 8; ++j) A[j] = (short)KL[nb + j];
#pragma unroll
    for (int m = 0; m < 16; ++m) {
      if (m < TPW && k >= m && k <= m + NTB / 2) {
        const int sb = T0 + 2 * m + tbsel - dl;
        const bf16x8 B = *(const bf16x8*)(UL + colb + (sb + 2) * 16);
        acc[m] = mfma16(A, B, acc[m]);
      }
    }
  }
  const int xc = (ORD == 0 ? GW : 2 * GW) + c;
  const float v0 = cw[0 * 3 * GW + xc], v1 = cw[1 * 3 * GW + xc], v2 = cw[2 * 3 * GW + xc], vb = cb[xc];
  const int bn = lane & 7;
#pragma unroll
  for (int m = 0; m < 16; ++m) {
    if (m < TPW) {
      const int t0 = 16 * (T0 + 2 * m + tbsel) + q4 * 4;
      const int row = bn * RPB + seg0 + t0;
      float raw[6];
#pragma unroll
      for (int j = 0; j < 6; ++j) { int tp = t0 - 1 + j; raw[j] = (tp >= 0 && tp < L) ? PJ(row - 1 + j, OFF_HY + xc) : 0.f; }
#pragma unroll
      for (int r = 0; r < 4; ++r) {
        float g = v0 * raw[r] + v1 * raw[r + 1] + v2 * raw[r + 2] + vb;
        float o = g * acc[m][r];
        if (ORD == 0) p.Z2[(size_t)(row + r) * GW + c] = o;
        else p.HY[(size_t)(row + r) * GW + c] = o;
      }
    }
  }
}
__device__ __forceinline__ int hyena_mfma_items(int l) { return (l != DEPTH - 1 ? 2 : 1) * GW; }
#endif


__device__ __forceinline__ float rw_shift(const P& p, int l, int row, int pp, int j) {
  float x = PJ(row, OFF_RW + j);
  float xp = has_prev(pp) ? PJ(row - 1, OFF_RW + j) : 0.f;
  float xn = has_next(pp) ? PJ(row + 1, OFF_RW + j) : 0.f;
  return x + p.rw_mu[(size_t)(l * 2 + 0) * RWSH + j] * (xp - x) + p.rw_mu[(size_t)(l * 2 + 1) * RWSH + j] * (xn - x);
}
__device__ __forceinline__ void ph_prep(const P& p, int l, int s, int gtid, int gsize, float* lds, int tid) {
  for (int it = gtid; it < RS * (2 * GW / 4); it += gsize) {
    const int j = (it % (2 * GW / 4)) * 4, row = it / (2 * GW / 4), pp = row % RPB;
    const float* cw = p.ml_cw + (size_t)l * 3 * 2 * GW + j;
    const bf16_t* pr = p.PROJ + (size_t)row * LDP + OFF_ML + j;
    f4 x0 = ldbf4(pr), xm = x0, xp = x0;
    xm.x = xm.y = xm.z = xm.w = 0.f; xp = xm;
    if (has_prev(pp)) xm = ldbf4(pr - LDP);
    if (has_next(pp)) xp = ldbf4(pr + LDP);
    const f4 c0 = ld4(cw), c1 = ld4(cw + 2 * GW), c2 = ld4(cw + 4 * GW), cb = ld4(p.ml_cb + l * 2 * GW + j);
    const float sc = (j < GW) ? 0.125f : 1.0f;
    f4 o;
    o.x = siluf_(c0.x * xm.x + c1.x * x0.x + c2.x * xp.x + cb.x) * sc;
    o.y = siluf_(c0.y * xm.y + c1.y * x0.y + c2.y * xp.y + cb.y) * sc;
    o.z = siluf_(c0.z * xm.z + c1.z * x0.z + c2.z * xp.z + cb.z) * sc;
    o.w = siluf_(c0.w * xm.w + c1.w * x0.w + c2.w * xp.w + cb.w) * sc;
    st4(p.MQK + (size_t)row * 2 * GW + j, o);
  }
  for (int it = gtid; it < RS * 4 * NH; it += gsize) {
    int gj = it % (4 * NH), row = it / (4 * NH);
    float g = PJ(row, OFF_ML + 4 * GW + gj) + p.ml_gb[l * 4 * NH + gj];
    if ((gj / NH) & 1) g = logsigmoidf_(g);
    p.MG[(size_t)row * 4 * NH + gj] = g;
  }
  for (int it = gtid; it < RS * (2 * GW / 4); it += gsize) {
    const int j = (it % (2 * GW / 4)) * 4, row = it / (2 * GW / 4), pp = row % RPB;
    const int which = j / GW, c = j % GW, dd = c % HD, hb = c - dd;
    const bf16_t* pr = p.PROJ + (size_t)row * LDP + OFF_RT + which * GW;
    const f4 x = ldbf4(pr + c);
    f4 o = x;
    if (pp >= CTX) {
      const int t = pp - CTX, ri = t / GRIDW, ci = t % GRIDW;
      const int half = dd / 32, e = dd % 32, pi = e % 16;
      const bool first = e < 16;
      const int pos = half ? ci : ri;
      const f4 xo = ldbf4(pr + hb + (first ? dd + 16 : dd - 16));
      const f4 cs = ld4(p.ropec + pos * 16 + pi), sn = ld4(p.ropes + pos * 16 + pi);
      const float sg = first ? -1.0f : 1.0f;
      o.x = x.x * cs.x + sg * xo.x * sn.x;
      o.y = x.y * cs.y + sg * xo.y * sn.y;
      o.z = x.z * cs.z + sg * xo.z * sn.z;
      o.w = x.w * cs.w + sg * xo.w * sn.w;
    }
    if (which == 0) { o.x *= 0.125f; o.y *= 0.125f; o.z *= 0.125f; o.w *= 0.125f; }
    st4(p.RQK + (size_t)row * 2 * GW + j, o);
  }
  {
    float* zs = lds;
    float* part = lds + 8 * RWSH;
    const size_t AS = (size_t)RS * GW;
    for (int tile = blockIdx.x; tile < RS / 8; tile += gridDim.x) {
      const int row0 = tile * 8;
      __syncthreads();
      for (int idx = tid; idx < 8 * RWSH; idx += 256) {
        int r = idx / RWSH, j = idx % RWSH, row = row0 + r;
        float z = rw_shift(p, l, row, row % RPB, j);
        if (j >= 3 * GW && j < 3 * GW + 32) z = tanhf_(z);
        else if (j >= 3 * GW + 64) z = sigmoidf_(z);
        zs[idx] = z;
      }
      __syncthreads();
      {
        int pr = tid >> 3, sub = tid & 7;
        if (pr < 8 * NH) {
          int r = pr / NH, h = pr % NH;
          float ss = 0.f, bs = 0.f;
          for (int i = sub * 8; i < sub * 8 + 8; ++i) {
            float kv = zs[r * RWSH + GW + h * HD + i], rv = zs[r * RWSH + h * HD + i];
            float kk = kv * p.rw_kk[l * GW + h * HD + i];
            ss += kk * kk;
            bs += rv * kv * p.rw_rk[(l * NH + h) * HD + i];
          }
          part[pr * 8 + sub] = ss;
          part[256 + pr * 8 + sub] = bs;
        }
      }
      __syncthreads();
      for (int c = tid; c < GW; c += 256) {
        const int h = c / HD;
        float wa0[8], wa1[8], aa0[8], aa1[8], gg[8];
#pragma unroll
        for (int r = 0; r < 8; ++r) { wa0[r] = 0.f; wa1[r] = 0.f; aa0[r] = 0.f; aa1[r] = 0.f; gg[r] = 0.f; }
#pragma unroll 8
        for (int i = 0; i < 32; ++i) {
          float w20 = p.rw_w2[((size_t)(l * 2 + 0) * 32 + i) * GW + c], w21 = p.rw_w2[((size_t)(l * 2 + 1) * 32 + i) * GW + c];
          float a20 = p.rw_a2[((size_t)(l * 2 + 0) * 32 + i) * GW + c], a21 = p.rw_a2[((size_t)(l * 2 + 1) * 32 + i) * GW + c];
#pragma unroll
          for (int r = 0; r < 8; ++r) {
            float tw = zs[r * RWSH + 3 * GW + i], al = zs[r * RWSH + 3 * GW + 32 + i];
            wa0[r] = fmaf(tw, w20, wa0[r]); wa1[r] = fmaf(tw, w21, wa1[r]);
            aa0[r] = fmaf(al, a20, aa0[r]); aa1[r] = fmaf(al, a21, aa1[r]);
          }
        }
#pragma unroll 16
        for (int j = 0; j < 64; ++j) {
          float g2 = p.rw_g2[((size_t)l * 64 + j) * GW + c];
#pragma unroll
          for (int r = 0; r < 8; ++r) gg[r] = fmaf(zs[r * RWSH + 3 * GW + 64 + j], g2, gg[r]);
        }
        const float ka = p.rw_ka[l * GW + c], kks = p.rw_kk[l * GW + c];
        const float w00 = p.rw_w0[(l * 2 + 0) * GW + c], w01 = p.rw_w0[(l * 2 + 1) * GW + c];
        const float a00 = p.rw_a0[(l * 2 + 0) * GW + c], a01 = p.rw_a0[(l * 2 + 1) * GW + c];
#pragma unroll
        for (int r = 0; r < 8; ++r) {
          const int pr = r * NH + h;
          float ss = 0.f, bs = 0.f;
#pragma unroll
          for (int u = 0; u < 8; ++u) { ss += part[pr * 8 + u]; bs += part[256 + pr * 8 + u]; }
          const float rr = zs[r * RWSH + c], k = zs[r * RWSH + GW + c], v = zs[r * RWSH + 2 * GW + c];
          const float kkv = k * kks / sqrtf(ss + 1e-12f);
          const size_t o = (size_t)(row0 + r) * GW + c;
          p.RW[0 * AS + o] = rr;
          p.RW[1 * AS + o] = kkv;
          p.BON[o] = bs * v;
          p.GG[o] = gg[r];
#pragma unroll
          for (int d = 0; d < 2; ++d) {
            float wpre = (d ? w01 : w00) + (d ? wa1[r] : wa0[r]);
            float decay = expf(-expf(-softplusf_(-wpre) - 0.5f));
            float a = sigmoidf_((d ? a01 : a00) + (d ? aa1[r] : aa0[r]));
            p.RW[(2 + d) * AS + o] = decay;
            p.RW[(4 + d) * AS + o] = k * (1.0f + (a - 1.0f) * ka);
            p.RW[(6 + d) * AS + o] = kkv * a;
          }
        }
      }
    }
    __syncthreads();
  }
#if SB == 8
  for (int it = blockIdx.x; it < hyena_mfma_items(l); it += gridDim.x) hyena_mfma_item<0>(p, l, it, (bf16_t*)lds, tid);
  __syncthreads();
#else
  for (int it = gtid; it < hyena_items(l); it += gsize) hyena_conv_item<0>(p, l, it);
#endif
}

__device__ __forceinline__ int scan_pos(int dir, int step) {
  if (!dir) return step;
  return step < CTX ? CTX - 1 - step : RPB - 1 - (step - CTX);
}
#ifndef CPU_EMU
__device__ __forceinline__ float quad_sum(float v) {
  v += __int_as_float(__builtin_amdgcn_mov_dpp(__float_as_int(v), 0xB1, 0xF, 0xF, true));
  v += __int_as_float(__builtin_amdgcn_mov_dpp(__float_as_int(v), 0x4E, 0xF, 0xF, true));
  return v;
}
__device__ __forceinline__ float oct_sum(float v) {
  v = quad_sum(v);
  v += __int_as_float(__builtin_amdgcn_mov_dpp(__float_as_int(v), 0x141, 0xF, 0xF, true));
  return v;
}
#endif
#define SCT 16
#define NCHUNK (RPB / SCT)
__device__ __forceinline__ void bscan_rwkv(const P& p, int l, int bl, int h, int dir, int half, float* lds, int tid) {
  const int i = half * 32 + (tid >> 3), kq = tid & 7, st = tid >> 4, sp = tid & 15;
  float S[8];
#pragma unroll
  for (int d = 0; d < 8; ++d) S[d] = 0.f;
  float* H = dir ? p.HB : p.HF;
  const size_t AS = (size_t)RS * GW;
  const int vc = 2 * GW + h * HD + sp * 4;
  const f4 mu0 = ld4(p.rw_mu + (size_t)(l * 2 + 0) * RWSH + vc), mu1 = ld4(p.rw_mu + (size_t)(l * 2 + 1) * RWSH + vc);
  f4 rg[5], rv;
  auto load = [&](int c) {
    const int pp = scan_pos(dir, c * SCT + st), row = bl * RPB + pp;
    const size_t o = (size_t)row * GW + h * HD + sp * 4;
    rg[0] = ld4(p.RW + 0 * AS + o);
    rg[1] = ld4(p.RW + 1 * AS + o);
    rg[2] = ld4(p.RW + (size_t)(2 + dir) * AS + o);
    rg[3] = ld4(p.RW + (size_t)(4 + dir) * AS + o);
    rg[4] = ld4(p.RW + (size_t)(6 + dir) * AS + o);
    const bf16_t* pr = p.PROJ + (size_t)row * LDP + OFF_RW + vc;
    f4 x = ldbf4(pr), xm = x, xp = x;
    xm.x = xm.y = xm.z = xm.w = 0.f; xp = xm;
    if (has_prev(pp)) xm = ldbf4(pr - LDP);
    if (has_next(pp)) xp = ldbf4(pr + LDP);
    rv.x = x.x + mu0.x * (xm.x - x.x) + mu1.x * (xp.x - x.x);
    rv.y = x.y + mu0.y * (xm.y - x.y) + mu1.y * (xp.y - x.y);
    rv.z = x.z + mu0.z * (xm.z - x.z) + mu1.z * (xp.z - x.z);
    rv.w = x.w + mu0.w * (xm.w - x.w) + mu1.w * (xp.w - x.w);
  };
  load(0);
  for (int c = 0; c < NCHUNK; ++c) {
    __syncthreads();
#pragma unroll
    for (int a = 0; a < 5; ++a) st4(lds + (st * 6 + a) * 64 + sp * 4, rg[a]);
    st4(lds + (st * 6 + 5) * 64 + sp * 4, rv);
    __syncthreads();
    if (c + 1 < NCHUNK) load(c + 1);
#pragma nounroll
    for (int t = 0; t < SCT; ++t) {
      const float* L = lds + t * 6 * 64 + kq * 8;
      const float vv = lds[(t * 6 + 5) * 64 + i];
      float a_r[8], a_k[8], a_w[8], a_d[8], a_b[8];
      ld8(a_k, L + 1 * 64);
      ld8(a_w, L + 2 * 64);
      ld8(a_d, L + 3 * 64);
      ld8(a_b, L + 4 * 64);
      ld8(a_r, L + 0 * 64);
      float sa4[4] = {0.f, 0.f, 0.f, 0.f};
#pragma unroll
      for (int d = 0; d < 8; ++d) sa4[d & 3] = fmaf(S[d], a_k[d], sa4[d & 3]);
      const float sa = -oct_sum((sa4[0] + sa4[1]) + (sa4[2] + sa4[3]));
      float y4[4] = {0.f, 0.f, 0.f, 0.f};
#pragma unroll
      for (int d = 0; d < 8; ++d) {
        S[d] = fmaf(S[d], a_w[d], fmaf(sa, a_b[d], vv * a_d[d]));
        y4[d & 3] = fmaf(S[d], a_r[d], y4[d & 3]);
      }
      const float y = oct_sum((y4[0] + y4[1]) + (y4[2] + y4[3]));
      if (kq == 0) {
        const int row = bl * RPB + scan_pos(dir, c * SCT + t);
        H[(size_t)row * 3 * GW + 2 * GW + h * HD + i] = y;
      }
    }
  }
}
__device__ __forceinline__ void bscan_mlstm(const P& p, int bl, int h, int dir, int half, float* lds, int tid) {
  const int i = half * 32 + (tid >> 3), kq = tid & 7, st = tid >> 4, sp = tid & 15;
  float C[8], n[8];
#pragma unroll
  for (int d = 0; d < 8; ++d) { C[d] = 0.f; n[d] = 0.f; }
  float m = 0.f;
  float* H = dir ? p.HB : p.HF;
  f4 rq, rk, rv;
  float g0 = 0.f, g1 = 0.f;
  auto load = [&](int c) {
    const int pp = scan_pos(dir, c * SCT + st), row = bl * RPB + pp;
    const float* q = p.MQK + (size_t)row * 2 * GW + h * HD + sp * 4;
    rq = ld4(q);
    rk = ld4(q + GW);
    rv = ldbf4(p.PROJ + (size_t)row * LDP + OFF_ML + 2 * GW + h * HD + sp * 4);
    if (sp == 0) {
      const float* mg = p.MG + (size_t)row * 4 * NH;
      g0 = mg[(dir ? 2 : 0) * NH + h];
      g1 = mg[(dir ? 3 : 1) * NH + h];
    }
  };
  load(0);
  for (int c = 0; c < NCHUNK; ++c) {
    __syncthreads();
    st4(lds + (st * 4 + 0) * 64 + sp * 4, rq);
    st4(lds + (st * 4 + 1) * 64 + sp * 4, rk);
    st4(lds + (st * 4 + 2) * 64 + sp * 4, rv);
    if (sp == 0) { lds[(st * 4 + 3) * 64 + 0] = g0; lds[(st * 4 + 3) * 64 + 1] = g1; }
    __syncthreads();
    if (c + 1 < NCHUNK) load(c + 1);
#pragma nounroll
    for (int t = 0; t < SCT; ++t) {
      const float* L = lds + t * 4 * 64;
      const float ig = L[3 * 64 + 0], lf = L[3 * 64 + 1];
      const float mn = fmaxf(lf + m, ig);
      const float f = fexp_(lf + m - mn), ii = fexp_(ig - mn), em = fexp_(-mn);
      m = mn;
      const float iv = ii * L[2 * 64 + i];
      float a_q[8], a_k[8];
      ld8(a_q, L + kq * 8);
      ld8(a_k, L + 64 + kq * 8);
      float num4[4] = {0.f, 0.f, 0.f, 0.f}, den4[4] = {0.f, 0.f, 0.f, 0.f};
#pragma unroll
      for (int d = 0; d < 8; ++d) {
        const float kd = a_k[d], qd = a_q[d];
        C[d] = fmaf(kd, iv, f * C[d]);
        n[d] = fmaf(kd, ii, f * n[d]);
        num4[d & 3] = fmaf(qd, C[d], num4[d & 3]);
        den4[d & 3] = fmaf(qd, n[d], den4[d & 3]);
      }
      const float num = oct_sum((num4[0] + num4[1]) + (num4[2] + num4[3]));
      const float den = oct_sum((den4[0] + den4[1]) + (den4[2] + den4[3]));
      if (kq == 0) {
        const int row = bl * RPB + scan_pos(dir, c * SCT + t);
        H[(size_t)row * 3 * GW + 0 * GW + h * HD + i] = num * frcp_(fmaxf(fabsf(den), em));
      }
    }
  }
}
__device__ __forceinline__ void bscan_ret(const P& p, int bl, int h, int dir, int half, float* lds, int tid) {
  const int i = half * 32 + (tid >> 3), kq = tid & 7, st = tid >> 4, sp = tid & 15;
  float S[8];
#pragma unroll
  for (int d = 0; d < 8; ++d) S[d] = 0.f;
  const int hh = dir ? NH - 1 - h : h;
  const float gamma = 1.0f - exp2f(-5.0f - (float)hh);
  float* H = dir ? p.HB : p.HF;
  f4 rq, rk, rv;
  auto load = [&](int c) {
    const int pp = scan_pos(dir, c * SCT + st), row = bl * RPB + pp;
    const float* q = p.RQK + (size_t)row * 2 * GW + h * HD + sp * 4;
    rq = ld4(q);
    rk = ld4(q + GW);
    rv = ldbf4(p.PROJ + (size_t)row * LDP + OFF_RT + 2 * GW + h * HD + sp * 4);
  };
  load(0);
  for (int c = 0; c < NCHUNK; ++c) {
    __syncthreads();
    st4(lds + (st * 4 + 0) * 64 + sp * 4, rq);
    st4(lds + (st * 4 + 1) * 64 + sp * 4, rk);
    st4(lds + (st * 4 + 2) * 64 + sp * 4, rv);
    __syncthreads();
    if (c + 1 < NCHUNK) load(c + 1);
#pragma nounroll
    for (int t = 0; t < SCT; ++t) {
      const float* L = lds + t * 4 * 64;
      const float v = L[2 * 64 + i];
      float a_q[8], a_k[8];
      ld8(a_q, L + kq * 8);
      ld8(a_k, L + 64 + kq * 8);
      float o4[4] = {0.f, 0.f, 0.f, 0.f};
#pragma unroll
      for (int d = 0; d < 8; ++d) {
        S[d] = fmaf(S[d], gamma, a_k[d] * v);
        o4[d & 3] = fmaf(a_q[d], S[d], o4[d & 3]);
      }
      const float o = oct_sum((o4[0] + o4[1]) + (o4[2] + o4[3]));
      if (kq == 0) {
        const int row = bl * RPB + scan_pos(dir, c * SCT + t);
        H[(size_t)row * 3 * GW + 1 * GW + h * HD + i] = o;
      }
    }
  }
}
#define NSCAN (3 * SB * NH * 2 * 2)
__device__ __forceinline__ void ph_scan(const P& p, int l, int s, int gtid, int gsize, float* lds, int tid) {
  for (int w = blockIdx.x; w < NSCAN; w += gridDim.x) {
    int mixer = w / (SB * NH * 4), r = w % (SB * NH * 4);
    int half = r & 1, dir = (r >> 1) & 1, h = (r >> 2) % NH, bl = (r >> 2) / NH;
    if (mixer == 0) bscan_rwkv(p, l, bl, h, dir, half, lds, tid);
    else if (mixer == 1) bscan_mlstm(p, bl, h, dir, half, lds, tid);
    else bscan_ret(p, bl, h, dir, half, lds, tid);
    __syncthreads();
  }
#if SB == 8
  {
    int* sh = (int*)lds;
    const int nitem = hyena_mfma_items(l);
    for (;;) {
      __syncthreads();
      if (tid == 0) sh[0] = atomicAdd(p.ctr, 1);
      __syncthreads();
      const int it = sh[0];
      if (it >= nitem) break;
      hyena_mfma_item<1>(p, l, it, (bf16_t*)lds, tid);
    }
  }
#else
  for (int it = gtid; it < hyena_items(l); it += gsize) hyena_conv_item<1>(p, l, it);
#endif
}

#define NE (HD / WL)
__device__ __forceinline__ void ph_fin(const P& p, int l, int s, int gtid, int gsize) {
  const bool last = (l == DEPTH - 1);
  const int lane = gtid % WL, gw = gtid / WL, nw = gsize / WL;
  for (int item = gw; item < (RS / 4) * 4 * NH; item += nw) {
    const int hg = item % (4 * NH), row0 = (item / (4 * NH)) * 4, pp0 = row0 % RPB;
    if (last && pp0 < CTX) continue;
    const int g = hg / NH, h = hg % NH;
    const int c0 = g * GW + h * HD;
    float val[4][NE];
#pragma unroll
    for (int r = 0; r < 4; ++r) {
      const int row = row0 + r;
#pragma unroll
      for (int e = 0; e < NE; ++e) {
        const int i = e * WL + lane;
        float v;
        if (g == 1) v = p.HY[(size_t)row * GW + h * HD + i];
        else {
          const int slot = (g == 0) ? 0 : (g == 2 ? 1 : 2);
          const size_t o = (size_t)row * 3 * GW + slot * GW + h * HD + i;
          v = p.HF[o] + p.HB[o];
        }
        val[r][e] = v;
      }
    }
    float mu[4], rs[4];
#pragma unroll
    for (int r = 0; r < 4; ++r) {
      float sm = 0.f;
#pragma unroll
      for (int e = 0; e < NE; ++e) sm += val[r][e];
      mu[r] = wave_sum(sm) * (1.0f / HD);
    }
#pragma unroll
    for (int r = 0; r < 4; ++r) {
      float q = 0.f;
#pragma unroll
      for (int e = 0; e < NE; ++e) { float d = val[r][e] - mu[r]; q += d * d; }
      rs[r] = 1.0f / sqrtf(wave_sum(q) * (1.0f / HD) + 1e-5f);
    }
#pragma unroll
    for (int r = 0; r < 4; ++r) {
      const int row = row0 + r;
#pragma unroll
      for (int e = 0; e < NE; ++e) {
        const int i = e * WL + lane;
        float v = (val[r][e] - mu[r]) * rs[r] * p.ng[l * DM + c0 + i] + p.nb[l * DM + c0 + i];
        if (g == 0) v *= sigmoidf_(PJ(row, OFF_ML + 3 * GW + h * HD + i));
        else if (g == 2) v *= siluf_(PJ(row, OFF_RT + 3 * GW + h * HD + i));
        else if (g == 3) v = p.GG[(size_t)row * GW + h * HD + i] * (v + p.BON[(size_t)row * GW + h * HD + i]);
        p.U[(size_t)row * DM + c0 + i] = f2bf(v);
      }
    }
  }
}

__device__ __forceinline__ void ph_act(const P& p, int l, int s, int gtid, int gsize) {
  const bool last = (l == DEPTH - 1);
  const float* cw = p.f_cw + (size_t)l * 3 * DFF;
  const float* cb = p.f_cb + (size_t)l * DFF;
  for (int it = gtid; it < RS * (DFF / 8); it += gsize) {
    const int j = (it % (DFF / 8)) * 8, row = it / (DFF / 8), pp = row % RPB;
    if (last && pp < CTX) continue;
    const bf16_t* hr = p.HFF + (size_t)row * 2 * DFF;
    unsigned am[4] = {0u, 0u, 0u, 0u}, a0[4], ap[4] = {0u, 0u, 0u, 0u}, bv[4], ov[4];
#pragma unroll
    for (int e = 0; e < 4; ++e) { a0[e] = ((const unsigned*)(hr + j))[e]; bv[e] = ((const unsigned*)(hr + DFF + j))[e]; }
    if (has_prev(pp)) {
#pragma unroll
      for (int e = 0; e < 4; ++e) am[e] = ((const unsigned*)(hr - 2 * DFF + j))[e];
    }
    if (has_next(pp)) {
#pragma unroll
      for (int e = 0; e < 4; ++e) ap[e] = ((const unsigned*)(hr + 2 * DFF + j))[e];
    }
#pragma unroll
    for (int e = 0; e < 4; ++e) {
      float o[2];
#pragma unroll
      for (int hh = 0; hh < 2; ++hh) {
        const int jj = j + 2 * e + hh;
        float xm = bf2f((bf16_t)(am[e] >> (16 * hh))), x0 = bf2f((bf16_t)(a0[e] >> (16 * hh))), xp = bf2f((bf16_t)(ap[e] >> (16 * hh)));
        float v = cw[jj] * xm + cw[DFF + jj] * x0 + cw[2 * DFF + jj] * xp + cb[jj];
        o[hh] = siluf_(v) * bf2f((bf16_t)(bv[e] >> (16 * hh)));
      }
      ov[e] = pack_bf16(o[0], o[1]);
    }
#pragma unroll
    for (int e = 0; e < 4; ++e) ((unsigned*)(p.ACT + (size_t)row * DFF + j))[e] = ov[e];
  }
}

enum { PH_PRO_A = 0, PH_PRO_B, PH_PRO_C, PH_LN0, PH_GEMM_IN, PH_PREP, PH_SCAN, PH_FIN, PH_GEMM_OUT, PH_LN1, PH_GEMM_UP, PH_ACT, PH_GEMM_DN, PH_LN2, PH_COUNT };

__device__ __forceinline__ void run_phase(const P& p, int ph, int l, int s, bf16_t* lds) {
  int tid = threadIdx.x;
#ifndef CPU_EMU
  asm volatile("" : "+v"(tid));
#endif
  const int gtid = blockIdx.x * blockDim.x + tid;
  const int gsize = gridDim.x * blockDim.x;
  const bool last = (l == DEPTH - 1);
  switch (ph) {
    case PH_PRO_A: ph_pro_a(p, gtid, gsize); break;
    case PH_PRO_B: ph_pro_b(p, gtid, gsize); break;
    case PH_PRO_C: ph_pro_c(p, gtid, gsize); break;
    case PH_LN0: ph_ln0(p, l, s, gtid, gsize); break;
    case PH_GEMM_IN: gemm_phase<true>(p.U, p.wt_in + (size_t)l * LDP * DM, p.PROJ, RS, LDP, DM, LDP, false, lds, tid); break;
    case PH_PREP: ph_prep(p, l, s, gtid, gsize, (float*)lds, tid); break;
    case PH_SCAN: ph_scan(p, l, s, gtid, gsize, (float*)lds, tid); break;
    case PH_FIN: ph_fin(p, l, s, gtid, gsize); break;
    case PH_GEMM_OUT: gemm_phase<false>(p.U, p.wt_out + (size_t)l * DM * DM, p.OUTF, RS, DM, DM, DM, last, lds, tid); break;
    case PH_LN1: ph_ln1(p, l, s, gtid, gsize); break;
    case PH_GEMM_UP: gemm_phase<true>(p.U, p.wt_up + (size_t)l * 2 * DFF * DM, p.HFF, RS, 2 * DFF, DM, 2 * DFF, last, lds, tid); break;
    case PH_ACT: ph_act(p, l, s, gtid, gsize); break;
    case PH_GEMM_DN: gemm_phase<false>(p.ACT, p.wt_dn + (size_t)l * DM * DFF, p.OUTF, RS, DM, DFF, DM, last, lds, tid); break;
    case PH_LN2: ph_ln2(p, l, s, gtid, gsize); break;
  }
}

#ifndef CPU_EMU
#define XB_TMO      128
#define XB_XCNT(j)  (256  + 64 * (j))
#define XB_XSUB(j)  (1280 + 64 * (j))
#define XB_XGEN(j)  (2304 + 64 * (j))
#define XB_TOP      3328
#define XB_TOPGEN   3392
#define XCD_BAR_WORDS 3456
#define XB_SPIN_CAP (1u << 22)
#define LAS __attribute__((address_space(3)))

__device__ __forceinline__ unsigned xb_ld(unsigned* p)              { return __hip_atomic_load(p, __ATOMIC_RELAXED, __HIP_MEMORY_SCOPE_AGENT); }
__device__ __forceinline__ unsigned xb_add(unsigned* p, unsigned v) { return __hip_atomic_fetch_add(p, v, __ATOMIC_RELAXED, __HIP_MEMORY_SCOPE_AGENT); }
__device__ __forceinline__ unsigned xb_xcc_id() { return (unsigned)__builtin_amdgcn_s_getreg((3 << 11) | 20) & 0xFu; }
#define XB_SPIN(cond, bar) do { unsigned _sp = 0; while (cond) { __builtin_amdgcn_s_sleep(1); \
    if ((++_sp & 255u) == 0u) { if (xb_ld(&(bar)[XB_TMO])) break; if (_sp > XB_SPIN_CAP) { atomicAdd(&(bar)[XB_TMO], 1u); break; } } } } while (0)

struct XcdBarrier {
    unsigned* bar; unsigned x;
    volatile LAS unsigned* st;
};

__device__ __forceinline__ XcdBarrier xcd_barrier_post(unsigned* bar, volatile LAS unsigned* st) {
    XcdBarrier b; b.bar = bar; b.x = xb_xcc_id(); b.st = st;
    if (threadIdx.x == 0) (void)xb_add(&bar[XB_XCNT(b.x)], 1u);
    return b;
}
__device__ __forceinline__ void xcd_barrier_complete(unsigned* bar, unsigned x, unsigned& nloc, unsigned& nx) {
    const unsigned G = gridDim.x * gridDim.y * gridDim.z;
    unsigned sum, cnt, mine, sp = 0u;
    for (;;) {
        sum = 0u; cnt = 0u; mine = 0u;
#pragma unroll
        for (unsigned j = 0; j < 16; ++j) { const unsigned c = xb_ld(&bar[XB_XCNT(j)]); sum += c; cnt += (c > 0u) ? 1u : 0u; mine = (j == x) ? c : mine; }
        if (sum == G) break;
        __builtin_amdgcn_s_sleep(1);
        if ((++sp & 255u) == 0u) { if (xb_ld(&bar[XB_TMO])) break; if (sp > XB_SPIN_CAP) { atomicAdd(&bar[XB_TMO], 1u); break; } }
    }
    nloc = mine > 0u ? mine : 1u; nx = cnt > 0u ? cnt : 1u;
}

__device__ __forceinline__ void xcd_barrier(const XcdBarrier& b) {
    asm volatile("s_waitcnt vmcnt(0)" ::: "memory");
    __syncthreads();
    if (threadIdx.x == 0) {
        unsigned* bar = b.bar;
        __builtin_amdgcn_s_waitcnt(0);
        unsigned nloc = b.st[0], nx = b.st[1];
        if (nloc == 0u) { xcd_barrier_complete(bar, b.x, nloc, nx); b.st[0] = nloc; b.st[1] = nx; }
        const unsigned old = xb_add(&bar[XB_XSUB(b.x)], 1u);
        const unsigned gen = old / nloc;
        if (old + 1u == (gen + 1u) * nloc) {
            __builtin_amdgcn_fence(__ATOMIC_RELEASE, "agent");
            asm volatile("s_waitcnt vmcnt(0)" ::: "memory");
            const unsigned og = xb_add(&bar[XB_TOP], 1u);
            const unsigned tg = og / nx;
            if (og + 1u == (tg + 1u) * nx) xb_add(&bar[XB_TOPGEN], 1u);
            else XB_SPIN(xb_ld(&bar[XB_TOPGEN]) == tg, bar);
            __builtin_amdgcn_fence(__ATOMIC_ACQUIRE, "agent");
            xb_add(&bar[XB_XGEN(b.x)], 1u);
            asm volatile("s_waitcnt vmcnt(0)" ::: "memory");
        } else {
            XB_SPIN(xb_ld(&bar[XB_XGEN(b.x)]) == gen, bar);
            __builtin_amdgcn_fence(__ATOMIC_ACQUIRE, "agent");
            asm volatile("s_waitcnt vmcnt(0)" ::: "memory");
        }
    }
    __syncthreads();
}

#endif

#ifndef PROBE_MASK
#define PROBE_MASK 0
#endif
#if PROBE_MASK
#define RUNPH(ph) do { int reps_ = 1 + ((PROBE_MASK >> ph) & 1); asm volatile("" : "+s"(reps_)); for (int q_ = 0; q_ < reps_; ++q_) { run_phase(p, ph, l, s, lds); GSYNC(); } } while (0)
#else
#define RUNPH(ph) do { run_phase(p, ph, l, s, lds); GSYNC(); } while (0)
#endif
#ifndef CPU_EMU
__global__ void __launch_bounds__(256, 2) k_mega(P p) {
  __shared__ __attribute__((aligned(16))) bf16_t lds[24576];
  __shared__ uint4 xb_words;
  cg::grid_group grid = cg::this_grid();
  if (threadIdx.x == 0) xb_words = make_uint4(0u, 0u, 0u, 0u);
  __syncthreads();
  XcdBarrier xb = xcd_barrier_post(p.bar, (volatile LAS unsigned*)&xb_words);
#define GSYNC() xcd_barrier(xb)
  run_phase(p, PH_PRO_A, 0, 0, lds);
  grid.sync();
  run_phase(p, PH_PRO_B, 0, 0, lds);
  GSYNC();
  run_phase(p, PH_PRO_C, 0, 0, lds);
  GSYNC();
  for (int l = 0; l < DEPTH; ++l)
    for (int s = 0; s < NSLICE; ++s)
    {
      RUNPH(PH_LN0);
      RUNPH(PH_GEMM_IN);
      RUNPH(PH_PREP);
      RUNPH(PH_SCAN);
      RUNPH(PH_FIN);
      RUNPH(PH_GEMM_OUT);
      RUNPH(PH_LN1);
      RUNPH(PH_GEMM_UP);
      RUNPH(PH_ACT);
      RUNPH(PH_GEMM_DN);
      RUNPH(PH_LN2);
    }
}
#endif

static size_t ws_take(size_t& off, size_t bytes) { size_t o = off; off += (bytes + 255) & ~(size_t)255; return o; }

static void build_params(P& p, void* const* d_in, void* d_out, void* d_ws) {
  const float** f = (const float**)&p;
  for (int i = 0; i < 39; ++i) f[i] = (const float*)d_in[i];
  p.out = (float*)d_out;
  char* w = (char*)d_ws;
  size_t off = 0;
  p.wt_in = (bf16_t*)(w + ws_take(off, (size_t)DEPTH * LDP * DM * 2));
  p.wt_out = (bf16_t*)(w + ws_take(off, (size_t)DEPTH * DM * DM * 2));
  p.wt_up = (bf16_t*)(w + ws_take(off, (size_t)DEPTH * 2 * DFF * DM * 2));
  p.wt_dn = (bf16_t*)(w + ws_take(off, (size_t)DEPTH * DM * DFF * 2));
  p.kf_lat = (float*)(w + ws_take(off, (size_t)DEPTH * 2 * 2 * SEQ * GW * 4));
  p.kf_ctx = (float*)(w + ws_take(off, (size_t)DEPTH * 2 * 2 * CTX * GW * 4));
  p.kt_lat = (bf16_t*)(w + ws_take(off, (size_t)DEPTH * 2 * 2 * SEQ * GW * 2));
  p.kt_ctx = (bf16_t*)(w + ws_take(off, (size_t)DEPTH * 2 * 2 * CTX * GW * 2));
  p.ropec = (float*)(w + ws_take(off, 64 * 16 * 4));
  p.ropes = (float*)(w + ws_take(off, 64 * 16 * 4));
  p.hyh1 = (float*)(w + ws_take(off, (size_t)DEPTH * 2 * SEQ * 64 * 4));
  p.hyh2 = (float*)(w + ws_take(off, (size_t)DEPTH * 2 * SEQ * 64 * 4));
  p.scv = (float*)(w + ws_take(off, (size_t)NMOD * DM * 4));
  p.modtab = (float*)(w + ws_take(off, (size_t)DEPTH * NMOD * 6 * DM * 4));
  p.xc = (float*)(w + ws_take(off, (size_t)NB * CTX * DM * 4));
  p.ctr = (int*)(w + ws_take(off, 256));
  p.bar = (unsigned*)(w + ws_take(off, 16384));
  p.U = (bf16_t*)(w + ws_take(off, (size_t)RS * DM * 2));
  size_t arena = off;
  p.PROJ = (bf16_t*)(w + ws_take(off, (size_t)RS * LDP * 2));
  p.MQK = (float*)(w + ws_take(off, (size_t)RS * 2 * GW * 4));
  p.MG = (float*)(w + ws_take(off, (size_t)RS * 4 * NH * 4));
  p.RQK = (float*)(w + ws_take(off, (size_t)RS * 2 * GW * 4));
  p.RW = (float*)(w + ws_take(off, (size_t)8 * RS * GW * 4));
  p.HF = (float*)(w + ws_take(off, (size_t)RS * 3 * GW * 4));
  p.HB = (float*)(w + ws_take(off, (size_t)RS * 3 * GW * 4));
  p.Z2 = (float*)(w + ws_take(off, (size_t)RS * GW * 4));
  p.HY = (float*)(w + ws_take(off, (size_t)RS * GW * 4));
  p.BON = (float*)(w + ws_take(off, (size_t)RS * GW * 4));
  p.GG = (float*)(w + ws_take(off, (size_t)RS * GW * 4));
  size_t off2 = arena;
  p.OUTF = (float*)(w + ws_take(off2, (size_t)RS * DM * 4));
  p.HFF = (bf16_t*)(w + ws_take(off2, (size_t)RS * 2 * DFF * 2));
  p.ACT = (bf16_t*)(w + ws_take(off2, (size_t)RS * DFF * 2));
}

#ifndef CPU_EMU
extern "C" void kernel_launch(void* const* d_in, const int* in_sizes, int n_in, void* d_out, int out_size, void* d_ws, size_t ws_size,
                              hipStream_t stream) {
  static int grid_blocks = 0;
  if (!grid_blocks) {
    int dev = 0, cus = 0, per_cu = 0;
    hipGetDevice(&dev);
    hipDeviceGetAttribute(&cus, hipDeviceAttributeMultiprocessorCount, dev);
    hipOccupancyMaxActiveBlocksPerMultiprocessor(&per_cu, k_mega, 256, 0);
    if (per_cu < 1) per_cu = 1;
    grid_blocks = cus * per_cu;
  }
  P p;
  memset(&p, 0, sizeof(p));
  build_params(p, d_in, d_out, d_ws);
  hipMemsetAsync(p.bar, 0, XCD_BAR_WORDS * sizeof(unsigned), stream);
  void* args[] = {&p};
  hipError_t e = hipLaunchCooperativeKernel((void*)k_mega, dim3(grid_blocks), dim3(256), args, 0, stream);
  if (e != hipSuccess) fprintf(stderr, "cooperative launch failed: %s (grid %d)\n", hipGetErrorString(e), grid_blocks);
}
#endif
```

```cpp
#ifndef CPU_EMU
#include <hip/hip_runtime.h>
#include <hip/hip_cooperative_groups.h>
#include <cstdio>
#include <cstring>
namespace cg = cooperative_groups;
#endif
#include <stdint.h>

#if !defined(CFG_SMALL) && !defined(CFG_CONVTEST)
#define DM 1024
#define NB 32
#define SEQ 2048
#define CTX 256
#define DFF 2816
#define SB 8
#elif defined(CFG_CONVTEST)
#define DM 512
#define NB 8
#define SEQ 256
#define CTX 128
#define DFF 192
#define SB 8
#else
#define DM 512
#define NB 2
#define SEQ 256
#define CTX 128
#define DFF 192
#define SB 1
#endif
#define DEPTH 2
#define GRIDW 64
#define HD 64
#define GW (DM / 4)
#define NH (GW / HD)
#define DPROJ (14 * GW + 4 * NH + 128)
#define LDP ((DPROJ + 127) / 128 * 128)
#define OFF_ML 0
#define OFF_HY (4 * GW + 4 * NH)
#define OFF_RT (OFF_HY + 3 * GW)
#define OFF_RW (OFF_RT + 4 * GW)
#define RWSH (3 * GW + 128)
#define RPB (CTX + SEQ)
#define RS (SB * RPB)
#define NSLICE (NB / SB)
#define ALPHA 1.41421356237309515f
#define NMOD 33
#ifdef CPU_EMU
#define WL 1
#else
#define WL 64
#endif

typedef unsigned short bf16_t;

struct P {
  const float *x, *c, *ctx, *c_ctx, *ada_w, *ada_b, *w_in, *ml_cw, *ml_cb, *ml_gb, *hy_cw, *hy_cb, *hy_w1, *hy_b1, *hy_w2, *hy_b2, *hy_w3,
      *hy_freq, *hy_d, *rw_mu, *rw_w0, *rw_w2, *rw_a0, *rw_a2, *rw_g2, *rw_kk, *rw_ka, *rw_rk, *ng, *nb, *w_out, *ln1g, *ln1b, *w_up, *f_cw,
      *f_cb, *w_dn, *ln2g, *ln2b;
  float* out;
  bf16_t *wt_in, *wt_out, *wt_up, *wt_dn;
  float *kf_lat, *kf_ctx, *hyh1, *hyh2, *scv, *modtab, *xc;
  bf16_t *kt_lat, *kt_ctx;
  float *ropec, *ropes;
  bf16_t *U, *PROJ;
  float *MQK, *MG, *RQK, *RW, *HF, *HB, *Z2, *HY, *BON, *GG;
  float* OUTF;
  bf16_t *HFF, *ACT;
  int* ctr;
  unsigned* bar;
};

__device__ __forceinline__ bf16_t f2bf(float f) {
  unsigned u = __float_as_uint(f);
  u += 0x7fffu + ((u >> 16) & 1u);
  return (bf16_t)(u >> 16);
}
#ifndef CPU_EMU
typedef __bf16 bf16v2_t __attribute__((ext_vector_type(2)));
typedef float f32x2_t __attribute__((ext_vector_type(2)));
#endif
__device__ __forceinline__ unsigned pack_bf16(float lo, float hi) {
#ifndef CPU_EMU
  f32x2_t v = {lo, hi};
  bf16v2_t b = __builtin_convertvector(v, bf16v2_t);
  return __builtin_bit_cast(unsigned, b);
#else
  return f2bf(lo) | ((unsigned)f2bf(hi) << 16);
#endif
}
__device__ __forceinline__ float bf2f(bf16_t h) { return __uint_as_float(((unsigned)h) << 16); }
#ifndef CPU_EMU
__device__ __forceinline__ float fexp_(float x) { return __expf(x); }
__device__ __forceinline__ float frcp_(float x) { return __builtin_amdgcn_rcpf(x); }
#else
__device__ __forceinline__ float fexp_(float x) { return expf(x); }
__device__ __forceinline__ float frcp_(float x) { return 1.0f / x; }
#endif
#ifndef CPU_EMU
__device__ __forceinline__ float sigmoidf_(float x) { return frcp_(1.0f + fexp_(-x)); }
__device__ __forceinline__ float siluf_(float x) { return x * frcp_(1.0f + fexp_(-x)); }
__device__ __forceinline__ float softplusf_(float x) { return fmaxf(x, 0.0f) + log1pf(expf(-fabsf(x))); }
__device__ __forceinline__ float tanhf_(float x) { return 1.0f - 2.0f * frcp_(1.0f + fexp_(2.0f * x)); }
#else
__device__ __forceinline__ float sigmoidf_(float x) { return 1.0f / (1.0f + expf(-x)); }
__device__ __forceinline__ float siluf_(float x) { return x / (1.0f + expf(-x)); }
__device__ __forceinline__ float softplusf_(float x) { return fmaxf(x, 0.0f) + log1pf(expf(-fabsf(x))); }
__device__ __forceinline__ float tanhf_(float x) { return tanhf(x); }
#endif
__device__ __forceinline__ float logsigmoidf_(float x) { return -softplusf_(-x); }

__device__ __forceinline__ float wave_sum(float v) {
#ifndef CPU_EMU
#pragma unroll
  for (int o = 32; o > 0; o >>= 1) v += __shfl_xor(v, o, 64);
#endif
  return v;
}

#ifndef CPU_EMU
typedef float f4 __attribute__((ext_vector_type(4)));
typedef unsigned u2v __attribute__((ext_vector_type(2)));
__device__ __forceinline__ f4 ld4(const float* a) { return *(const f4*)a; }
__device__ __forceinline__ void st4(float* a, f4 v) { *(f4*)a = v; }
__device__ __forceinline__ f4 ldbf4(const bf16_t* a) {
  u2v u = *(const u2v*)a;
  f4 r;
  r.x = __uint_as_float(u.x << 16); r.y = __uint_as_float(u.x & 0xffff0000u);
  r.z = __uint_as_float(u.y << 16); r.w = __uint_as_float(u.y & 0xffff0000u);
  return r;
}
#else
struct f4 { float x, y, z, w; };
__device__ __forceinline__ f4 ld4(const float* a) { f4 r; r.x = a[0]; r.y = a[1]; r.z = a[2]; r.w = a[3]; return r; }
__device__ __forceinline__ void st4(float* a, f4 v) { a[0] = v.x; a[1] = v.y; a[2] = v.z; a[3] = v.w; }
__device__ __forceinline__ f4 ldbf4(const bf16_t* a) { f4 r; r.x = bf2f(a[0]); r.y = bf2f(a[1]); r.z = bf2f(a[2]); r.w = bf2f(a[3]); return r; }
#endif
__device__ __forceinline__ void ld8(float* dst, const float* src) {
#pragma unroll
  for (int j = 0; j < 2; ++j) { f4 v = ld4(src + 4 * j); dst[4 * j] = v.x; dst[4 * j + 1] = v.y; dst[4 * j + 2] = v.z; dst[4 * j + 3] = v.w; }
}
__device__ __forceinline__ void ld16(float* dst, const float* src) {
#pragma unroll
  for (int j = 0; j < 4; ++j) { f4 v = ld4(src + 4 * j); dst[4 * j] = v.x; dst[4 * j + 1] = v.y; dst[4 * j + 2] = v.z; dst[4 * j + 3] = v.w; }
}


__device__ __forceinline__ const float* xsrc_row(const P& p, int l, int b, int pp) {
  if (pp < CTX) return (l == 0 ? p.ctx : p.xc) + ((size_t)b * CTX + pp) * DM;
  return (l == 0 ? p.x : p.out) + ((size_t)b * SEQ + (pp - CTX)) * DM;
}
__device__ __forceinline__ float* xdst_row(const P& p, int b, int pp) {
  if (pp < CTX) return p.xc + ((size_t)b * CTX + pp) * DM;
  return p.out + ((size_t)b * SEQ + (pp - CTX)) * DM;
}
__device__ __forceinline__ bool has_prev(int pp) { return pp != 0 && pp != CTX; }
__device__ __forceinline__ bool has_next(int pp) { return pp != CTX - 1 && pp != RPB - 1; }

__device__ __forceinline__ void cvt_weight(const float* W, bf16_t* Wt, int K, int N, int Npad, int gtid, int gsize) {
  const int nk8 = K / 8;
  for (long it = gtid; it < (long)nk8 * Npad; it += gsize) {
    int n = (int)(it % Npad), k8 = (int)(it / Npad);
    bf16_t v[8];
#pragma unroll
    for (int j = 0; j < 8; ++j) v[j] = (n < N) ? f2bf(W[(size_t)(k8 * 8 + j) * N + n]) : (bf16_t)0;
    uint4 o;
    o.x = v[0] | ((unsigned)v[1] << 16); o.y = v[2] | ((unsigned)v[3] << 16);
    o.z = v[4] | ((unsigned)v[5] << 16); o.w = v[6] | ((unsigned)v[7] << 16);
    *(uint4*)(Wt + (size_t)n * K + k8 * 8) = o;
  }
}
__device__ __forceinline__ void hy_feat_h1(const P& p, int gtid, int gsize) {
  const int per_l = (SEQ + CTX) * 64;
  for (int it = gtid; it < DEPTH * per_l; it += gsize) {
    int l = it / per_l, r = it % per_l;
    int i, L, seg;
    int j = r % 64; r /= 64;
    if (r < SEQ) { seg = 0; i = r; L = SEQ; } else { seg = 1; i = r - SEQ; L = CTX; }
    const float* w1 = p.hy_w1 + (size_t)l * 33 * 64;
    float t = (float)i / (float)(L - 1);
    float ang = 6.283185307179586f * (float)i / (float)L;
    float acc = t * w1[j];
    for (int b = 0; b < 16; ++b) {
      float band = 1e-4f + (float)b * ((15.0f - 1e-4f) / 15.0f);
      float a = band * ang;
      acc += cosf(a) * w1[(1 + b) * 64 + j];
      acc -= sinf(a) * w1[(17 + b) * 64 + j];
    }
    float h = sinf(p.hy_freq[l * 64 + j] * (acc + p.hy_b1[l * 64 + j]));
    p.hyh1[((size_t)(l * 2 + seg) * SEQ + i) * 64 + j] = h;
  }
}
__device__ __forceinline__ void ph_pro_a(const P& p, int gtid, int gsize) {
  for (int l = 0; l < DEPTH; ++l) {
    cvt_weight(p.w_in + (size_t)l * DM * DPROJ, p.wt_in + (size_t)l * LDP * DM, DM, DPROJ, LDP, gtid, gsize);
    cvt_weight(p.w_out + (size_t)l * DM * DM, p.wt_out + (size_t)l * DM * DM, DM, DM, DM, gtid, gsize);
    cvt_weight(p.w_up + (size_t)l * DM * 2 * DFF, p.wt_up + (size_t)l * 2 * DFF * DM, DM, 2 * DFF, 2 * DFF, gtid, gsize);
    cvt_weight(p.w_dn + (size_t)l * DFF * DM, p.wt_dn + (size_t)l * DM * DFF, DFF, DM, DM, gtid, gsize);
  }
  for (int it = gtid; it < NMOD * DM; it += gsize) {
    int r = it / DM, k = it % DM;
    float v = (r < NB) ? p.c[(size_t)r * DM + k] : p.c_ctx[k];
    p.scv[it] = siluf_(v);
  }
  hy_feat_h1(p, gtid, gsize);
  for (int it = gtid; it < 64 * 16; it += gsize) {
    float a = (float)(it / 16) * powf(10000.0f, -(float)(it % 16) / 16.0f);
    p.ropec[it] = cosf(a);
    p.ropes[it] = sinf(a);
  }
}
__device__ __forceinline__ void ph_pro_b(const P& p, int gtid, int gsize) {
  for (int it = gtid; it < DEPTH * NMOD * 6 * DM; it += gsize) {
    int j = it % (6 * DM), r = (it / (6 * DM)) % NMOD, l = it / (6 * DM * NMOD);
    const float* w = p.ada_w + (size_t)l * DM * 6 * DM + j;
    const float* sv = p.scv + r * DM;
    float acc = 0.f;
    for (int k = 0; k < DM; ++k) acc += sv[k] * w[(size_t)k * 6 * DM];
    p.modtab[it] = acc + p.ada_b[l * 6 * DM + j];
  }
  const int per_l = (SEQ + CTX) * 64;
  for (int it = gtid; it < DEPTH * per_l; it += gsize) {
    int l = it / per_l, r = it % per_l;
    int j = r % 64; r /= 64;
    int seg = r < SEQ ? 0 : 1, i = r < SEQ ? r : r - SEQ;
    const float* h1 = p.hyh1 + ((size_t)(l * 2 + seg) * SEQ + i) * 64;
    const float* w2 = p.hy_w2 + (size_t)l * 64 * 64;
    float acc = 0.f;
    for (int k = 0; k < 64; ++k) acc += h1[k] * w2[k * 64 + j];
    p.hyh2[((size_t)(l * 2 + seg) * SEQ + i) * 64 + j] = sinf(p.hy_freq[l * 64 + j] * (acc + p.hy_b2[l * 64 + j]));
  }
}
__device__ __forceinline__ void ph_pro_c(const P& p, int gtid, int gsize) {
  const int per_l = 2 * (2 * SEQ + 2 * CTX) * GW;
  const float max_decay = -4.605170185988091f / 0.3f, min_decay = -4.605170185988091f / 1.5f;
  for (int it = gtid; it < DEPTH * per_l; it += gsize) {
    int l = it / per_l, r = it % per_l;
    int c = r % GW; r /= GW;
    int ord = r & 1; r >>= 1;
    int seg, idx, L;
    if (r < 2 * SEQ) { seg = 0; idx = r; L = SEQ; } else { seg = 1; idx = r - 2 * SEQ; L = CTX; }
    int d = idx - L;
    float val = 0.f;
    if (idx != 0) {
      int i = d < 0 ? -d : d;
      float ti = (float)i / (float)(L - 1);
      float delta = fabsf(min_decay + (float)c * ((max_decay - min_decay) / (float)(GW - 1)));
      float win = expf(-ti * delta);
      const float* h2 = p.hyh2 + ((size_t)(l * 2 + seg) * SEQ + i) * 64;
      const float* w3 = p.hy_w3 + (size_t)l * 64 * 4 * GW;
      float af = 0.f, ab = 0.f;
      for (int k = 0; k < 64; ++k) {
        float hv = h2[k];
        af += hv * w3[k * 4 * GW + 0 * 2 * GW + ord * GW + c];
        ab += hv * w3[k * 4 * GW + 1 * 2 * GW + ord * GW + c];
      }
      if (d > 0) val = af * win;
      else if (d < 0) val = ab * win;
      else val = (af + ab) * win + p.hy_d[(l * 2 + ord) * GW + c];
    }
    float* kf = seg == 0 ? p.kf_lat + ((size_t)(l * 2 + ord) * 2 * SEQ + idx) * GW : p.kf_ctx + ((size_t)(l * 2 + ord) * 2 * CTX + idx) * GW;
    kf[c] = val;
    if (seg == 0) p.kt_lat[((size_t)(l * 2 + ord) * GW + c) * 2 * SEQ + idx] = f2bf(val);
    else p.kt_ctx[((size_t)(l * 2 + ord) * GW + c) * 2 * CTX + idx] = f2bf(val);
  }
}

#define NV (DM / WL)
__device__ __forceinline__ void ln_inplace(float* v, int lane) {
  float s = 0.f;
#pragma unroll
  for (int i = 0; i < NV; ++i) s += v[i];
  s = wave_sum(s);
  float mu = s * (1.0f / DM);
  float q = 0.f;
#pragma unroll
  for (int i = 0; i < NV; ++i) { float d = v[i] - mu; q += d * d; }
  q = wave_sum(q);
  float rs = 1.0f / sqrtf(q * (1.0f / DM) + 1e-5f);
#pragma unroll
  for (int i = 0; i < NV; ++i) v[i] = (v[i] - mu) * rs;
}
__device__ __forceinline__ void ph_ln0(const P& p, int l, int s, int gtid, int gsize) {
  const int lane = gtid % WL, gw = gtid / WL, nw = gsize / WL;
  if (gtid == 0) *p.ctr = 0;
  for (int row = gw; row < RS; row += nw) {
    int bl = row / RPB, pp = row % RPB, b = s * SB + bl;
    const float* xr = xsrc_row(p, l, b, pp);
    const float* mod = p.modtab + ((size_t)l * NMOD + (pp < CTX ? NB : b)) * 6 * DM;
    float v[NV];
#pragma unroll
    for (int i = 0; i < NV; ++i) v[i] = xr[i * WL + lane];
    ln_inplace(v, lane);
#pragma unroll
    for (int i = 0; i < NV; ++i) {
      int k = i * WL + lane;
      p.U[(size_t)row * DM + k] = f2bf(v[i] * (1.0f + mod[DM + k]) + mod[k]);
    }
  }
}
__device__ __forceinline__ void ph_ln1(const P& p, int l, int s, int gtid, int gsize) {
  const int lane = gtid % WL, gw = gtid / WL, nw = gsize / WL;
  const bool last = (l == DEPTH - 1);
  for (int row = gw; row < RS; row += nw) {
    int bl = row / RPB, pp = row % RPB, b = s * SB + bl;
    if (last && pp < CTX) continue;
    const float* xr = xsrc_row(p, l, b, pp);
    float* xd = xdst_row(p, b, pp);
    const float* mod = p.modtab + ((size_t)l * NMOD + (pp < CTX ? NB : b)) * 6 * DM;
    const float* o = p.OUTF + (size_t)row * DM;
    float v[NV];
#pragma unroll
    for (int i = 0; i < NV; ++i) { int k = i * WL + lane; v[i] = ALPHA * xr[k] + mod[2 * DM + k] * o[k]; }
    ln_inplace(v, lane);
#pragma unroll
    for (int i = 0; i < NV; ++i) { int k = i * WL + lane; v[i] = v[i] * p.ln1g[l * DM + k] + p.ln1b[l * DM + k]; xd[k] = v[i]; }
    ln_inplace(v, lane);
#pragma unroll
    for (int i = 0; i < NV; ++i) {
      int k = i * WL + lane;
      p.U[(size_t)row * DM + k] = f2bf(v[i] * (1.0f + mod[4 * DM + k]) + mod[3 * DM + k]);
    }
  }
}
__device__ __forceinline__ void ph_ln2(const P& p, int l, int s, int gtid, int gsize) {
  const int lane = gtid % WL, gw = gtid / WL, nw = gsize / WL;
  const bool last = (l == DEPTH - 1);
  for (int row = gw; row < RS; row += nw) {
    int bl = row / RPB, pp = row % RPB, b = s * SB + bl;
    if (last && pp < CTX) continue;
    float* xd = xdst_row(p, b, pp);
    const float* mod = p.modtab + ((size_t)l * NMOD + (pp < CTX ? NB : b)) * 6 * DM;
    const float* o = p.OUTF + (size_t)row * DM;
    float v[NV];
#pragma unroll
    for (int i = 0; i < NV; ++i) { int k = i * WL + lane; v[i] = ALPHA * xd[k] + mod[5 * DM + k] * o[k]; }
    ln_inplace(v, lane);
#pragma unroll
    for (int i = 0; i < NV; ++i) { int k = i * WL + lane; xd[k] = v[i] * p.ln2g[l * DM + k] + p.ln2b[l * DM + k]; }
  }
}

#ifndef CPU_EMU
typedef short bf16x8 __attribute__((ext_vector_type(8)));
typedef float f32x4 __attribute__((ext_vector_type(4)));
typedef unsigned u32x4 __attribute__((ext_vector_type(4)));
__device__ __forceinline__ f32x4 mfma16(bf16x8 a, bf16x8 b, f32x4 c) { return __builtin_amdgcn_mfma_f32_16x16x32_bf16(a, b, c, 0, 0, 0); }
#define GBM 128
#define GBN 128
#define GBK 64
#define GLD (GBK + 8)
template <bool OUT_BF16>
__device__ __forceinline__ void gemm_phase(const bf16_t* __restrict__ A, const bf16_t* __restrict__ Bt, void* __restrict__ Cv, int M, int N, int K, int ldc,
                           bool skip_ctx, bf16_t* lds, int tid) {
  bf16_t* sA = lds;
  bf16_t* sB = lds + GBM * GLD;
  const int lane = tid & 63, wave = tid >> 6;
  const int wm = wave >> 1, wn = wave & 1;
  const int ntm = M / GBM, ntn = N / GBN;
  const int KT = K / GBK;
  const int lr = lane & 15, lq = lane >> 4;
  for (int tile = blockIdx.x; tile < ntm * ntn; tile += gridDim.x) {
    const int tm = tile / ntn, tn = tile % ntn;
    if (skip_ctx && (tm % (RPB / GBM)) < (CTX / GBM)) continue;
    const int m0 = tm * GBM, n0 = tn * GBN;
    f32x4 acc[4][4];
#pragma unroll
    for (int i = 0; i < 4; ++i)
#pragma unroll
      for (int j = 0; j < 4; ++j) acc[i][j] = (f32x4){0.f, 0.f, 0.f, 0.f};
    u32x4 ra[4], rb[4];
#pragma unroll
    for (int i = 0; i < 4; ++i) {
      int id = tid + i * 256, r = id >> 3, ch = id & 7;
      ra[i] = *(const u32x4*)(A + (size_t)(m0 + r) * K + ch * 8);
      rb[i] = *(const u32x4*)(Bt + (size_t)(n0 + r) * K + ch * 8);
    }
    for (int kt = 0; kt < KT; ++kt) {
      __syncthreads();
#pragma unroll
      for (int i = 0; i < 4; ++i) {
        int id = tid + i * 256, r = id >> 3, ch = id & 7;
        *(u32x4*)(sA + r * GLD + ch * 8) = ra[i];
        *(u32x4*)(sB + r * GLD + ch * 8) = rb[i];
      }
      __syncthreads();
      if (kt + 1 < KT) {
#pragma unroll
        for (int i = 0; i < 4; ++i) {
          int id = tid + i * 256, r = id >> 3, ch = id & 7;
          ra[i] = *(const u32x4*)(A + (size_t)(m0 + r) * K + (kt + 1) * GBK + ch * 8);
          rb[i] = *(const u32x4*)(Bt + (size_t)(n0 + r) * K + (kt + 1) * GBK + ch * 8);
        }
      }
      __builtin_amdgcn_sched_barrier(0);
      {
        bf16x8 fa[2][4], fb[2][4];
#pragma unroll
        for (int kh = 0; kh < 2; ++kh) {
#pragma unroll
          for (int i = 0; i < 4; ++i) fa[kh][i] = *(const bf16x8*)(sA + (wm * 64 + i * 16 + lr) * GLD + kh * 32 + lq * 8);
#pragma unroll
          for (int j = 0; j < 4; ++j) fb[kh][j] = *(const bf16x8*)(sB + (wn * 64 + j * 16 + lr) * GLD + kh * 32 + lq * 8);
        }
        __builtin_amdgcn_sched_barrier(0);
#pragma unroll
        for (int kh = 0; kh < 2; ++kh)
#pragma unroll
          for (int i = 0; i < 4; ++i)
#pragma unroll
            for (int j = 0; j < 4; ++j) acc[i][j] = __builtin_amdgcn_mfma_f32_16x16x32_bf16(fb[kh][j], fa[kh][i], acc[i][j], 0, 0, 0);
      }
    }
#pragma unroll
    for (int i = 0; i < 4; ++i)
#pragma unroll
      for (int j = 0; j < 4; ++j) {
        size_t off = (size_t)(m0 + wm * 64 + i * 16 + lr) * ldc + n0 + wn * 64 + j * 16 + lq * 4;
        if (OUT_BF16) {
          uint2 o;
          o.x = pack_bf16(acc[i][j][0], acc[i][j][1]);
          o.y = pack_bf16(acc[i][j][2], acc[i][j][3]);
          *(uint2*)((bf16_t*)Cv + off) = o;
        } else {
          *(float4*)((float*)Cv + off) = make_float4(acc[i][j][0], acc[i][j][1], acc[i][j][2], acc[i][j][3]);
        }
      }
  }
}
#else
template <bool OUT_BF16>
void gemm_phase(const bf16_t* A, const bf16_t* Bt, void* Cv, int M, int N, int K, int ldc, bool skip_ctx, bf16_t* lds, int tid) {
  int gtid = blockIdx.x * blockDim.x + threadIdx.x, gsize = gridDim.x * blockDim.x;
  for (long it = gtid; it < (long)M * N; it += gsize) {
    int m = (int)(it / N), n = (int)(it % N);
    if (skip_ctx && (m % RPB) < CTX) continue;
    float acc = 0.f;
    for (int k = 0; k < K; ++k) acc += bf2f(A[(size_t)m * K + k]) * bf2f(Bt[(size_t)n * K + k]);
    if (OUT_BF16) ((bf16_t*)Cv)[(size_t)m * ldc + n] = f2bf(acc);
    else ((float*)Cv)[(size_t)m * ldc + n] = acc;
  }
}
#endif

#define PJ(row, col) bf2f(p.PROJ[(size_t)(row) * LDP + (col)])
template <int ORD>
__device__ __forceinline__ void hyena_conv_item(const P& p, int l, int it) {
  const bool need_ctx = (l != DEPTH - 1);
  const int ntb = (need_ctx ? CTX / 16 : 0) + SEQ / 16;
  int c = it % GW, r = it / GW;
  int tb = r % ntb, bl = r / ntb;
  int seg0, L, t0;
  const float* kf;
  if (need_ctx && tb < CTX / 16) { seg0 = 0; L = CTX; t0 = tb * 16; kf = p.kf_ctx + (size_t)(l * 2 + ORD) * 2 * CTX * GW; }
  else { int tb2 = tb - (need_ctx ? CTX / 16 : 0); seg0 = CTX; L = SEQ; t0 = tb2 * 16; kf = p.kf_lat + (size_t)(l * 2 + ORD) * 2 * SEQ * GW; }
  const int rowbase = bl * RPB + seg0;
  const float* cw = p.hy_cw + (size_t)l * 3 * 3 * GW;
  const float* cb = p.hy_cb + (size_t)l * 3 * GW;
  float acc[16], F[31], u[16];
#pragma unroll
  for (int i = 0; i < 16; ++i) acc[i] = 0.f;
#pragma unroll
  for (int m = 0; m < 15; ++m) F[m] = kf[(size_t)(L + t0 + 1 + m) * GW + c];
  const float w0 = cw[0 * 3 * GW + c], w1 = cw[1 * 3 * GW + c], w2 = cw[2 * 3 * GW + c], bb = cb[c];
  float nF[16], nin[18];
  auto fetch = [&](int s0) {
#pragma unroll
    for (int m = 0; m < 16; ++m) nF[m] = kf[(size_t)(L + t0 - s0 - 15 + m) * GW + c];
    if (ORD == 0) {
#pragma unroll
      for (int j = 0; j < 18; ++j) {
        int sp = s0 - 1 + j;
        nin[j] = (sp >= 0 && sp < L) ? PJ(rowbase + sp, OFF_HY + c) : 0.f;
      }
    } else {
#pragma unroll
      for (int j = 0; j < 16; ++j) nin[j] = p.Z2[(size_t)(rowbase + s0 + j) * GW + c];
    }
  };
  fetch(0);
  for (int s0 = 0; s0 < L; s0 += 16) {
#pragma unroll
    for (int m = 14; m >= 0; --m) F[m + 16] = F[m];
#pragma unroll
    for (int m = 0; m < 16; ++m) F[m] = nF[m];
    if (ORD == 0) {
#pragma unroll
      for (int j = 0; j < 16; ++j) u[j] = w0 * nin[j] + w1 * nin[j + 1] + w2 * nin[j + 2] + bb;
    } else {
#pragma unroll
      for (int j = 0; j < 16; ++j) u[j] = nin[j];
    }
    if (s0 + 16 < L) fetch(s0 + 16);
#pragma unroll
    for (int j = 0; j < 16; ++j)
#pragma unroll
      for (int i = 0; i < 16; ++i) acc[i] += F[i - j + 15] * u[j];
  }
  const int xc = (ORD == 0 ? GW : 2 * GW) + c;
  const float v0 = cw[0 * 3 * GW + xc], v1 = cw[1 * 3 * GW + xc], v2 = cw[2 * 3 * GW + xc], vb = cb[xc];
#pragma unroll
  for (int i = 0; i < 16; ++i) {
    int t = t0 + i;
    float xm = t > 0 ? PJ(rowbase + t - 1, OFF_HY + xc) : 0.f;
    float x0 = PJ(rowbase + t, OFF_HY + xc);
    float xp = t < L - 1 ? PJ(rowbase + t + 1, OFF_HY + xc) : 0.f;
    float g = v0 * xm + v1 * x0 + v2 * xp + vb;
    float o = g * acc[i];
    if (ORD == 0) p.Z2[(size_t)(rowbase + t) * GW + c] = o;
    else p.HY[(size_t)(rowbase + t) * GW + c] = o;
  }
}
__device__ __forceinline__ int hyena_items(int l) { return SB * ((l != DEPTH - 1 ? CTX / 16 : 0) + SEQ / 16) * GW; }

#if SB == 8
#define HC_KOFF (SEQ + 32)
#define HC_KLEN (2 * SEQ + 64)
#define HC_ULS ((SEQ / 16 + 4) * 16)
template <int ORD>
__device__ __forceinline__ void hyena_mfma_item(const P& p, int l, int item, bf16_t* lds, int tid) {
  const int c = item % GW, seg = item / GW;
  const int L = seg ? CTX : SEQ, seg0 = seg ? 0 : CTX, NTB = L / 16;
  const bf16_t* kt = (seg ? p.kt_ctx + ((size_t)(l * 2 + ORD) * GW + c) * 2 * CTX : p.kt_lat + ((size_t)(l * 2 + ORD) * GW + c) * 2 * SEQ);
  bf16_t* KL = lds;
  bf16_t* UL = lds + HC_KLEN;
  const float* cw = p.hy_cw + (size_t)l * 3 * 3 * GW;
  const float* cb = p.hy_cb + (size_t)l * 3 * GW;
  __syncthreads();
  for (int n = -(L + 32) + tid; n < L + 32; n += 256) KL[HC_KOFF + n] = (n > -L && n < L) ? kt[L - n] : (bf16_t)0;
  for (int q = tid; q < SB * 4; q += 256) {
    int b = q >> 2, w = q & 3;
    bf16_t* dst = UL + b * HC_ULS + (w < 2 ? w * 16 : (NTB + w) * 16);
    for (int j = 0; j < 16; ++j) dst[j] = 0;
  }
  {
    const float w0 = cw[0 * 3 * GW + c], w1 = cw[1 * 3 * GW + c], w2 = cw[2 * 3 * GW + c], bb = cb[c];
    for (int q = tid; q < SB * (L / 8); q += 256) {
      const int b = q / (L / 8), s8 = (q % (L / 8)) * 8;
      const int row = b * RPB + seg0 + s8;
      float u[8];
      if (ORD == 0) {
        float raw[10];
#pragma unroll
        for (int j = 0; j < 10; ++j) { int sp = s8 - 1 + j; raw[j] = (sp >= 0 && sp < L) ? PJ(row - 1 + j, OFF_HY + c) : 0.f; }
#pragma unroll
        for (int j = 0; j < 8; ++j) u[j] = w0 * raw[j] + w1 * raw[j + 1] + w2 * raw[j + 2] + bb;
      } else {
#pragma unroll
        for (int j = 0; j < 8; ++j) u[j] = p.Z2[(size_t)(row + j) * GW + c];
      }
      unsigned* dst = (unsigned*)(UL + b * HC_ULS + 32 + s8);
#pragma unroll
      for (int j = 0; j < 4; ++j) dst[j] = pack_bf16(u[2 * j], u[2 * j + 1]);
    }
  }
  __syncthreads();
  const int lane = tid & 63, wave = tid >> 6;
  const int ti = lane & 15, q4 = lane >> 4;
  const int NT = NTB / 2, TPW = NT / 4;
  const int T0 = wave * TPW * 2;
  f32x4 acc[16];
#pragma unroll
  for (int m = 0; m < 16; ++m) acc[m] = (f32x4){0.f, 0.f, 0.f, 0.f};
  const int nK = NTB / 2 + TPW;
  const int colb = (lane & 7) * HC_ULS + (q4 & 1) * 8;
  const int tbsel = (lane >> 3) & 1;
  for (int k = 0; k < nK; ++k) {
    const int dl = T0 - NTB + 2 * k + (q4 >> 1);
    const int nb = HC_KOFF - 16 * dl - ti + 8 * (q4 & 1);
    bf16x8 A;
#pragma unroll
    for (int j = 0; j < 8; ++j) A[j] = (short)KL[nb + j];
#pragma unroll
    for (int m = 0; m < 16; ++m) {
      if (m < TPW && k >= m && k <= m + NTB / 2) {
        const int sb = T0 + 2 * m + tbsel - dl;
        const bf16x8 B = *(const bf16x8*)(UL + colb + (sb + 2) * 16);
        acc[m] = mfma16(A, B, acc[m]);
      }
    }
  }
  const int xc = (ORD == 0 ? GW : 2 * GW) + c;
  const float v0 = cw[0 * 3 * GW + xc], v1 = cw[1 * 3 * GW + xc], v2 = cw[2 * 3 * GW + xc], vb = cb[xc];
  const int bn = lane & 7;
#pragma unroll
  for (int m = 0; m < 16; ++m) {
    if (m < TPW) {
      const int t0 = 16 * (T0 + 2 * m + tbsel) + q4 * 4;
      const int row = bn * RPB + seg0 + t0;
      float raw[6];
#pragma unroll
      for (int j = 0; j < 6; ++j) { int tp = t0 - 1 + j; raw[j] = (tp >= 0 && tp < L) ? PJ(row - 1 + j, OFF_HY + xc) : 0.f; }
#pragma unroll
      for (int r = 0; r < 4; ++r) {
        float g = v0 * raw[r] + v1 * raw[r + 1] + v2 * raw[r + 2] + vb;
        float o = g * acc[m][r];
        if (ORD == 0) p.Z2[(size_t)(row + r) * GW + c] = o;
        else p.HY[(size_t)(row + r) * GW + c] = o;
      }
    }
  }
}
__device__ __forceinline__ int hyena_mfma_items(int l) { return (l != DEPTH - 1 ? 2 : 1) * GW; }
#endif


__device__ __forceinline__ float rw_shift(const P& p, int l, int row, int pp, int j) {
  float x = PJ(row, OFF_RW + j);
  float xp = has_prev(pp) ? PJ(row - 1, OFF_RW + j) : 0.f;
  float xn = has_next(pp) ? PJ(row + 1, OFF_RW + j) : 0.f;
  return x + p.rw_mu[(size_t)(l * 2 + 0) * RWSH + j] * (xp - x) + p.rw_mu[(size_t)(l * 2 + 1) * RWSH + j] * (xn - x);
}
__device__ __forceinline__ void ph_prep(const P& p, int l, int s, int gtid, int gsize, float* lds, int tid) {
  for (int it = gtid; it < RS * (2 * GW / 4); it += gsize) {
    const int j = (it % (2 * GW / 4)) * 4, row = it / (2 * GW / 4), pp = row % RPB;
    const float* cw = p.ml_cw + (size_t)l * 3 * 2 * GW + j;
    const bf16_t* pr = p.PROJ + (size_t)row * LDP + OFF_ML + j;
    f4 x0 = ldbf4(pr), xm = x0, xp = x0;
    xm.x = xm.y = xm.z = xm.w = 0.f; xp = xm;
    if (has_prev(pp)) xm = ldbf4(pr - LDP);
    if (has_next(pp)) xp = ldbf4(pr + LDP);
    const f4 c0 = ld4(cw), c1 = ld4(cw + 2 * GW), c2 = ld4(cw + 4 * GW), cb = ld4(p.ml_cb + l * 2 * GW + j);
    const float sc = (j < GW) ? 0.125f : 1.0f;
    f4 o;
    o.x = siluf_(c0.x * xm.x + c1.x * x0.x + c2.x * xp.x + cb.x) * sc;
    o.y = siluf_(c0.y * xm.y + c1.y * x0.y + c2.y * xp.y + cb.y) * sc;
    o.z = siluf_(c0.z * xm.z + c1.z * x0.z + c2.z * xp.z + cb.z) * sc;
    o.w = siluf_(c0.w * xm.w + c1.w * x0.w + c2.w * xp.w + cb.w) * sc;
    st4(p.MQK + (size_t)row * 2 * GW + j, o);
  }
  for (int it = gtid; it < RS * 4 * NH; it += gsize) {
    int gj = it % (4 * NH), row = it / (4 * NH);
    float g = PJ(row, OFF_ML + 4 * GW + gj) + p.ml_gb[l * 4 * NH + gj];
    if ((gj / NH) & 1) g = logsigmoidf_(g);
    p.MG[(size_t)row * 4 * NH + gj] = g;
  }
  for (int it = gtid; it < RS * (2 * GW / 4); it += gsize) {
    const int j = (it % (2 * GW / 4)) * 4, row = it / (2 * GW / 4), pp = row % RPB;
    const int which = j / GW, c = j % GW, dd = c % HD, hb = c - dd;
    const bf16_t* pr = p.PROJ + (size_t)row * LDP + OFF_RT + which * GW;
    const f4 x = ldbf4(pr + c);
    f4 o = x;
    if (pp >= CTX) {
      const int t = pp - CTX, ri = t / GRIDW, ci = t % GRIDW;
      const int half = dd / 32, e = dd % 32, pi = e % 16;
      const bool first = e < 16;
      const int pos = half ? ci : ri;
      const f4 xo = ldbf4(pr + hb + (first ? dd + 16 : dd - 16));
      const f4 cs = ld4(p.ropec + pos * 16 + pi), sn = ld4(p.ropes + pos * 16 + pi);
      const float sg = first ? -1.0f : 1.0f;
      o.x = x.x * cs.x + sg * xo.x * sn.x;
      o.y = x.y * cs.y + sg * xo.y * sn.y;
      o.z = x.z * cs.z + sg * xo.z * sn.z;
      o.w = x.w * cs.w + sg * xo.w * sn.w;
    }
    if (which == 0) { o.x *= 0.125f; o.y *= 0.125f; o.z *= 0.125f; o.w *= 0.125f; }
    st4(p.RQK + (size_t)row * 2 * GW + j, o);
  }
  {
    float* zs = lds;
    float* part = lds + 8 * RWSH;
    const size_t AS = (size_t)RS * GW;
    for (int tile = blockIdx.x; tile < RS / 8; tile += gridDim.x) {
      const int row0 = tile * 8;
      __syncthreads();
      for (int idx = tid; idx < 8 * RWSH; idx += 256) {
        int r = idx / RWSH, j = idx % RWSH, row = row0 + r;
        float z = rw_shift(p, l, row, row % RPB, j);
        if (j >= 3 * GW && j < 3 * GW + 32) z = tanhf_(z);
        else if (j >= 3 * GW + 64) z = sigmoidf_(z);
        zs[idx] = z;
      }
      __syncthreads();
      {
        int pr = tid >> 3, sub = tid & 7;
        if (pr < 8 * NH) {
          int r = pr / NH, h = pr % NH;
          float ss = 0.f, bs = 0.f;
          for (int i = sub * 8; i < sub * 8 + 8; ++i) {
            float kv = zs[r * RWSH + GW + h * HD + i], rv = zs[r * RWSH + h * HD + i];
            float kk = kv * p.rw_kk[l * GW + h * HD + i];
            ss += kk * kk;
            bs += rv * kv * p.rw_rk[(l * NH + h) * HD + i];
          }
          part[pr * 8 + sub] = ss;
          part[256 + pr * 8 + sub] = bs;
        }
      }
      __syncthreads();
      for (int c = tid; c < GW; c += 256) {
        const int h = c / HD;
        float wa0[8], wa1[8], aa0[8], aa1[8], gg[8];
#pragma unroll
        for (int r = 0; r < 8; ++r) { wa0[r] = 0.f; wa1[r] = 0.f; aa0[r] = 0.f; aa1[r] = 0.f; gg[r] = 0.f; }
#pragma unroll 8
        for (int i = 0; i < 32; ++i) {
          float w20 = p.rw_w2[((size_t)(l * 2 + 0) * 32 + i) * GW + c], w21 = p.rw_w2[((size_t)(l * 2 + 1) * 32 + i) * GW + c];
          float a20 = p.rw_a2[((size_t)(l * 2 + 0) * 32 + i) * GW + c], a21 = p.rw_a2[((size_t)(l * 2 + 1) * 32 + i) * GW + c];
#pragma unroll
          for (int r = 0; r < 8; ++r) {
            float tw = zs[r * RWSH + 3 * GW + i], al = zs[r * RWSH + 3 * GW + 32 + i];
            wa0[r] = fmaf(tw, w20, wa0[r]); wa1[r] = fmaf(tw, w21, wa1[r]);
            aa0[r] = fmaf(al, a20, aa0[r]); aa1[r] = fmaf(al, a21, aa1[r]);
          }
        }
#pragma unroll 16
        for (int j = 0; j < 64; ++j) {
          float g2 = p.rw_g2[((size_t)l * 64 + j) * GW + c];
#pragma unroll
          for (int r = 0; r < 8; ++r) gg[r] = fmaf(zs[r * RWSH + 3 * GW + 64 + j], g2, gg[r]);
        }
        const float ka = p.rw_ka[l * GW + c], kks = p.rw_kk[l * GW + c];
        const float w00 = p.rw_w0[(l * 2 + 0) * GW + c], w01 = p.rw_w0[(l * 2 + 1) * GW + c];
        const float a00 = p.rw_a0[(l * 2 + 0) * GW + c], a01 = p.rw_a0[(l * 2 + 1) * GW + c];
#pragma unroll
        for (int r = 0; r < 8; ++r) {
          const int pr = r * NH + h;
          float ss = 0.f, bs = 0.f;
#pragma unroll
          for (int u = 0; u < 8; ++u) { ss += part[pr * 8 + u]; bs += part[256 + pr * 8 + u]; }
          const float rr = zs[r * RWSH + c], k = zs[r * RWSH + GW + c], v = zs[r * RWSH + 2 * GW + c];
          const float kkv = k * kks / sqrtf(ss + 1e-12f);
          const size_t o = (size_t)(row0 + r) * GW + c;
          p.RW[0 * AS + o] = rr;
          p.RW[1 * AS + o] = kkv;
          p.BON[o] = bs * v;
          p.GG[o] = gg[r];
#pragma unroll
          for (int d = 0; d < 2; ++d) {
            float wpre = (d ? w01 : w00) + (d ? wa1[r] : wa0[r]);
            float decay = expf(-expf(-softplusf_(-wpre) - 0.5f));
            float a = sigmoidf_((d ? a01 : a00) + (d ? aa1[r] : aa0[r]));
            p.RW[(2 + d) * AS + o] = decay;
            p.RW[(4 + d) * AS + o] = k * (1.0f + (a - 1.0f) * ka);
            p.RW[(6 + d) * AS + o] = kkv * a;
          }
        }
      }
    }
    __syncthreads();
  }
#if SB == 8
  for (int it = blockIdx.x; it < hyena_mfma_items(l); it += gridDim.x) hyena_mfma_item<0>(p, l, it, (bf16_t*)lds, tid);
  __syncthreads();
#else
  for (int it = gtid; it < hyena_items(l); it += gsize) hyena_conv_item<0>(p, l, it);
#endif
}

__device__ __forceinline__ int scan_pos(int dir, int step) {
  if (!dir) return step;
  return step < CTX ? CTX - 1 - step : RPB - 1 - (step - CTX);
}
#ifndef CPU_EMU
__device__ __forceinline__ float quad_sum(float v) {
  v += __int_as_float(__builtin_amdgcn_mov_dpp(__float_as_int(v), 0xB1, 0xF, 0xF, true));
  v += __int_as_float(__builtin_amdgcn_mov_dpp(__float_as_int(v), 0x4E, 0xF, 0xF, true));
  return v;
}
__device__ __forceinline__ float oct_sum(float v) {
  v = quad_sum(v);
  v += __int_as_float(__builtin_amdgcn_mov_dpp(__float_as_int(v), 0x141, 0xF, 0xF, true));
  return v;
}
#endif
#define SCT 16
#define NCHUNK (RPB / SCT)
__device__ __forceinline__ void bscan_rwkv(const P& p, int l, int bl, int h, int dir, int half, float* lds, int tid) {
  const int i = half * 32 + (tid >> 3), kq = tid & 7, st = tid >> 4, sp = tid & 15;
  float S[8];
#pragma unroll
  for (int d = 0; d < 8; ++d) S[d] = 0.f;
  float* H = dir ? p.HB : p.HF;
  const size_t AS = (size_t)RS * GW;
  const int vc = 2 * GW + h * HD + sp * 4;
  const f4 mu0 = ld4(p.rw_mu + (size_t)(l * 2 + 0) * RWSH + vc), mu1 = ld4(p.rw_mu + (size_t)(l * 2 + 1) * RWSH + vc);
  f4 rg[5], rv;
  auto load = [&](int c) {
    const int pp = scan_pos(dir, c * SCT + st), row = bl * RPB + pp;
    const size_t o = (size_t)row * GW + h * HD + sp * 4;
    rg[0] = ld4(p.RW + 0 * AS + o);
    rg[1] = ld4(p.RW + 1 * AS + o);
    rg[2] = ld4(p.RW + (size_t)(2 + dir) * AS + o);
    rg[3] = ld4(p.RW + (size_t)(4 + dir) * AS + o);
    rg[4] = ld4(p.RW + (size_t)(6 + dir) * AS + o);
    const bf16_t* pr = p.PROJ + (size_t)row * LDP + OFF_RW + vc;
    f4 x = ldbf4(pr), xm = x, xp = x;
    xm.x = xm.y = xm.z = xm.w = 0.f; xp = xm;
    if (has_prev(pp)) xm = ldbf4(pr - LDP);
    if (has_next(pp)) xp = ldbf4(pr + LDP);
    rv.x = x.x + mu0.x * (xm.x - x.x) + mu1.x * (xp.x - x.x);
    rv.y = x.y + mu0.y * (xm.y - x.y) + mu1.y * (xp.y - x.y);
    rv.z = x.z + mu0.z * (xm.z - x.z) + mu1.z * (xp.z - x.z);
    rv.w = x.w + mu0.w * (xm.w - x.w) + mu1.w * (xp.w - x.w);
  };
  load(0);
  for (int c = 0; c < NCHUNK; ++c) {
    __syncthreads();
#pragma unroll
    for (int a = 0; a < 5; ++a) st4(lds + (st * 6 + a) * 64 + sp * 4, rg[a]);
    st4(lds + (st * 6 + 5) * 64 + sp * 4, rv);
    __syncthreads();
    if (c + 1 < NCHUNK) load(c + 1);
    struct RwOps { float r[8], k[8], w[8], d[8], b[8], vv; };
    auto ldstep = [&](RwOps& o, int t) {
      const float* L = lds + t * 6 * 64 + kq * 8;
      o.vv = lds[(t * 6 + 5) * 64 + i];
      ld8(o.k, L + 1 * 64);
      ld8(o.w, L + 2 * 64);
      ld8(o.d, L + 3 * 64);
      ld8(o.b, L + 4 * 64);
      ld8(o.r, L + 0 * 64);
    };
    auto step = [&](const RwOps& o, int t) {
      float sa4[4] = {0.f, 0.f, 0.f, 0.f};
#pragma unroll
      for (int d = 0; d < 8; ++d) sa4[d & 3] = fmaf(S[d], o.k[d], sa4[d & 3]);
      const float sa = -oct_sum((sa4[0] + sa4[1]) + (sa4[2] + sa4[3]));
      float y4[4] = {0.f, 0.f, 0.f, 0.f};
#pragma unroll
      for (int d = 0; d < 8; ++d) {
        S[d] = fmaf(S[d], o.w[d], fmaf(sa, o.b[d], o.vv * o.d[d]));
        y4[d & 3] = fmaf(S[d], o.r[d], y4[d & 3]);
      }
      const float y = oct_sum((y4[0] + y4[1]) + (y4[2] + y4[3]));
      if (kq == 0) {
        const int row = bl * RPB + scan_pos(dir, c * SCT + t);
        H[(size_t)row * 3 * GW + 2 * GW + h * HD + i] = y;
      }
    };
    RwOps oa, ob;
    ldstep(oa, 0);
#pragma nounroll
    for (int t = 0; t < SCT; t += 2) {
      ldstep(ob, t + 1);
      step(oa, t);
      if (t + 2 < SCT) ldstep(oa, t + 2);
      step(ob, t + 1);
    }
  }
}
__device__ __forceinline__ void bscan_mlstm(const P& p, int bl, int h, int dir, int half, float* lds, int tid) {
  const int i = half * 32 + (tid >> 3), kq = tid & 7, st = tid >> 4, sp = tid & 15;
  float C[8], n[8];
#pragma unroll
  for (int d = 0; d < 8; ++d) { C[d] = 0.f; n[d] = 0.f; }
  float m = 0.f;
  float* H = dir ? p.HB : p.HF;
  f4 rq, rk, rv;
  float g0 = 0.f, g1 = 0.f;
  auto load = [&](int c) {
    const int pp = scan_pos(dir, c * SCT + st), row = bl * RPB + pp;
    const float* q = p.MQK + (size_t)row * 2 * GW + h * HD + sp * 4;
    rq = ld4(q);
    rk = ld4(q + GW);
    rv = ldbf4(p.PROJ + (size_t)row * LDP + OFF_ML + 2 * GW + h * HD + sp * 4);
    if (sp == 0) {
      const float* mg = p.MG + (size_t)row * 4 * NH;
      g0 = mg[(dir ? 2 : 0) * NH + h];
      g1 = mg[(dir ? 3 : 1) * NH + h];
    }
  };
  load(0);
  for (int c = 0; c < NCHUNK; ++c) {
    __syncthreads();
    st4(lds + (st * 4 + 0) * 64 + sp * 4, rq);
    st4(lds + (st * 4 + 1) * 64 + sp * 4, rk);
    st4(lds + (st * 4 + 2) * 64 + sp * 4, rv);
    if (sp == 0) { lds[(st * 4 + 3) * 64 + 0] = g0; lds[(st * 4 + 3) * 64 + 1] = g1; }
    __syncthreads();
    if (c + 1 < NCHUNK) load(c + 1);
    struct MlOps { float q[8], k[8], ig, lf, v; };
    auto ldstep = [&](MlOps& o, int t) {
      const float* L = lds + t * 4 * 64;
      o.ig = L[3 * 64 + 0]; o.lf = L[3 * 64 + 1]; o.v = L[2 * 64 + i];
      ld8(o.q, L + kq * 8);
      ld8(o.k, L + 64 + kq * 8);
    };
    auto step = [&](const MlOps& o, int t) {
      const float mn = fmaxf(o.lf + m, o.ig);
      const float f = fexp_(o.lf + m - mn), ii = fexp_(o.ig - mn), em = fexp_(-mn);
      m = mn;
      const float iv = ii * o.v;
      float num4[4] = {0.f, 0.f, 0.f, 0.f}, den4[4] = {0.f, 0.f, 0.f, 0.f};
#pragma unroll
      for (int d = 0; d < 8; ++d) {
        const float kd = o.k[d], qd = o.q[d];
        C[d] = fmaf(kd, iv, f * C[d]);
        n[d] = fmaf(kd, ii, f * n[d]);
        num4[d & 3] = fmaf(qd, C[d], num4[d & 3]);
        den4[d & 3] = fmaf(qd, n[d], den4[d & 3]);
      }
      const float num = oct_sum((num4[0] + num4[1]) + (num4[2] + num4[3]));
      const float den = oct_sum((den4[0] + den4[1]) + (den4[2] + den4[3]));
      if (kq == 0) {
        const int row = bl * RPB + scan_pos(dir, c * SCT + t);
        H[(size_t)row * 3 * GW + 0 * GW + h * HD + i] = num * frcp_(fmaxf(fabsf(den), em));
      }
    };
    MlOps oa, ob;
    ldstep(oa, 0);
#pragma nounroll
    for (int t = 0; t < SCT; t += 2) {
      ldstep(ob, t + 1);
      step(oa, t);
      if (t + 2 < SCT) ldstep(oa, t + 2);
      step(ob, t + 1);
    }
  }
}
__device__ __forceinline__ void bscan_ret(const P& p, int bl, int h, int dir, int half, float* lds, int tid) {
  const int i = half * 32 + (tid >> 3), kq = tid & 7, st = tid >> 4, sp = tid & 15;
  float S[8];
#pragma unroll
  for (int d = 0; d < 8; ++d) S[d] = 0.f;
  const int hh = dir ? NH - 1 - h : h;
  const float gamma = 1.0f - exp2f(-5.0f - (float)hh);
  float* H = dir ? p.HB : p.HF;
  f4 rq, rk, rv;
  auto load = [&](int c) {
    const int pp = scan_pos(dir, c * SCT + st), row = bl * RPB + pp;
    const float* q = p.RQK + (size_t)row * 2 * GW + h * HD + sp * 4;
    rq = ld4(q);
    rk = ld4(q + GW);
    rv = ldbf4(p.PROJ + (size_t)row * LDP + OFF_RT + 2 * GW + h * HD + sp * 4);
  };
  load(0);
  for (int c = 0; c < NCHUNK; ++c) {
    __syncthreads();
    st4(lds + (st * 4 + 0) * 64 + sp * 4, rq);
    st4(lds + (st * 4 + 1) * 64 + sp * 4, rk);
    st4(lds + (st * 4 + 2) * 64 + sp * 4, rv);
    __syncthreads();
    if (c + 1 < NCHUNK) load(c + 1);
    struct RtOps { float q[8], k[8], v; };
    auto ldstep = [&](RtOps& o, int t) {
      const float* L = lds + t * 4 * 64;
      o.v = L[2 * 64 + i];
      ld8(o.q, L + kq * 8);
      ld8(o.k, L + 64 + kq * 8);
    };
    auto step = [&](const RtOps& o, int t) {
      float o4[4] = {0.f, 0.f, 0.f, 0.f};
#pragma unroll
      for (int d = 0; d < 8; ++d) {
        S[d] = fmaf(S[d], gamma, o.k[d] * o.v);
        o4[d & 3] = fmaf(o.q[d], S[d], o4[d & 3]);
      }
      const float ov = oct_sum((o4[0] + o4[1]) + (o4[2] + o4[3]));
      if (kq == 0) {
        const int row = bl * RPB + scan_pos(dir, c * SCT + t);
        H[(size_t)row * 3 * GW + 1 * GW + h * HD + i] = ov;
      }
    };
    RtOps oa, ob;
    ldstep(oa, 0);
#pragma nounroll
    for (int t = 0; t < SCT; t += 2) {
      ldstep(ob, t + 1);
      step(oa, t);
      if (t + 2 < SCT) ldstep(oa, t + 2);
      step(ob, t + 1);
    }
  }
}
#define NSCAN (3 * SB * NH * 2 * 2)
__device__ __forceinline__ void ph_scan(const P& p, int l, int s, int gtid, int gsize, float* lds, int tid) {
  for (int w = blockIdx.x; w < NSCAN; w += gridDim.x) {
    int mixer = w / (SB * NH * 4), r = w % (SB * NH * 4);
    int half = r & 1, dir = (r >> 1) & 1, h = (r >> 2) % NH, bl = (r >> 2) / NH;
    if (mixer == 0) bscan_rwkv(p, l, bl, h, dir, half, lds, tid);
    else if (mixer == 1) bscan_mlstm(p, bl, h, dir, half, lds, tid);
    else bscan_ret(p, bl, h, dir, half, lds, tid);
    __syncthreads();
  }
#if SB == 8
  {
    int* sh = (int*)lds;
    const int nitem = hyena_mfma_items(l);
    for (;;) {
      __syncthreads();
      if (tid == 0) sh[0] = atomicAdd(p.ctr, 1);
      __syncthreads();
      const int it = sh[0];
      if (it >= nitem) break;
      hyena_mfma_item<1>(p, l, it, (bf16_t*)lds, tid);
    }
  }
#else
  for (int it = gtid; it < hyena_items(l); it += gsize) hyena_conv_item<1>(p, l, it);
#endif
}

#define NE (HD / WL)
__device__ __forceinline__ void ph_fin(const P& p, int l, int s, int gtid, int gsize) {
  const bool last = (l == DEPTH - 1);
  const int lane = gtid % WL, gw = gtid / WL, nw = gsize / WL;
  for (int item = gw; item < (RS / 4) * 4 * NH; item += nw) {
    const int hg = item % (4 * NH), row0 = (item / (4 * NH)) * 4, pp0 = row0 % RPB;
    if (last && pp0 < CTX) continue;
    const int g = hg / NH, h = hg % NH;
    const int c0 = g * GW + h * HD;
    float val[4][NE];
#pragma unroll
    for (int r = 0; r < 4; ++r) {
      const int row = row0 + r;
#pragma unroll
      for (int e = 0; e < NE; ++e) {
        const int i = e * WL + lane;
        float v;
        if (g == 1) v = p.HY[(size_t)row * GW + h * HD + i];
        else {
          const int slot = (g == 0) ? 0 : (g == 2 ? 1 : 2);
          const size_t o = (size_t)row * 3 * GW + slot * GW + h * HD + i;
          v = p.HF[o] + p.HB[o];
        }
        val[r][e] = v;
      }
    }
    float mu[4], rs[4];
#pragma unroll
    for (int r = 0; r < 4; ++r) {
      float sm = 0.f;
#pragma unroll
      for (int e = 0; e < NE; ++e) sm += val[r][e];
      mu[r] = wave_sum(sm) * (1.0f / HD);
    }
#pragma unroll
    for (int r = 0; r < 4; ++r) {
      float q = 0.f;
#pragma unroll
      for (int e = 0; e < NE; ++e) { float d = val[r][e] - mu[r]; q += d * d; }
      rs[r] = 1.0f / sqrtf(wave_sum(q) * (1.0f / HD) + 1e-5f);
    }
#pragma unroll
    for (int r = 0; r < 4; ++r) {
      const int row = row0 + r;
#pragma unroll
      for (int e = 0; e < NE; ++e) {
        const int i = e * WL + lane;
        float v = (val[r][e] - mu[r]) * rs[r] * p.ng[l * DM + c0 + i] + p.nb[l * DM + c0 + i];
        if (g == 0) v *= sigmoidf_(PJ(row, OFF_ML + 3 * GW + h * HD + i));
        else if (g == 2) v *= siluf_(PJ(row, OFF_RT + 3 * GW + h * HD + i));
        else if (g == 3) v = p.GG[(size_t)row * GW + h * HD + i] * (v + p.BON[(size_t)row * GW + h * HD + i]);
        p.U[(size_t)row * DM + c0 + i] = f2bf(v);
      }
    }
  }
}

__device__ __forceinline__ void ph_act(const P& p, int l, int s, int gtid, int gsize) {
  const bool last = (l == DEPTH - 1);
  const float* cw = p.f_cw + (size_t)l * 3 * DFF;
  const float* cb = p.f_cb + (size_t)l * DFF;
  for (int it = gtid; it < RS * (DFF / 8); it += gsize) {
    const int j = (it % (DFF / 8)) * 8, row = it / (DFF / 8), pp = row % RPB;
    if (last && pp < CTX) continue;
    const bf16_t* hr = p.HFF + (size_t)row * 2 * DFF;
    unsigned am[4] = {0u, 0u, 0u, 0u}, a0[4], ap[4] = {0u, 0u, 0u, 0u}, bv[4], ov[4];
#pragma unroll
    for (int e = 0; e < 4; ++e) { a0[e] = ((const unsigned*)(hr + j))[e]; bv[e] = ((const unsigned*)(hr + DFF + j))[e]; }
    if (has_prev(pp)) {
#pragma unroll
      for (int e = 0; e < 4; ++e) am[e] = ((const unsigned*)(hr - 2 * DFF + j))[e];
    }
    if (has_next(pp)) {
#pragma unroll
      for (int e = 0; e < 4; ++e) ap[e] = ((const unsigned*)(hr + 2 * DFF + j))[e];
    }
#pragma unroll
    for (int e = 0; e < 4; ++e) {
      float o[2];
#pragma unroll
      for (int hh = 0; hh < 2; ++hh) {
        const int jj = j + 2 * e + hh;
        float xm = bf2f((bf16_t)(am[e] >> (16 * hh))), x0 = bf2f((bf16_t)(a0[e] >> (16 * hh))), xp = bf2f((bf16_t)(ap[e] >> (16 * hh)));
        float v = cw[jj] * xm + cw[DFF + jj] * x0 + cw[2 * DFF + jj] * xp + cb[jj];
        o[hh] = siluf_(v) * bf2f((bf16_t)(bv[e] >> (16 * hh)));
      }
      ov[e] = pack_bf16(o[0], o[1]);
    }
#pragma unroll
    for (int e = 0; e < 4; ++e) ((unsigned*)(p.ACT + (size_t)row * DFF + j))[e] = ov[e];
  }
}

enum { PH_PRO_A = 0, PH_PRO_B, PH_PRO_C, PH_LN0, PH_GEMM_IN, PH_PREP, PH_SCAN, PH_FIN, PH_GEMM_OUT, PH_LN1, PH_GEMM_UP, PH_ACT, PH_GEMM_DN, PH_LN2, PH_COUNT };

__device__ __forceinline__ void run_phase(const P& p, int ph, int l, int s, bf16_t* lds) {
  int tid = threadIdx.x;
#ifndef CPU_EMU
  asm volatile("" : "+v"(tid));
#endif
  const int gtid = blockIdx.x * blockDim.x + tid;
  const int gsize = gridDim.x * blockDim.x;
  const bool last = (l == DEPTH - 1);
  switch (ph) {
    case PH_PRO_A: ph_pro_a(p, gtid, gsize); break;
    case PH_PRO_B: ph_pro_b(p, gtid, gsize); break;
    case PH_PRO_C: ph_pro_c(p, gtid, gsize); break;
    case PH_LN0: ph_ln0(p, l, s, gtid, gsize); break;
    case PH_GEMM_IN: gemm_phase<true>(p.U, p.wt_in + (size_t)l * LDP * DM, p.PROJ, RS, LDP, DM, LDP, false, lds, tid); break;
    case PH_PREP: ph_prep(p, l, s, gtid, gsize, (float*)lds, tid); break;
    case PH_SCAN: ph_scan(p, l, s, gtid, gsize, (float*)lds, tid); break;
    case PH_FIN: ph_fin(p, l, s, gtid, gsize); break;
    case PH_GEMM_OUT: gemm_phase<false>(p.U, p.wt_out + (size_t)l * DM * DM, p.OUTF, RS, DM, DM, DM, last, lds, tid); break;
    case PH_LN1: ph_ln1(p, l, s, gtid, gsize); break;
    case PH_GEMM_UP: gemm_phase<true>(p.U, p.wt_up + (size_t)l * 2 * DFF * DM, p.HFF, RS, 2 * DFF, DM, 2 * DFF, last, lds, tid); break;
    case PH_ACT: ph_act(p, l, s, gtid, gsize); break;
    case PH_GEMM_DN: gemm_phase<false>(p.ACT, p.wt_dn + (size_t)l * DM * DFF, p.OUTF, RS, DM, DFF, DM, last, lds, tid); break;
    case PH_LN2: ph_ln2(p, l, s, gtid, gsize); break;
  }
}

#ifndef CPU_EMU
#define XB_TMO      128
#define XB_XCNT(j)  (256  + 64 * (j))
#define XB_XSUB(j)  (1280 + 64 * (j))
#define XB_XGEN(j)  (2304 + 64 * (j))
#define XB_TOP      3328
#define XB_TOPGEN   3392
#define XCD_BAR_WORDS 3456
#define XB_SPIN_CAP (1u << 22)
#define LAS __attribute__((address_space(3)))

__device__ __forceinline__ unsigned xb_ld(unsigned* p)              { return __hip_atomic_load(p, __ATOMIC_RELAXED, __HIP_MEMORY_SCOPE_AGENT); }
__device__ __forceinline__ unsigned xb_add(unsigned* p, unsigned v) { return __hip_atomic_fetch_add(p, v, __ATOMIC_RELAXED, __HIP_MEMORY_SCOPE_AGENT); }
__device__ __forceinline__ unsigned xb_xcc_id() { return (unsigned)__builtin_amdgcn_s_getreg((3 << 11) | 20) & 0xFu; }
#define XB_SPIN(cond, bar) do { unsigned _sp = 0; while (cond) { __builtin_amdgcn_s_sleep(1); \
    if ((++_sp & 255u) == 0u) { if (xb_ld(&(bar)[XB_TMO])) break; if (_sp > XB_SPIN_CAP) { atomicAdd(&(bar)[XB_TMO], 1u); break; } } } } while (0)

struct XcdBarrier {
    unsigned* bar; unsigned x;
    volatile LAS unsigned* st;
};

__device__ __forceinline__ XcdBarrier xcd_barrier_post(unsigned* bar, volatile LAS unsigned* st) {
    XcdBarrier b; b.bar = bar; b.x = xb_xcc_id(); b.st = st;
    if (threadIdx.x == 0) (void)xb_add(&bar[XB_XCNT(b.x)], 1u);
    return b;
}
__device__ __forceinline__ void xcd_barrier_complete(unsigned* bar, unsigned x, unsigned& nloc, unsigned& nx) {
    const unsigned G = gridDim.x * gridDim.y * gridDim.z;
    unsigned sum, cnt, mine, sp = 0u;
    for (;;) {
        sum = 0u; cnt = 0u; mine = 0u;
#pragma unroll
        for (unsigned j = 0; j < 16; ++j) { const unsigned c = xb_ld(&bar[XB_XCNT(j)]); sum += c; cnt += (c > 0u) ? 1u : 0u; mine = (j == x) ? c : mine; }
        if (sum == G) break;
        __builtin_amdgcn_s_sleep(1);
        if ((++sp & 255u) == 0u) { if (xb_ld(&bar[XB_TMO])) break; if (sp > XB_SPIN_CAP) { atomicAdd(&bar[XB_TMO], 1u); break; } }
    }
    nloc = mine > 0u ? mine : 1u; nx = cnt > 0u ? cnt : 1u;
}

__device__ __forceinline__ void xcd_barrier(const XcdBarrier& b) {
    asm volatile("s_waitcnt vmcnt(0)" ::: "memory");
    __syncthreads();
    if (threadIdx.x == 0) {
        unsigned* bar = b.bar;
        __builtin_amdgcn_s_waitcnt(0);
        unsigned nloc = b.st[0], nx = b.st[1];
        if (nloc == 0u) { xcd_barrier_complete(bar, b.x, nloc, nx); b.st[0] = nloc; b.st[1] = nx; }
        const unsigned old = xb_add(&bar[XB_XSUB(b.x)], 1u);
        const unsigned gen = old / nloc;
        if (old + 1u == (gen + 1u) * nloc) {
            __builtin_amdgcn_fence(__ATOMIC_RELEASE, "agent");
            asm volatile("s_waitcnt vmcnt(0)" ::: "memory");
            const unsigned og = xb_add(&bar[XB_TOP], 1u);
            const unsigned tg = og / nx;
            if (og + 1u == (tg + 1u) * nx) xb_add(&bar[XB_TOPGEN], 1u);
            else XB_SPIN(xb_ld(&bar[XB_TOPGEN]) == tg, bar);
            __builtin_amdgcn_fence(__ATOMIC_ACQUIRE, "agent");
            xb_add(&bar[XB_XGEN(b.x)], 1u);
            asm volatile("s_waitcnt vmcnt(0)" ::: "memory");
        } else {
            XB_SPIN(xb_ld(&bar[XB_XGEN(b.x)]) == gen, bar);
            __builtin_amdgcn_fence(__ATOMIC_ACQUIRE, "agent");
            asm volatile("s_waitcnt vmcnt(0)" ::: "memory");
        }
    }
    __syncthreads();
}

#endif

#ifndef PROBE_MASK
#define PROBE_MASK 0
#endif
#if PROBE_MASK
#define RUNPH(ph) do { int reps_ = 1 + ((PROBE_MASK >> ph) & 1); asm volatile("" : "+s"(reps_)); for (int q_ = 0; q_ < reps_; ++q_) { run_phase(p, ph, l, s, lds); GSYNC(); } } while (0)
#else
#define RUNPH(ph) do { run_phase(p, ph, l, s, lds); GSYNC(); } while (0)
#endif
#ifndef CPU_EMU
__global__ void __launch_bounds__(256, 2) k_mega(P p) {
  __shared__ __attribute__((aligned(16))) bf16_t lds[24576];
  __shared__ uint4 xb_words;
  cg::grid_group grid = cg::this_grid();
  if (threadIdx.x == 0) xb_words = make_uint4(0u, 0u, 0u, 0u);
  __syncthreads();
  XcdBarrier xb = xcd_barrier_post(p.bar, (volatile LAS unsigned*)&xb_words);
#define GSYNC() xcd_barrier(xb)
  run_phase(p, PH_PRO_A, 0, 0, lds);
  grid.sync();
  run_phase(p, PH_PRO_B, 0, 0, lds);
  GSYNC();
  run_phase(p, PH_PRO_C, 0, 0, lds);
  GSYNC();
  for (int l = 0; l < DEPTH; ++l)
    for (int s = 0; s < NSLICE; ++s)
    {
      RUNPH(PH_LN0);
      RUNPH(PH_GEMM_IN);
      RUNPH(PH_PREP);
      RUNPH(PH_SCAN);
      RUNPH(PH_FIN);
      RUNPH(PH_GEMM_OUT);
      RUNPH(PH_LN1);
      RUNPH(PH_GEMM_UP);
      RUNPH(PH_ACT);
      RUNPH(PH_GEMM_DN);
      RUNPH(PH_LN2);
    }
}
#endif

static size_t ws_take(size_t& off, size_t bytes) { size_t o = off; off += (bytes + 255) & ~(size_t)255; return o; }

static void build_params(P& p, void* const* d_in, void* d_out, void* d_ws) {
  const float** f = (const float**)&p;
  for (int i = 0; i < 39; ++i) f[i] = (const float*)d_in[i];
  p.out = (float*)d_out;
  char* w = (char*)d_ws;
  size_t off = 0;
  p.wt_in = (bf16_t*)(w + ws_take(off, (size_t)DEPTH * LDP * DM * 2));
  p.wt_out = (bf16_t*)(w + ws_take(off, (size_t)DEPTH * DM * DM * 2));
  p.wt_up = (bf16_t*)(w + ws_take(off, (size_t)DEPTH * 2 * DFF * DM * 2));
  p.wt_dn = (bf16_t*)(w + ws_take(off, (size_t)DEPTH * DM * DFF * 2));
  p.kf_lat = (float*)(w + ws_take(off, (size_t)DEPTH * 2 * 2 * SEQ * GW * 4));
  p.kf_ctx = (float*)(w + ws_take(off, (size_t)DEPTH * 2 * 2 * CTX * GW * 4));
  p.kt_lat = (bf16_t*)(w + ws_take(off, (size_t)DEPTH * 2 * 2 * SEQ * GW * 2));
  p.kt_ctx = (bf16_t*)(w + ws_take(off, (size_t)DEPTH * 2 * 2 * CTX * GW * 2));
  p.ropec = (float*)(w + ws_take(off, 64 * 16 * 4));
  p.ropes = (float*)(w + ws_take(off, 64 * 16 * 4));
  p.hyh1 = (float*)(w + ws_take(off, (size_t)DEPTH * 2 * SEQ * 64 * 4));
  p.hyh2 = (float*)(w + ws_take(off, (size_t)DEPTH * 2 * SEQ * 64 * 4));
  p.scv = (float*)(w + ws_take(off, (size_t)NMOD * DM * 4));
  p.modtab = (float*)(w + ws_take(off, (size_t)DEPTH * NMOD * 6 * DM * 4));
  p.xc = (float*)(w + ws_take(off, (size_t)NB * CTX * DM * 4));
  p.ctr = (int*)(w + ws_take(off, 256));
  p.bar = (unsigned*)(w + ws_take(off, 16384));
  p.U = (bf16_t*)(w + ws_take(off, (size_t)RS * DM * 2));
  size_t arena = off;
  p.PROJ = (bf16_t*)(w + ws_take(off, (size_t)RS * LDP * 2));
  p.MQK = (float*)(w + ws_take(off, (size_t)RS * 2 * GW * 4));
  p.MG = (float*)(w + ws_take(off, (size_t)RS * 4 * NH * 4));
  p.RQK = (float*)(w + ws_take(off, (size_t)RS * 2 * GW * 4));
  p.RW = (float*)(w + ws_take(off, (size_t)8 * RS * GW * 4));
  p.HF = (float*)(w + ws_take(off, (size_t)RS * 3 * GW * 4));
  p.HB = (float*)(w + ws_take(off, (size_t)RS * 3 * GW * 4));
  p.Z2 = (float*)(w + ws_take(off, (size_t)RS * GW * 4));
  p.HY = (float*)(w + ws_take(off, (size_t)RS * GW * 4));
  p.BON = (float*)(w + ws_take(off, (size_t)RS * GW * 4));
  p.GG = (float*)(w + ws_take(off, (size_t)RS * GW * 4));
  size_t off2 = arena;
  p.OUTF = (float*)(w + ws_take(off2, (size_t)RS * DM * 4));
  p.HFF = (bf16_t*)(w + ws_take(off2, (size_t)RS * 2 * DFF * 2));
  p.ACT = (bf16_t*)(w + ws_take(off2, (size_t)RS * DFF * 2));
}

#ifndef CPU_EMU
extern "C" void kernel_launch(void* const* d_in, const int* in_sizes, int n_in, void* d_out, int out_size, void* d_ws, size_t ws_size,
                              hipStream_t stream) {
  static int grid_blocks = 0;
  if (!grid_blocks) {
    int dev = 0, cus = 0, per_cu = 0;
    hipGetDevice(&dev);
    hipDeviceGetAttribute(&cus, hipDeviceAttributeMultiprocessorCount, dev);
    hipOccupancyMaxActiveBlocksPerMultiprocessor(&per_cu, k_mega, 256, 0);
    if (per_cu < 1) per_cu = 1;
    grid_blocks = cus * per_cu;
  }
  P p;
  memset(&p, 0, sizeof(p));
  build_params(p, d_in, d_out, d_ws);
  hipMemsetAsync(p.bar, 0, XCD_BAR_WORDS * sizeof(unsigned), stream);
  void* args[] = {&p};
  hipError_t e = hipLaunchCooperativeKernel((void*)k_mega, dim3(grid_blocks), dim3(256), args, 0, stream);
  if (e != hipSuccess) fprintf(stderr, "cooperative launch failed: %s (grid %d)\n", hipGetErrorString(e), grid_blocks);
}
#endif
```

```cpp
#ifndef CPU_EMU
#include <hip/hip_runtime.h>
#include <hip/hip_cooperative_groups.h>
#include <cstdio>
#include <cstring>
namespace cg = cooperative_groups;
#endif
#include <stdint.h>
#include <stddef.h>

#if !defined(CFG_SMALL) && !defined(CFG_CONVTEST)
#define DM 1024
#define NB 32
#define SEQ 2048
#define CTX 256
#define DFF 2816
#define SB 8
#elif defined(CFG_CONVTEST)
#define DM 512
#define NB 8
#define SEQ 256
#define CTX 128
#define DFF 192
#define SB 8
#else
#define DM 512
#define NB 2
#define SEQ 256
#define CTX 128
#define DFF 192
#define SB 1
#endif
#define DEPTH 2
#define GRIDW 64
#define HD 64
#define GW (DM / 4)
#define NH (GW / HD)
#define DPROJ (14 * GW + 4 * NH + 128)
#define LDP ((DPROJ + 127) / 128 * 128)
#define OFF_ML 0
#define OFF_HY (4 * GW + 4 * NH)
#define OFF_RT (OFF_HY + 3 * GW)
#define OFF_RW (OFF_RT + 4 * GW)
#define RWSH (3 * GW + 128)
#define RPB (CTX + SEQ)
#define RS (SB * RPB)
#define NSLICE (NB / SB)
#define ALPHA 1.41421356237309515f
#define NMOD 33
#ifdef CPU_EMU
#define WL 1
#else
#define WL 64
#endif

typedef unsigned short bf16_t;

struct P {
  const float *x, *c, *ctx, *c_ctx, *ada_w, *ada_b, *w_in, *ml_cw, *ml_cb, *ml_gb, *hy_cw, *hy_cb, *hy_w1, *hy_b1, *hy_w2, *hy_b2, *hy_w3,
      *hy_freq, *hy_d, *rw_mu, *rw_w0, *rw_w2, *rw_a0, *rw_a2, *rw_g2, *rw_kk, *rw_ka, *rw_rk, *ng, *nb, *w_out, *ln1g, *ln1b, *w_up, *f_cw,
      *f_cb, *w_dn, *ln2g, *ln2b;
  float* out;
  bf16_t *wt_in, *wt_out, *wt_up, *wt_dn;
  float *kf_lat, *kf_ctx, *hyh1, *hyh2, *scv, *modtab, *xc;
  bf16_t *kt_lat, *kt_ctx;
  float *ropec, *ropes;
  bf16_t *U, *PROJ;
  float *MQK, *MG, *RQK, *RW, *HF, *HB, *Z2, *HY, *BON, *GG;
  float* OUTF;
  bf16_t *HFF, *ACT;
  int* ctr;
  unsigned* bar;
};

__device__ __forceinline__ bf16_t f2bf(float f) {
  unsigned u = __float_as_uint(f);
  u += 0x7fffu + ((u >> 16) & 1u);
  return (bf16_t)(u >> 16);
}
#ifndef CPU_EMU
typedef __bf16 bf16v2_t __attribute__((ext_vector_type(2)));
typedef float f32x2_t __attribute__((ext_vector_type(2)));
#endif
__device__ __forceinline__ unsigned pack_bf16(float lo, float hi) {
#ifndef CPU_EMU
  f32x2_t v = {lo, hi};
  bf16v2_t b = __builtin_convertvector(v, bf16v2_t);
  return __builtin_bit_cast(unsigned, b);
#else
  return f2bf(lo) | ((unsigned)f2bf(hi) << 16);
#endif
}
__device__ __forceinline__ float bf2f(bf16_t h) { return __uint_as_float(((unsigned)h) << 16); }
#ifndef CPU_EMU
__device__ __forceinline__ float fexp_(float x) { return __expf(x); }
__device__ __forceinline__ float frcp_(float x) { return __builtin_amdgcn_rcpf(x); }
#else
__device__ __forceinline__ float fexp_(float x) { return expf(x); }
__device__ __forceinline__ float frcp_(float x) { return 1.0f / x; }
#endif
#ifndef CPU_EMU
__device__ __forceinline__ float sigmoidf_(float x) { return frcp_(1.0f + fexp_(-x)); }
__device__ __forceinline__ float siluf_(float x) { return x * frcp_(1.0f + fexp_(-x)); }
__device__ __forceinline__ float softplusf_(float x) { return fmaxf(x, 0.0f) + log1pf(expf(-fabsf(x))); }
__device__ __forceinline__ float tanhf_(float x) { return 1.0f - 2.0f * frcp_(1.0f + fexp_(2.0f * x)); }
#else
__device__ __forceinline__ float sigmoidf_(float x) { return 1.0f / (1.0f + expf(-x)); }
__device__ __forceinline__ float siluf_(float x) { return x / (1.0f + expf(-x)); }
__device__ __forceinline__ float softplusf_(float x) { return fmaxf(x, 0.0f) + log1pf(expf(-fabsf(x))); }
__device__ __forceinline__ float tanhf_(float x) { return tanhf(x); }
#endif
__device__ __forceinline__ float logsigmoidf_(float x) { return -softplusf_(-x); }

__device__ __forceinline__ float wave_sum(float v) {
#ifndef CPU_EMU
#pragma unroll
  for (int o = 32; o > 0; o >>= 1) v += __shfl_xor(v, o, 64);
#endif
  return v;
}

#ifndef CPU_EMU
typedef float f4 __attribute__((ext_vector_type(4)));
typedef unsigned u2v __attribute__((ext_vector_type(2)));
__device__ __forceinline__ f4 ld4(const float* a) { return *(const f4*)a; }
__device__ __forceinline__ void st4(float* a, f4 v) { *(f4*)a = v; }
__device__ __forceinline__ f4 ldbf4(const bf16_t* a) {
  u2v u = *(const u2v*)a;
  f4 r;
  r.x = __uint_as_float(u.x << 16); r.y = __uint_as_float(u.x & 0xffff0000u);
  r.z = __uint_as_float(u.y << 16); r.w = __uint_as_float(u.y & 0xffff0000u);
  return r;
}
#else
struct f4 { float x, y, z, w; };
__device__ __forceinline__ f4 ld4(const float* a) { f4 r; r.x = a[0]; r.y = a[1]; r.z = a[2]; r.w = a[3]; return r; }
__device__ __forceinline__ void st4(float* a, f4 v) { a[0] = v.x; a[1] = v.y; a[2] = v.z; a[3] = v.w; }
__device__ __forceinline__ f4 ldbf4(const bf16_t* a) { f4 r; r.x = bf2f(a[0]); r.y = bf2f(a[1]); r.z = bf2f(a[2]); r.w = bf2f(a[3]); return r; }
#endif
__device__ __forceinline__ void ld8(float* dst, const float* src) {
#pragma unroll
  for (int j = 0; j < 2; ++j) { f4 v = ld4(src + 4 * j); dst[4 * j] = v.x; dst[4 * j + 1] = v.y; dst[4 * j + 2] = v.z; dst[4 * j + 3] = v.w; }
}
__device__ __forceinline__ void ld16(float* dst, const float* src) {
#pragma unroll
  for (int j = 0; j < 4; ++j) { f4 v = ld4(src + 4 * j); dst[4 * j] = v.x; dst[4 * j + 1] = v.y; dst[4 * j + 2] = v.z; dst[4 * j + 3] = v.w; }
}


__device__ __forceinline__ const float* xsrc_row(const P& p, int l, int b, int pp) {
  if (pp < CTX) return (l == 0 ? p.ctx : p.xc) + ((size_t)b * CTX + pp) * DM;
  return (l == 0 ? p.x : p.out) + ((size_t)b * SEQ + (pp - CTX)) * DM;
}
__device__ __forceinline__ float* xdst_row(const P& p, int b, int pp) {
  if (pp < CTX) return p.xc + ((size_t)b * CTX + pp) * DM;
  return p.out + ((size_t)b * SEQ + (pp - CTX)) * DM;
}
__device__ __forceinline__ bool has_prev(int pp) { return pp != 0 && pp != CTX; }
__device__ __forceinline__ bool has_next(int pp) { return pp != CTX - 1 && pp != RPB - 1; }

__device__ __forceinline__ void cvt_weight(const float* W, bf16_t* Wt, int K, int N, int Npad, int gtid, int gsize) {
  const int nk8 = K / 8;
  for (long it = gtid; it < (long)nk8 * Npad; it += gsize) {
    int n = (int)(it % Npad), k8 = (int)(it / Npad);
    bf16_t v[8];
#pragma unroll
    for (int j = 0; j < 8; ++j) v[j] = (n < N) ? f2bf(W[(size_t)(k8 * 8 + j) * N + n]) : (bf16_t)0;
    uint4 o;
    o.x = v[0] | ((unsigned)v[1] << 16); o.y = v[2] | ((unsigned)v[3] << 16);
    o.z = v[4] | ((unsigned)v[5] << 16); o.w = v[6] | ((unsigned)v[7] << 16);
    *(uint4*)(Wt + (size_t)n * K + k8 * 8) = o;
  }
}
__device__ __forceinline__ void hy_feat_h1(const P& p, int gtid, int gsize) {
  const int per_l = (SEQ + CTX) * 64;
  for (int it = gtid; it < DEPTH * per_l; it += gsize) {
    int l = it / per_l, r = it % per_l;
    int i, L, seg;
    int j = r % 64; r /= 64;
    if (r < SEQ) { seg = 0; i = r; L = SEQ; } else { seg = 1; i = r - SEQ; L = CTX; }
    const float* w1 = p.hy_w1 + (size_t)l * 33 * 64;
    float t = (float)i / (float)(L - 1);
    float ang = 6.283185307179586f * (float)i / (float)L;
    float acc = t * w1[j];
    for (int b = 0; b < 16; ++b) {
      float band = 1e-4f + (float)b * ((15.0f - 1e-4f) / 15.0f);
      float a = band * ang;
      acc += cosf(a) * w1[(1 + b) * 64 + j];
      acc -= sinf(a) * w1[(17 + b) * 64 + j];
    }
    float h = sinf(p.hy_freq[l * 64 + j] * (acc + p.hy_b1[l * 64 + j]));
    p.hyh1[((size_t)(l * 2 + seg) * SEQ + i) * 64 + j] = h;
  }
}
__device__ __forceinline__ void ph_pro_a(const P& p, int gtid, int gsize) {
  for (int l = 0; l < DEPTH; ++l) {
    cvt_weight(p.w_in + (size_t)l * DM * DPROJ, p.wt_in + (size_t)l * LDP * DM, DM, DPROJ, LDP, gtid, gsize);
    cvt_weight(p.w_out + (size_t)l * DM * DM, p.wt_out + (size_t)l * DM * DM, DM, DM, DM, gtid, gsize);
    cvt_weight(p.w_up + (size_t)l * DM * 2 * DFF, p.wt_up + (size_t)l * 2 * DFF * DM, DM, 2 * DFF, 2 * DFF, gtid, gsize);
    cvt_weight(p.w_dn + (size_t)l * DFF * DM, p.wt_dn + (size_t)l * DM * DFF, DFF, DM, DM, gtid, gsize);
  }
  for (int it = gtid; it < NMOD * DM; it += gsize) {
    int r = it / DM, k = it % DM;
    float v = (r < NB) ? p.c[(size_t)r * DM + k] : p.c_ctx[k];
    p.scv[it] = siluf_(v);
  }
  hy_feat_h1(p, gtid, gsize);
  for (int it = gtid; it < 64 * 16; it += gsize) {
    float a = (float)(it / 16) * powf(10000.0f, -(float)(it % 16) / 16.0f);
    p.ropec[it] = cosf(a);
    p.ropes[it] = sinf(a);
  }
}
__device__ __forceinline__ void ph_pro_b(const P& p, int gtid, int gsize) {
  for (int it = gtid; it < DEPTH * NMOD * 6 * DM; it += gsize) {
    int j = it % (6 * DM), r = (it / (6 * DM)) % NMOD, l = it / (6 * DM * NMOD);
    const float* w = p.ada_w + (size_t)l * DM * 6 * DM + j;
    const float* sv = p.scv + r * DM;
    float acc = 0.f;
    for (int k = 0; k < DM; ++k) acc += sv[k] * w[(size_t)k * 6 * DM];
    p.modtab[it] = acc + p.ada_b[l * 6 * DM + j];
  }
  const int per_l = (SEQ + CTX) * 64;
  for (int it = gtid; it < DEPTH * per_l; it += gsize) {
    int l = it / per_l, r = it % per_l;
    int j = r % 64; r /= 64;
    int seg = r < SEQ ? 0 : 1, i = r < SEQ ? r : r - SEQ;
    const float* h1 = p.hyh1 + ((size_t)(l * 2 + seg) * SEQ + i) * 64;
    const float* w2 = p.hy_w2 + (size_t)l * 64 * 64;
    float acc = 0.f;
    for (int k = 0; k < 64; ++k) acc += h1[k] * w2[k * 64 + j];
    p.hyh2[((size_t)(l * 2 + seg) * SEQ + i) * 64 + j] = sinf(p.hy_freq[l * 64 + j] * (acc + p.hy_b2[l * 64 + j]));
  }
}
__device__ __forceinline__ void ph_pro_c(const P& p, int gtid, int gsize) {
  const int per_l = 2 * (2 * SEQ + 2 * CTX) * GW;
  const float max_decay = -4.605170185988091f / 0.3f, min_decay = -4.605170185988091f / 1.5f;
  for (int it = gtid; it < DEPTH * per_l; it += gsize) {
    int l = it / per_l, r = it % per_l;
    int c = r % GW; r /= GW;
    int ord = r & 1; r >>= 1;
    int seg, idx, L;
    if (r < 2 * SEQ) { seg = 0; idx = r; L = SEQ; } else { seg = 1; idx = r - 2 * SEQ; L = CTX; }
    int d = idx - L;
    float val = 0.f;
    if (idx != 0) {
      int i = d < 0 ? -d : d;
      float ti = (float)i / (float)(L - 1);
      float delta = fabsf(min_decay + (float)c * ((max_decay - min_decay) / (float)(GW - 1)));
      float win = expf(-ti * delta);
      const float* h2 = p.hyh2 + ((size_t)(l * 2 + seg) * SEQ + i) * 64;
      const float* w3 = p.hy_w3 + (size_t)l * 64 * 4 * GW;
      float af = 0.f, ab = 0.f;
      for (int k = 0; k < 64; ++k) {
        float hv = h2[k];
        af += hv * w3[k * 4 * GW + 0 * 2 * GW + ord * GW + c];
        ab += hv * w3[k * 4 * GW + 1 * 2 * GW + ord * GW + c];
      }
      if (d > 0) val = af * win;
      else if (d < 0) val = ab * win;
      else val = (af + ab) * win + p.hy_d[(l * 2 + ord) * GW + c];
    }
    float* kf = seg == 0 ? p.kf_lat + ((size_t)(l * 2 + ord) * 2 * SEQ + idx) * GW : p.kf_ctx + ((size_t)(l * 2 + ord) * 2 * CTX + idx) * GW;
    kf[c] = val;
    if (seg == 0) p.kt_lat[((size_t)(l * 2 + ord) * GW + c) * 2 * SEQ + idx] = f2bf(val);
    else p.kt_ctx[((size_t)(l * 2 + ord) * GW + c) * 2 * CTX + idx] = f2bf(val);
  }
}

#define NV (DM / WL)
__device__ __forceinline__ void ln_inplace(float* v, int lane) {
  float s = 0.f;
#pragma unroll
  for (int i = 0; i < NV; ++i) s += v[i];
  s = wave_sum(s);
  float mu = s * (1.0f / DM);
  float q = 0.f;
#pragma unroll
  for (int i = 0; i < NV; ++i) { float d = v[i] - mu; q += d * d; }
  q = wave_sum(q);
  float rs = 1.0f / sqrtf(q * (1.0f / DM) + 1e-5f);
#pragma unroll
  for (int i = 0; i < NV; ++i) v[i] = (v[i] - mu) * rs;
}
__device__ __forceinline__ void ph_ln0(const P& p, int l, int s, int gtid, int gsize) {
  const int lane = gtid % WL, gw = gtid / WL, nw = gsize / WL;
  if (gtid == 0) *p.ctr = 0;
  for (int row = gw; row < RS; row += nw) {
    int bl = row / RPB, pp = row % RPB, b = s * SB + bl;
    const float* xr = xsrc_row(p, l, b, pp);
    const float* mod = p.modtab + ((size_t)l * NMOD + (pp < CTX ? NB : b)) * 6 * DM;
    float v[NV];
#pragma unroll
    for (int i = 0; i < NV; ++i) v[i] = xr[i * WL + lane];
    ln_inplace(v, lane);
#pragma unroll
    for (int i = 0; i < NV; ++i) {
      int k = i * WL + lane;
      p.U[(size_t)row * DM + k] = f2bf(v[i] * (1.0f + mod[DM + k]) + mod[k]);
    }
  }
}
__device__ __forceinline__ void ph_ln1(const P& p, int l, int s, int gtid, int gsize) {
  const int lane = gtid % WL, gw = gtid / WL, nw = gsize / WL;
  const bool last = (l == DEPTH - 1);
  for (int row = gw; row < RS; row += nw) {
    int bl = row / RPB, pp = row % RPB, b = s * SB + bl;
    if (last && pp < CTX) continue;
    const float* xr = xsrc_row(p, l, b, pp);
    float* xd = xdst_row(p, b, pp);
    const float* mod = p.modtab + ((size_t)l * NMOD + (pp < CTX ? NB : b)) * 6 * DM;
    const float* o = p.OUTF + (size_t)row * DM;
    float v[NV];
#pragma unroll
    for (int i = 0; i < NV; ++i) { int k = i * WL + lane; v[i] = ALPHA * xr[k] + mod[2 * DM + k] * o[k]; }
    ln_inplace(v, lane);
#pragma unroll
    for (int i = 0; i < NV; ++i) { int k = i * WL + lane; v[i] = v[i] * p.ln1g[l * DM + k] + p.ln1b[l * DM + k]; xd[k] = v[i]; }
    ln_inplace(v, lane);
#pragma unroll
    for (int i = 0; i < NV; ++i) {
      int k = i * WL + lane;
      p.U[(size_t)row * DM + k] = f2bf(v[i] * (1.0f + mod[4 * DM + k]) + mod[3 * DM + k]);
    }
  }
}
__device__ __forceinline__ void ph_ln2(const P& p, int l, int s, int gtid, int gsize) {
  const int lane = gtid % WL, gw = gtid / WL, nw = gsize / WL;
  const bool last = (l == DEPTH - 1);
  for (int row = gw; row < RS; row += nw) {
    int bl = row / RPB, pp = row % RPB, b = s * SB + bl;
    if (last && pp < CTX) continue;
    float* xd = xdst_row(p, b, pp);
    const float* mod = p.modtab + ((size_t)l * NMOD + (pp < CTX ? NB : b)) * 6 * DM;
    const float* o = p.OUTF + (size_t)row * DM;
    float v[NV];
#pragma unroll
    for (int i = 0; i < NV; ++i) { int k = i * WL + lane; v[i] = ALPHA * xd[k] + mod[5 * DM + k] * o[k]; }
    ln_inplace(v, lane);
#pragma unroll
    for (int i = 0; i < NV; ++i) { int k = i * WL + lane; xd[k] = v[i] * p.ln2g[l * DM + k] + p.ln2b[l * DM + k]; }
  }
}

#ifndef CPU_EMU
typedef short bf16x8 __attribute__((ext_vector_type(8)));
typedef float f32x4 __attribute__((ext_vector_type(4)));
typedef unsigned u32x4 __attribute__((ext_vector_type(4)));
__device__ __forceinline__ f32x4 mfma16(bf16x8 a, bf16x8 b, f32x4 c) { return __builtin_amdgcn_mfma_f32_16x16x32_bf16(a, b, c, 0, 0, 0); }
#define GBM 128
#define GBN 128
#define GBK 64
#define GLD (GBK + 8)
template <bool OUT_BF16>
__device__ __forceinline__ void gemm_phase(const bf16_t* __restrict__ A, const bf16_t* __restrict__ Bt, void* __restrict__ Cv, int M, int N, int K, int ldc,
                           bool skip_ctx, bf16_t* lds, int tid) {
  bf16_t* sA = lds;
  bf16_t* sB = lds + GBM * GLD;
  const int lane = tid & 63, wave = tid >> 6;
  const int wm = wave >> 1, wn = wave & 1;
  const int ntm = M / GBM, ntn = N / GBN;
  const int KT = K / GBK;
  const int lr = lane & 15, lq = lane >> 4;
  for (int tile = blockIdx.x; tile < ntm * ntn; tile += gridDim.x) {
    const int tm = tile / ntn, tn = tile % ntn;
    if (skip_ctx && (tm % (RPB / GBM)) < (CTX / GBM)) continue;
    const int m0 = tm * GBM, n0 = tn * GBN;
    f32x4 acc[4][4];
#pragma unroll
    for (int i = 0; i < 4; ++i)
#pragma unroll
      for (int j = 0; j < 4; ++j) acc[i][j] = (f32x4){0.f, 0.f, 0.f, 0.f};
    u32x4 ra[4], rb[4];
#pragma unroll
    for (int i = 0; i < 4; ++i) {
      int id = tid + i * 256, r = id >> 3, ch = id & 7;
      ra[i] = *(const u32x4*)(A + (size_t)(m0 + r) * K + ch * 8);
      rb[i] = *(const u32x4*)(Bt + (size_t)(n0 + r) * K + ch * 8);
    }
    for (int kt = 0; kt < KT; ++kt) {
      __syncthreads();
#pragma unroll
      for (int i = 0; i < 4; ++i) {
        int id = tid + i * 256, r = id >> 3, ch = id & 7;
        *(u32x4*)(sA + r * GLD + ch * 8) = ra[i];
        *(u32x4*)(sB + r * GLD + ch * 8) = rb[i];
      }
      __syncthreads();
      if (kt + 1 < KT) {
#pragma unroll
        for (int i = 0; i < 4; ++i) {
          int id = tid + i * 256, r = id >> 3, ch = id & 7;
          ra[i] = *(const u32x4*)(A + (size_t)(m0 + r) * K + (kt + 1) * GBK + ch * 8);
          rb[i] = *(const u32x4*)(Bt + (size_t)(n0 + r) * K + (kt + 1) * GBK + ch * 8);
        }
      }
      __builtin_amdgcn_sched_barrier(0);
      {
        bf16x8 fa[2][4], fb[2][4];
#pragma unroll
        for (int kh = 0; kh < 2; ++kh) {
#pragma unroll
          for (int i = 0; i < 4; ++i) fa[kh][i] = *(const bf16x8*)(sA + (wm * 64 + i * 16 + lr) * GLD + kh * 32 + lq * 8);
#pragma unroll
          for (int j = 0; j < 4; ++j) fb[kh][j] = *(const bf16x8*)(sB + (wn * 64 + j * 16 + lr) * GLD + kh * 32 + lq * 8);
        }
        __builtin_amdgcn_sched_barrier(0);
#pragma unroll
        for (int kh = 0; kh < 2; ++kh)
#pragma unroll
          for (int i = 0; i < 4; ++i)
#pragma unroll
            for (int j = 0; j < 4; ++j) acc[i][j] = __builtin_amdgcn_mfma_f32_16x16x32_bf16(fb[kh][j], fa[kh][i], acc[i][j], 0, 0, 0);
      }
    }
#pragma unroll
    for (int i = 0; i < 4; ++i)
#pragma unroll
      for (int j = 0; j < 4; ++j) {
        size_t off = (size_t)(m0 + wm * 64 + i * 16 + lr) * ldc + n0 + wn * 64 + j * 16 + lq * 4;
        if (OUT_BF16) {
          uint2 o;
          o.x = pack_bf16(acc[i][j][0], acc[i][j][1]);
          o.y = pack_bf16(acc[i][j][2], acc[i][j][3]);
          *(uint2*)((bf16_t*)Cv + off) = o;
        } else {
          *(float4*)((float*)Cv + off) = make_float4(acc[i][j][0], acc[i][j][1], acc[i][j][2], acc[i][j][3]);
        }
      }
  }
}
#else
template <bool OUT_BF16>
void gemm_phase(const bf16_t* A, const bf16_t* Bt, void* Cv, int M, int N, int K, int ldc, bool skip_ctx, bf16_t* lds, int tid) {
  int gtid = blockIdx.x * blockDim.x + threadIdx.x, gsize = gridDim.x * blockDim.x;
  for (long it = gtid; it < (long)M * N; it += gsize) {
    int m = (int)(it / N), n = (int)(it % N);
    if (skip_ctx && (m % RPB) < CTX) continue;
    float acc = 0.f;
    for (int k = 0; k < K; ++k) acc += bf2f(A[(size_t)m * K + k]) * bf2f(Bt[(size_t)n * K + k]);
    if (OUT_BF16) ((bf16_t*)Cv)[(size_t)m * ldc + n] = f2bf(acc);
    else ((float*)Cv)[(size_t)m * ldc + n] = acc;
  }
}
#endif

#define PJ(row, col) bf2f(p.PROJ[(size_t)(row) * LDP + (col)])
template <int ORD>
__device__ __forceinline__ void hyena_conv_item(const P& p, int l, int it) {
  const bool need_ctx = (l != DEPTH - 1);
  const int ntb = (need_ctx ? CTX / 16 : 0) + SEQ / 16;
  int c = it % GW, r = it / GW;
  int tb = r % ntb, bl = r / ntb;
  int seg0, L, t0;
  const float* kf;
  if (need_ctx && tb < CTX / 16) { seg0 = 0; L = CTX; t0 = tb * 16; kf = p.kf_ctx + (size_t)(l * 2 + ORD) * 2 * CTX * GW; }
  else { int tb2 = tb - (need_ctx ? CTX / 16 : 0); seg0 = CTX; L = SEQ; t0 = tb2 * 16; kf = p.kf_lat + (size_t)(l * 2 + ORD) * 2 * SEQ * GW; }
  const int rowbase = bl * RPB + seg0;
  const float* cw = p.hy_cw + (size_t)l * 3 * 3 * GW;
  const float* cb = p.hy_cb + (size_t)l * 3 * GW;
  float acc[16], F[31], u[16];
#pragma unroll
  for (int i = 0; i < 16; ++i) acc[i] = 0.f;
#pragma unroll
  for (int m = 0; m < 15; ++m) F[m] = kf[(size_t)(L + t0 + 1 + m) * GW + c];
  const float w0 = cw[0 * 3 * GW + c], w1 = cw[1 * 3 * GW + c], w2 = cw[2 * 3 * GW + c], bb = cb[c];
  float nF[16], nin[18];
  auto fetch = [&](int s0) {
#pragma unroll
    for (int m = 0; m < 16; ++m) nF[m] = kf[(size_t)(L + t0 - s0 - 15 + m) * GW + c];
    if (ORD == 0) {
#pragma unroll
      for (int j = 0; j < 18; ++j) {
        int sp = s0 - 1 + j;
        nin[j] = (sp >= 0 && sp < L) ? PJ(rowbase + sp, OFF_HY + c) : 0.f;
      }
    } else {
#pragma unroll
      for (int j = 0; j < 16; ++j) nin[j] = p.Z2[(size_t)(rowbase + s0 + j) * GW + c];
    }
  };
  fetch(0);
  for (int s0 = 0; s0 < L; s0 += 16) {
#pragma unroll
    for (int m = 14; m >= 0; --m) F[m + 16] = F[m];
#pragma unroll
    for (int m = 0; m < 16; ++m) F[m] = nF[m];
    if (ORD == 0) {
#pragma unroll
      for (int j = 0; j < 16; ++j) u[j] = w0 * nin[j] + w1 * nin[j + 1] + w2 * nin[j + 2] + bb;
    } else {
#pragma unroll
      for (int j = 0; j < 16; ++j) u[j] = nin[j];
    }
    if (s0 + 16 < L) fetch(s0 + 16);
#pragma unroll
    for (int j = 0; j < 16; ++j)
#pragma unroll
      for (int i = 0; i < 16; ++i) acc[i] += F[i - j + 15] * u[j];
  }
  const int xc = (ORD == 0 ? GW : 2 * GW) + c;
  const float v0 = cw[0 * 3 * GW + xc], v1 = cw[1 * 3 * GW + xc], v2 = cw[2 * 3 * GW + xc], vb = cb[xc];
#pragma unroll
  for (int i = 0; i < 16; ++i) {
    int t = t0 + i;
    float xm = t > 0 ? PJ(rowbase + t - 1, OFF_HY + xc) : 0.f;
    float x0 = PJ(rowbase + t, OFF_HY + xc);
    float xp = t < L - 1 ? PJ(rowbase + t + 1, OFF_HY + xc) : 0.f;
    float g = v0 * xm + v1 * x0 + v2 * xp + vb;
    float o = g * acc[i];
    if (ORD == 0) p.Z2[(size_t)(rowbase + t) * GW + c] = o;
    else p.HY[(size_t)(rowbase + t) * GW + c] = o;
  }
}
__device__ __forceinline__ int hyena_items(int l) { return SB * ((l != DEPTH - 1 ? CTX / 16 : 0) + SEQ / 16) * GW; }

#if SB == 8
#define HC_KOFF (SEQ + 32)
#define HC_KLEN (2 * SEQ + 64)
#define HC_ULS ((SEQ / 16 + 4) * 16)
template <int ORD>
__device__ __forceinline__ void hyena_mfma_item(const P& p, int l, int item, bf16_t* lds, int tid) {
  const int c = item % GW, seg = item / GW;
  const int L = seg ? CTX : SEQ, seg0 = seg ? 0 : CTX, NTB = L / 16;
  const bf16_t* kt = (seg ? p.kt_ctx + ((size_t)(l * 2 + ORD) * GW + c) * 2 * CTX : p.kt_lat + ((size_t)(l * 2 + ORD) * GW + c) * 2 * SEQ);
  bf16_t* KL = lds;
  bf16_t* UL = lds + HC_KLEN;
  const float* cw = p.hy_cw + (size_t)l * 3 * 3 * GW;
  const float* cb = p.hy_cb + (size_t)l * 3 * GW;
  __syncthreads();
  for (int n = -(L + 32) + tid; n < L + 32; n += 256) KL[HC_KOFF + n] = (n > -L && n < L) ? kt[L - n] : (bf16_t)0;
  for (int q = tid; q < SB * 4; q += 256) {
    int b = q >> 2, w = q & 3;
    bf16_t* dst = UL + b * HC_ULS + (w < 2 ? w * 16 : (NTB + w) * 16);
    for (int j = 0; j < 16; ++j) dst[j] = 0;
  }
  {
    const float w0 = cw[0 * 3 * GW + c], w1 = cw[1 * 3 * GW + c], w2 = cw[2 * 3 * GW + c], bb = cb[c];
    for (int q = tid; q < SB * (L / 8); q += 256) {
      const int b = q / (L / 8), s8 = (q % (L / 8)) * 8;
      const int row = b * RPB + seg0 + s8;
      float u[8];
      if (ORD == 0) {
        float raw[10];
#pragma unroll
        for (int j = 0; j < 10; ++j) { int sp = s8 - 1 + j; raw[j] = (sp >= 0 && sp < L) ? PJ(row - 1 + j, OFF_HY + c) : 0.f; }
#pragma unroll
        for (int j = 0; j < 8; ++j) u[j] = w0 * raw[j] + w1 * raw[j + 1] + w2 * raw[j + 2] + bb;
      } else {
#pragma unroll
        for (int j = 0; j < 8; ++j) u[j] = p.Z2[(size_t)(row + j) * GW + c];
      }
      unsigned* dst = (unsigned*)(UL + b * HC_ULS + 32 + s8);
#pragma unroll
      for (int j = 0; j < 4; ++j) dst[j] = pack_bf16(u[2 * j], u[2 * j + 1]);
    }
  }
  __syncthreads();
  const int lane = tid & 63, wave = tid >> 6;
  const int ti = lane & 15, q4 = lane >> 4;
  const int NT = NTB / 2, TPW = NT / 4;
  const int T0 = wave * TPW * 2;
  f32x4 acc[16];
#pragma unroll
  for (int m = 0; m < 16; ++m) acc[m] = (f32x4){0.f, 0.f, 0.f, 0.f};
  const int nK = NTB / 2 + TPW;
  const int colb = (lane & 7) * HC_ULS + (q4 & 1) * 8;
  const int tbsel = (lane >> 3) & 1;
  for (int k = 0; k < nK; ++k) {
    const int dl = T0 - NTB + 2 * k + (q4 >> 1);
    const int nb = HC_KOFF - 16 * dl - ti + 8 * (q4 & 1);
    bf16x8 A;
#pragma unroll
    for (int j = 0; j < 8; ++j) A[j] = (short)KL[nb + j];
#pragma unroll
    for (int m = 0; m < 16; ++m) {
      if (m < TPW && k >= m && k <= m + NTB / 2) {
        const int sb = T0 + 2 * m + tbsel - dl;
        const bf16x8 B = *(const bf16x8*)(UL + colb + (sb + 2) * 16);
        acc[m] = mfma16(A, B, acc[m]);
      }
    }
  }
  const int xc = (ORD == 0 ? GW : 2 * GW) + c;
  const float v0 = cw[0 * 3 * GW + xc], v1 = cw[1 * 3 * GW + xc], v2 = cw[2 * 3 * GW + xc], vb = cb[xc];
  const int bn = lane & 7;
#pragma unroll
  for (int m = 0; m < 16; ++m) {
    if (m < TPW) {
      const int t0 = 16 * (T0 + 2 * m + tbsel) + q4 * 4;
      const int row = bn * RPB + seg0 + t0;
      float raw[6];
#pragma unroll
      for (int j = 0; j < 6; ++j) { int tp = t0 - 1 + j; raw[j] = (tp >= 0 && tp < L) ? PJ(row - 1 + j, OFF_HY + xc) : 0.f; }
#pragma unroll
      for (int r = 0; r < 4; ++r) {
        float g = v0 * raw[r] + v1 * raw[r + 1] + v2 * raw[r + 2] + vb;
        float o = g * acc[m][r];
        if (ORD == 0) p.Z2[(size_t)(row + r) * GW + c] = o;
        else p.HY[(size_t)(row + r) * GW + c] = o;
      }
    }
  }
}
__device__ __forceinline__ int hyena_mfma_items(int l) { return (l != DEPTH - 1 ? 2 : 1) * GW; }
#endif


__device__ __forceinline__ float rw_shift(const P& p, int l, int row, int pp, int j) {
  float x = PJ(row, OFF_RW + j);
  float xp = has_prev(pp) ? PJ(row - 1, OFF_RW + j) : 0.f;
  float xn = has_next(pp) ? PJ(row + 1, OFF_RW + j) : 0.f;
  return x + p.rw_mu[(size_t)(l * 2 + 0) * RWSH + j] * (xp - x) + p.rw_mu[(size_t)(l * 2 + 1) * RWSH + j] * (xn - x);
}
__device__ __forceinline__ void ph_prep(const P& p, int l, int s, int gtid, int gsize, float* lds, int tid) {
#pragma unroll 1
  for (int it = gtid; it < RS * (2 * GW / 4); it += gsize) {
    const int j = (it % (2 * GW / 4)) * 4, row = it / (2 * GW / 4), pp = row % RPB;
    const float* cw = p.ml_cw + (size_t)l * 3 * 2 * GW + j;
    const bf16_t* pr = p.PROJ + (size_t)row * LDP + OFF_ML + j;
    const f4 x0 = ldbf4(pr), xm = ldbf4(row > 0 ? pr - LDP : pr), xp = ldbf4(row < RS - 1 ? pr + LDP : pr);
    const float hp = has_prev(pp) ? 1.0f : 0.0f, hn = has_next(pp) ? 1.0f : 0.0f;
    f4 c0 = ld4(cw), c1 = ld4(cw + 2 * GW), c2 = ld4(cw + 4 * GW), cb = ld4(p.ml_cb + l * 2 * GW + j);
    c0.x *= hp; c0.y *= hp; c0.z *= hp; c0.w *= hp;
    c2.x *= hn; c2.y *= hn; c2.z *= hn; c2.w *= hn;
    const float sc = (j < GW) ? 0.125f : 1.0f;
    f4 o;
    o.x = siluf_(c0.x * xm.x + c1.x * x0.x + c2.x * xp.x + cb.x) * sc;
    o.y = siluf_(c0.y * xm.y + c1.y * x0.y + c2.y * xp.y + cb.y) * sc;
    o.z = siluf_(c0.z * xm.z + c1.z * x0.z + c2.z * xp.z + cb.z) * sc;
    o.w = siluf_(c0.w * xm.w + c1.w * x0.w + c2.w * xp.w + cb.w) * sc;
    st4(p.MQK + (size_t)row * 2 * GW + j, o);
  }
  for (int it = gtid; it < RS * 4 * NH; it += gsize) {
    int gj = it % (4 * NH), row = it / (4 * NH);
    float g = PJ(row, OFF_ML + 4 * GW + gj) + p.ml_gb[l * 4 * NH + gj];
    if ((gj / NH) & 1) g = logsigmoidf_(g);
    p.MG[(size_t)row * 4 * NH + gj] = g;
  }
#pragma unroll 1
  for (int it = gtid; it < RS * (2 * GW / 4); it += gsize) {
    const int j = (it % (2 * GW / 4)) * 4, row = it / (2 * GW / 4), pp = row % RPB;
    const int which = j / GW, c = j % GW, dd = c % HD, hb = c - dd;
    const bf16_t* pr = p.PROJ + (size_t)row * LDP + OFF_RT + which * GW;
    const f4 x = ldbf4(pr + c);
    f4 o;
    {
      const int t = pp >= CTX ? pp - CTX : 0, ri = t / GRIDW, ci = t % GRIDW;
      const int half = dd / 32, e = dd % 32, pi = e % 16;
      const bool first = e < 16;
      const int pos = pp >= CTX ? (half ? ci : ri) : 0;
      const f4 xo = ldbf4(pr + hb + (first ? dd + 16 : dd - 16));
      const f4 cs = ld4(p.ropec + pos * 16 + pi), sn = ld4(p.ropes + pos * 16 + pi);
      const float sg = first ? -1.0f : 1.0f;
      o.x = x.x * cs.x + sg * xo.x * sn.x;
      o.y = x.y * cs.y + sg * xo.y * sn.y;
      o.z = x.z * cs.z + sg * xo.z * sn.z;
      o.w = x.w * cs.w + sg * xo.w * sn.w;
    }
    if (which == 0) { o.x *= 0.125f; o.y *= 0.125f; o.z *= 0.125f; o.w *= 0.125f; }
    st4(p.RQK + (size_t)row * 2 * GW + j, o);
  }
  {
    float* zs = lds;
    float* part = lds + 8 * RWSH;
    const size_t AS = (size_t)RS * GW;
    for (int tile = blockIdx.x; tile < RS / 8; tile += gridDim.x) {
      const int row0 = tile * 8;
      __syncthreads();
      if (tid < RWSH / 4) {
        const int j4 = tid * 4;
        const f4 m0 = ld4(p.rw_mu + (size_t)(l * 2 + 0) * RWSH + j4), m1 = ld4(p.rw_mu + (size_t)(l * 2 + 1) * RWSH + j4);
        const int kind = (j4 >= 3 * GW && j4 < 3 * GW + 32) ? 1 : (j4 >= 3 * GW + 64 ? 2 : 0);
        const bf16_t* pr = p.PROJ + (size_t)row0 * LDP + OFF_RW + j4;
        f4 x[10];
#pragma unroll
        for (int r = 0; r < 10; ++r) {
          const int row = row0 - 1 + r;
          if (row >= 0 && row < RS) x[r] = ldbf4(pr + (ptrdiff_t)(r - 1) * LDP);
          else { x[r].x = 0.f; x[r].y = 0.f; x[r].z = 0.f; x[r].w = 0.f; }
        }
#pragma unroll
        for (int r = 0; r < 8; ++r) {
          const int pp = (row0 + r) % RPB;
          const float hp = has_prev(pp) ? 1.0f : 0.0f, hn = has_next(pp) ? 1.0f : 0.0f;
          const f4 c = x[r + 1];
          f4 z;
          z.x = c.x + m0.x * (hp * x[r].x - c.x) + m1.x * (hn * x[r + 2].x - c.x);
          z.y = c.y + m0.y * (hp * x[r].y - c.y) + m1.y * (hn * x[r + 2].y - c.y);
          z.z = c.z + m0.z * (hp * x[r].z - c.z) + m1.z * (hn * x[r + 2].z - c.z);
          z.w = c.w + m0.w * (hp * x[r].w - c.w) + m1.w * (hn * x[r + 2].w - c.w);
          if (kind == 1) { z.x = tanhf_(z.x); z.y = tanhf_(z.y); z.z = tanhf_(z.z); z.w = tanhf_(z.w); }
          else if (kind == 2) { z.x = sigmoidf_(z.x); z.y = sigmoidf_(z.y); z.z = sigmoidf_(z.z); z.w = sigmoidf_(z.w); }
          st4(zs + r * RWSH + j4, z);
        }
      }
      __syncthreads();
      {
        int pr = tid >> 3, sub = tid & 7;
        if (pr < 8 * NH) {
          int r = pr / NH, h = pr % NH;
          float ss = 0.f, bs = 0.f;
          for (int i = sub * 8; i < sub * 8 + 8; ++i) {
            float kv = zs[r * RWSH + GW + h * HD + i], rv = zs[r * RWSH + h * HD + i];
            float kk = kv * p.rw_kk[l * GW + h * HD + i];
            ss += kk * kk;
            bs += rv * kv * p.rw_rk[(l * NH + h) * HD + i];
          }
          part[pr * 8 + sub] = ss;
          part[256 + pr * 8 + sub] = bs;
        }
      }
      __syncthreads();
      for (int c = tid; c < GW; c += 256) {
        const int h = c / HD;
        float wa0[8], wa1[8], aa0[8], aa1[8], gg[8];
#pragma unroll
        for (int r = 0; r < 8; ++r) { wa0[r] = 0.f; wa1[r] = 0.f; aa0[r] = 0.f; aa1[r] = 0.f; gg[r] = 0.f; }
#pragma unroll 8
        for (int i = 0; i < 32; ++i) {
          float w20 = p.rw_w2[((size_t)(l * 2 + 0) * 32 + i) * GW + c], w21 = p.rw_w2[((size_t)(l * 2 + 1) * 32 + i) * GW + c];
          float a20 = p.rw_a2[((size_t)(l * 2 + 0) * 32 + i) * GW + c], a21 = p.rw_a2[((size_t)(l * 2 + 1) * 32 + i) * GW + c];
#pragma unroll
          for (int r = 0; r < 8; ++r) {
            float tw = zs[r * RWSH + 3 * GW + i], al = zs[r * RWSH + 3 * GW + 32 + i];
            wa0[r] = fmaf(tw, w20, wa0[r]); wa1[r] = fmaf(tw, w21, wa1[r]);
            aa0[r] = fmaf(al, a20, aa0[r]); aa1[r] = fmaf(al, a21, aa1[r]);
          }
        }
#pragma unroll 16
        for (int j = 0; j < 64; ++j) {
          float g2 = p.rw_g2[((size_t)l * 64 + j) * GW + c];
#pragma unroll
          for (int r = 0; r < 8; ++r) gg[r] = fmaf(zs[r * RWSH + 3 * GW + 64 + j], g2, gg[r]);
        }
        const float ka = p.rw_ka[l * GW + c], kks = p.rw_kk[l * GW + c];
        const float w00 = p.rw_w0[(l * 2 + 0) * GW + c], w01 = p.rw_w0[(l * 2 + 1) * GW + c];
        const float a00 = p.rw_a0[(l * 2 + 0) * GW + c], a01 = p.rw_a0[(l * 2 + 1) * GW + c];
#pragma unroll
        for (int r = 0; r < 8; ++r) {
          const int pr = r * NH + h;
          float ss = 0.f, bs = 0.f;
#pragma unroll
          for (int u = 0; u < 8; ++u) { ss += part[pr * 8 + u]; bs += part[256 + pr * 8 + u]; }
          const float rr = zs[r * RWSH + c], k = zs[r * RWSH + GW + c], v = zs[r * RWSH + 2 * GW + c];
          const float kkv = k * kks / sqrtf(ss + 1e-12f);
          const size_t o = (size_t)(row0 + r) * GW + c;
          p.RW[0 * AS + o] = rr;
          p.RW[1 * AS + o] = kkv;
          p.BON[o] = bs * v;
          p.GG[o] = gg[r];
#pragma unroll
          for (int d = 0; d < 2; ++d) {
            float wpre = (d ? w01 : w00) + (d ? wa1[r] : wa0[r]);
            float decay = expf(-expf(-softplusf_(-wpre) - 0.5f));
            float a = sigmoidf_((d ? a01 : a00) + (d ? aa1[r] : aa0[r]));
            p.RW[(2 + d) * AS + o] = decay;
            p.RW[(4 + d) * AS + o] = k * (1.0f + (a - 1.0f) * ka);
            p.RW[(6 + d) * AS + o] = kkv * a;
          }
        }
      }
    }
    __syncthreads();
  }
#if SB == 8
#else
  for (int it = gtid; it < hyena_items(l); it += gsize) hyena_conv_item<0>(p, l, it);
#endif
}

__device__ __forceinline__ int scan_pos(int dir, int step) {
  if (!dir) return step;
  return step < CTX ? CTX - 1 - step : RPB - 1 - (step - CTX);
}
#ifndef CPU_EMU
__device__ __forceinline__ float quad_sum(float v) {
  v += __int_as_float(__builtin_amdgcn_mov_dpp(__float_as_int(v), 0xB1, 0xF, 0xF, true));
  v += __int_as_float(__builtin_amdgcn_mov_dpp(__float_as_int(v), 0x4E, 0xF, 0xF, true));
  return v;
}
__device__ __forceinline__ float oct_sum(float v) {
  v = quad_sum(v);
  v += __int_as_float(__builtin_amdgcn_mov_dpp(__float_as_int(v), 0x141, 0xF, 0xF, true));
  return v;
}
#endif
#define SCT 16
#define NCHUNK (RPB / SCT)
__device__ __forceinline__ void bscan_rwkv(const P& p, int l, int bl, int h, int dir, int half, float* lds, int tid) {
  const int i = half * 32 + (tid >> 3), kq = tid & 7, st = tid >> 4, sp = tid & 15;
  float S[8];
#pragma unroll
  for (int d = 0; d < 8; ++d) S[d] = 0.f;
  float* H = dir ? p.HB : p.HF;
  const size_t AS = (size_t)RS * GW;
  const int vc = 2 * GW + h * HD + sp * 4;
  const f4 mu0 = ld4(p.rw_mu + (size_t)(l * 2 + 0) * RWSH + vc), mu1 = ld4(p.rw_mu + (size_t)(l * 2 + 1) * RWSH + vc);
  f4 rg[5], rv;
  auto load = [&](int c) {
    const int pp = scan_pos(dir, c * SCT + st), row = bl * RPB + pp;
    const size_t o = (size_t)row * GW + h * HD + sp * 4;
    rg[0] = ld4(p.RW + 0 * AS + o);
    rg[1] = ld4(p.RW + 1 * AS + o);
    rg[2] = ld4(p.RW + (size_t)(2 + dir) * AS + o);
    rg[3] = ld4(p.RW + (size_t)(4 + dir) * AS + o);
    rg[4] = ld4(p.RW + (size_t)(6 + dir) * AS + o);
    const bf16_t* pr = p.PROJ + (size_t)row * LDP + OFF_RW + vc;
    f4 x = ldbf4(pr), xm = x, xp = x;
    xm.x = xm.y = xm.z = xm.w = 0.f; xp = xm;
    if (has_prev(pp)) xm = ldbf4(pr - LDP);
    if (has_next(pp)) xp = ldbf4(pr + LDP);
    rv.x = x.x + mu0.x * (xm.x - x.x) + mu1.x * (xp.x - x.x);
    rv.y = x.y + mu0.y * (xm.y - x.y) + mu1.y * (xp.y - x.y);
    rv.z = x.z + mu0.z * (xm.z - x.z) + mu1.z * (xp.z - x.z);
    rv.w = x.w + mu0.w * (xm.w - x.w) + mu1.w * (xp.w - x.w);
  };
  load(0);
  for (int c = 0; c < NCHUNK; ++c) {
    __syncthreads();
#pragma unroll
    for (int a = 0; a < 5; ++a) st4(lds + (st * 6 + a) * 64 + sp * 4, rg[a]);
    st4(lds + (st * 6 + 5) * 64 + sp * 4, rv);
    __syncthreads();
    if (c + 1 < NCHUNK) load(c + 1);
    struct RwOps { float r[8], k[8], w[8], d[8], b[8], vv; };
    auto ldstep = [&](RwOps& o, int t) {
      const float* L = lds + t * 6 * 64 + kq * 8;
      o.vv = lds[(t * 6 + 5) * 64 + i];
      ld8(o.k, L + 1 * 64);
      ld8(o.w, L + 2 * 64);
      ld8(o.d, L + 3 * 64);
      ld8(o.b, L + 4 * 64);
      ld8(o.r, L + 0 * 64);
    };
    auto step = [&](const RwOps& o, int t) {
      float sa4[4] = {0.f, 0.f, 0.f, 0.f};
#pragma unroll
      for (int d = 0; d < 8; ++d) sa4[d & 3] = fmaf(S[d], o.k[d], sa4[d & 3]);
      const float sa = -oct_sum((sa4[0] + sa4[1]) + (sa4[2] + sa4[3]));
      float y4[4] = {0.f, 0.f, 0.f, 0.f};
#pragma unroll
      for (int d = 0; d < 8; ++d) {
        S[d] = fmaf(S[d], o.w[d], fmaf(sa, o.b[d], o.vv * o.d[d]));
        y4[d & 3] = fmaf(S[d], o.r[d], y4[d & 3]);
      }
      const float y = oct_sum((y4[0] + y4[1]) + (y4[2] + y4[3]));
      if (kq == 0) {
        const int row = bl * RPB + scan_pos(dir, c * SCT + t);
        H[(size_t)row * 3 * GW + 2 * GW + h * HD + i] = y;
      }
    };
    RwOps oa, ob;
    ldstep(oa, 0);
#pragma nounroll
    for (int t = 0; t < SCT; t += 2) {
      ldstep(ob, t + 1);
      step(oa, t);
      if (t + 2 < SCT) ldstep(oa, t + 2);
      step(ob, t + 1);
    }
  }
}
__device__ __forceinline__ void bscan_mlstm(const P& p, int bl, int h, int dir, int half, float* lds, int tid) {
  const int i = half * 32 + (tid >> 3), kq = tid & 7, st = tid >> 4, sp = tid & 15;
  float C[8], n[8];
#pragma unroll
  for (int d = 0; d < 8; ++d) { C[d] = 0.f; n[d] = 0.f; }
  float m = 0.f;
  float* H = dir ? p.HB : p.HF;
  f4 rq, rk, rv;
  float g0 = 0.f, g1 = 0.f;
  auto load = [&](int c) {
    const int pp = scan_pos(dir, c * SCT + st), row = bl * RPB + pp;
    const float* q = p.MQK + (size_t)row * 2 * GW + h * HD + sp * 4;
    rq = ld4(q);
    rk = ld4(q + GW);
    rv = ldbf4(p.PROJ + (size_t)row * LDP + OFF_ML + 2 * GW + h * HD + sp * 4);
    if (sp == 0) {
      const float* mg = p.MG + (size_t)row * 4 * NH;
      g0 = mg[(dir ? 2 : 0) * NH + h];
      g1 = mg[(dir ? 3 : 1) * NH + h];
    }
  };
  load(0);
  for (int c = 0; c < NCHUNK; ++c) {
    __syncthreads();
    st4(lds + (st * 4 + 0) * 64 + sp * 4, rq);
    st4(lds + (st * 4 + 1) * 64 + sp * 4, rk);
    st4(lds + (st * 4 + 2) * 64 + sp * 4, rv);
    if (sp == 0) { lds[(st * 4 + 3) * 64 + 0] = g0; lds[(st * 4 + 3) * 64 + 1] = g1; }
    __syncthreads();
    if (c + 1 < NCHUNK) load(c + 1);
    struct MlOps { float q[8], k[8], ig, lf, v; };
    auto ldstep = [&](MlOps& o, int t) {
      const float* L = lds + t * 4 * 64;
      o.ig = L[3 * 64 + 0]; o.lf = L[3 * 64 + 1]; o.v = L[2 * 64 + i];
      ld8(o.q, L + kq * 8);
      ld8(o.k, L + 64 + kq * 8);
    };
    auto step = [&](const MlOps& o, int t) {
      const float mn = fmaxf(o.lf + m, o.ig);
      const float f = fexp_(o.lf + m - mn), ii = fexp_(o.ig - mn), em = fexp_(-mn);
      m = mn;
      const float iv = ii * o.v;
      float num4[4] = {0.f, 0.f, 0.f, 0.f}, den4[4] = {0.f, 0.f, 0.f, 0.f};
#pragma unroll
      for (int d = 0; d < 8; ++d) {
        const float kd = o.k[d], qd = o.q[d];
        C[d] = fmaf(kd, iv, f * C[d]);
        n[d] = fmaf(kd, ii, f * n[d]);
        num4[d & 3] = fmaf(qd, C[d], num4[d & 3]);
        den4[d & 3] = fmaf(qd, n[d], den4[d & 3]);
      }
      const float num = oct_sum((num4[0] + num4[1]) + (num4[2] + num4[3]));
      const float den = oct_sum((den4[0] + den4[1]) + (den4[2] + den4[3]));
      if (kq == 0) {
        const int row = bl * RPB + scan_pos(dir, c * SCT + t);
        H[(size_t)row * 3 * GW + 0 * GW + h * HD + i] = num * frcp_(fmaxf(fabsf(den), em));
      }
    };
    MlOps oa, ob;
    ldstep(oa, 0);
#pragma nounroll
    for (int t = 0; t < SCT; t += 2) {
      ldstep(ob, t + 1);
      step(oa, t);
      if (t + 2 < SCT) ldstep(oa, t + 2);
      step(ob, t + 1);
    }
  }
}
__device__ __forceinline__ void bscan_ret(const P& p, int bl, int h, int dir, int half, float* lds, int tid) {
  const int i = half * 32 + (tid >> 3), kq = tid & 7, st = tid >> 4, sp = tid & 15;
  float S[8];
#pragma unroll
  for (int d = 0; d < 8; ++d) S[d] = 0.f;
  const int hh = dir ? NH - 1 - h : h;
  const float gamma = 1.0f - exp2f(-5.0f - (float)hh);
  float* H = dir ? p.HB : p.HF;
  f4 rq, rk, rv;
  auto load = [&](int c) {
    const int pp = scan_pos(dir, c * SCT + st), row = bl * RPB + pp;
    const float* q = p.RQK + (size_t)row * 2 * GW + h * HD + sp * 4;
    rq = ld4(q);
    rk = ld4(q + GW);
    rv = ldbf4(p.PROJ + (size_t)row * LDP + OFF_RT + 2 * GW + h * HD + sp * 4);
  };
  load(0);
  for (int c = 0; c < NCHUNK; ++c) {
    __syncthreads();
    st4(lds + (st * 4 + 0) * 64 + sp * 4, rq);
    st4(lds + (st * 4 + 1) * 64 + sp * 4, rk);
    st4(lds + (st * 4 + 2) * 64 + sp * 4, rv);
    __syncthreads();
    if (c + 1 < NCHUNK) load(c + 1);
    struct RtOps { float q[8], k[8], v; };
    auto ldstep = [&](RtOps& o, int t) {
      const float* L = lds + t * 4 * 64;
      o.v = L[2 * 64 + i];
      ld8(o.q, L + kq * 8);
      ld8(o.k, L + 64 + kq * 8);
    };
    auto step = [&](const RtOps& o, int t) {
      float o4[4] = {0.f, 0.f, 0.f, 0.f};
#pragma unroll
      for (int d = 0; d < 8; ++d) {
        S[d] = fmaf(S[d], gamma, o.k[d] * o.v);
        o4[d & 3] = fmaf(o.q[d], S[d], o4[d & 3]);
      }
      const float ov = oct_sum((o4[0] + o4[1]) + (o4[2] + o4[3]));
      if (kq == 0) {
        const int row = bl * RPB + scan_pos(dir, c * SCT + t);
        H[(size_t)row * 3 * GW + 1 * GW + h * HD + i] = ov;
      }
    };
    RtOps oa, ob;
    ldstep(oa, 0);
#pragma nounroll
    for (int t = 0; t < SCT; t += 2) {
      ldstep(ob, t + 1);
      step(oa, t);
      if (t + 2 < SCT) ldstep(oa, t + 2);
      step(ob, t + 1);
    }
  }
}
#define NSCAN (3 * SB * NH * 2 * 2)
__device__ __forceinline__ void ph_scan(const P& p, int l, int s, int gtid, int gsize, float* lds, int tid) {
  for (int w = blockIdx.x; w < NSCAN; w += gridDim.x) {
    int mixer = w / (SB * NH * 4), r = w % (SB * NH * 4);
    int half = r & 1, dir = (r >> 1) & 1, h = (r >> 2) % NH, bl = (r >> 2) / NH;
    if (mixer == 0) bscan_rwkv(p, l, bl, h, dir, half, lds, tid);
    else if (mixer == 1) bscan_mlstm(p, bl, h, dir, half, lds, tid);
    else bscan_ret(p, bl, h, dir, half, lds, tid);
    __syncthreads();
  }
#if SB == 8
  {
    int* sh = (int*)lds;
    const int nitem = hyena_mfma_items(l);
    for (;;) {
      __syncthreads();
      if (tid == 0) sh[0] = atomicAdd(p.ctr, 1);
      __syncthreads();
      const int it = sh[0];
      if (it >= nitem) break;
      hyena_mfma_item<0>(p, l, it, (bf16_t*)lds, tid);
      __threadfence();
      hyena_mfma_item<1>(p, l, it, (bf16_t*)lds, tid);
    }
  }
#else
  for (int it = gtid; it < hyena_items(l); it += gsize) hyena_conv_item<1>(p, l, it);
#endif
}

#define NE (HD / WL)
__device__ __forceinline__ void ph_fin(const P& p, int l, int s, int gtid, int gsize) {
  const bool last = (l == DEPTH - 1);
  const int lane = gtid % WL, gw = gtid / WL, nw = gsize / WL;
  for (int item = gw; item < (RS / 4) * 4 * NH; item += nw) {
    const int hg = item % (4 * NH), row0 = (item / (4 * NH)) * 4, pp0 = row0 % RPB;
    if (last && pp0 < CTX) continue;
    const int g = hg / NH, h = hg % NH;
    const int c0 = g * GW + h * HD;
    float val[4][NE];
#pragma unroll
    for (int r = 0; r < 4; ++r) {
      const int row = row0 + r;
#pragma unroll
      for (int e = 0; e < NE; ++e) {
        const int i = e * WL + lane;
        float v;
        if (g == 1) v = p.HY[(size_t)row * GW + h * HD + i];
        else {
          const int slot = (g == 0) ? 0 : (g == 2 ? 1 : 2);
          const size_t o = (size_t)row * 3 * GW + slot * GW + h * HD + i;
          v = p.HF[o] + p.HB[o];
        }
        val[r][e] = v;
      }
    }
    float mu[4], rs[4];
#pragma unroll
    for (int r = 0; r < 4; ++r) {
      float sm = 0.f;
#pragma unroll
      for (int e = 0; e < NE; ++e) sm += val[r][e];
      mu[r] = wave_sum(sm) * (1.0f / HD);
    }
#pragma unroll
    for (int r = 0; r < 4; ++r) {
      float q = 0.f;
#pragma unroll
      for (int e = 0; e < NE; ++e) { float d = val[r][e] - mu[r]; q += d * d; }
      rs[r] = 1.0f / sqrtf(wave_sum(q) * (1.0f / HD) + 1e-5f);
    }
#pragma unroll
    for (int r = 0; r < 4; ++r) {
      const int row = row0 + r;
#pragma unroll
      for (int e = 0; e < NE; ++e) {
        const int i = e * WL + lane;
        float v = (val[r][e] - mu[r]) * rs[r] * p.ng[l * DM + c0 + i] + p.nb[l * DM + c0 + i];
        if (g == 0) v *= sigmoidf_(PJ(row, OFF_ML + 3 * GW + h * HD + i));
        else if (g == 2) v *= siluf_(PJ(row, OFF_RT + 3 * GW + h * HD + i));
        else if (g == 3) v = p.GG[(size_t)row * GW + h * HD + i] * (v + p.BON[(size_t)row * GW + h * HD + i]);
        p.U[(size_t)row * DM + c0 + i] = f2bf(v);
      }
    }
  }
}

__device__ __forceinline__ void ph_act(const P& p, int l, int s, int gtid, int gsize) {
  const bool last = (l == DEPTH - 1);
  const float* cw = p.f_cw + (size_t)l * 3 * DFF;
  const float* cb = p.f_cb + (size_t)l * DFF;
  for (int it = gtid; it < RS * (DFF / 8); it += gsize) {
    const int j = (it % (DFF / 8)) * 8, row = it / (DFF / 8), pp = row % RPB;
    if (last && pp < CTX) continue;
    const bf16_t* hr = p.HFF + (size_t)row * 2 * DFF;
    unsigned am[4], a0[4], ap[4], bv[4], ov[4];
    const bf16_t* hm = row > 0 ? hr - 2 * DFF : hr;
    const bf16_t* hp = row < RS - 1 ? hr + 2 * DFF : hr;
    const unsigned mprev = has_prev(pp) ? 0xffffffffu : 0u, mnext = has_next(pp) ? 0xffffffffu : 0u;
#pragma unroll
    for (int e = 0; e < 4; ++e) {
      a0[e] = ((const unsigned*)(hr + j))[e]; bv[e] = ((const unsigned*)(hr + DFF + j))[e];
      am[e] = ((const unsigned*)(hm + j))[e] & mprev; ap[e] = ((const unsigned*)(hp + j))[e] & mnext;
    }
#pragma unroll
    for (int e = 0; e < 4; ++e) {
      float o[2];
#pragma unroll
      for (int hh = 0; hh < 2; ++hh) {
        const int jj = j + 2 * e + hh;
        float xm = bf2f((bf16_t)(am[e] >> (16 * hh))), x0 = bf2f((bf16_t)(a0[e] >> (16 * hh))), xp = bf2f((bf16_t)(ap[e] >> (16 * hh)));
        float v = cw[jj] * xm + cw[DFF + jj] * x0 + cw[2 * DFF + jj] * xp + cb[jj];
        o[hh] = siluf_(v) * bf2f((bf16_t)(bv[e] >> (16 * hh)));
      }
      ov[e] = pack_bf16(o[0], o[1]);
    }
#pragma unroll
    for (int e = 0; e < 4; ++e) ((unsigned*)(p.ACT + (size_t)row * DFF + j))[e] = ov[e];
  }
}

enum { PH_PRO_A = 0, PH_PRO_B, PH_PRO_C, PH_LN0, PH_GEMM_IN, PH_PREP, PH_SCAN, PH_FIN, PH_GEMM_OUT, PH_LN1, PH_GEMM_UP, PH_ACT, PH_GEMM_DN, PH_LN2, PH_COUNT };

__device__ __forceinline__ void run_phase(const P& p, int ph, int l, int s, bf16_t* lds) {
  int tid = threadIdx.x;
#ifndef CPU_EMU
  asm volatile("" : "+v"(tid));
#endif
  const int gtid = blockIdx.x * blockDim.x + tid;
  const int gsize = gridDim.x * blockDim.x;
  const bool last = (l == DEPTH - 1);
  switch (ph) {
    case PH_PRO_A: ph_pro_a(p, gtid, gsize); break;
    case PH_PRO_B: ph_pro_b(p, gtid, gsize); break;
    case PH_PRO_C: ph_pro_c(p, gtid, gsize); break;
    case PH_LN0: ph_ln0(p, l, s, gtid, gsize); break;
    case PH_GEMM_IN: gemm_phase<true>(p.U, p.wt_in + (size_t)l * LDP * DM, p.PROJ, RS, LDP, DM, LDP, false, lds, tid); break;
    case PH_PREP: ph_prep(p, l, s, gtid, gsize, (float*)lds, tid); break;
    case PH_SCAN: ph_scan(p, l, s, gtid, gsize, (float*)lds, tid); break;
    case PH_FIN: ph_fin(p, l, s, gtid, gsize); break;
    case PH_GEMM_OUT: gemm_phase<false>(p.U, p.wt_out + (size_t)l * DM * DM, p.OUTF, RS, DM, DM, DM, last, lds, tid); break;
    case PH_LN1: ph_ln1(p, l, s, gtid, gsize); break;
    case PH_GEMM_UP: gemm_phase<true>(p.U, p.wt_up + (size_t)l * 2 * DFF * DM, p.HFF, RS, 2 * DFF, DM, 2 * DFF, last, lds, tid); break;
    case PH_ACT: ph_act(p, l, s, gtid, gsize); break;
    case PH_GEMM_DN: gemm_phase<false>(p.ACT, p.wt_dn + (size_t)l * DM * DFF, p.OUTF, RS, DM, DFF, DM, last, lds, tid); break;
    case PH_LN2: ph_ln2(p, l, s, gtid, gsize); break;
  }
}

#ifndef CPU_EMU
#define XB_TMO      128
#define XB_XCNT(j)  (256  + 64 * (j))
#define XB_XSUB(j)  (1280 + 64 * (j))
#define XB_XGEN(j)  (2304 + 64 * (j))
#define XB_TOP      3328
#define XB_TOPGEN   3392
#define XCD_BAR_WORDS 3456
#define XB_SPIN_CAP (1u << 22)
#define LAS __attribute__((address_space(3)))

__device__ __forceinline__ unsigned xb_ld(unsigned* p)              { return __hip_atomic_load(p, __ATOMIC_RELAXED, __HIP_MEMORY_SCOPE_AGENT); }
__device__ __forceinline__ unsigned xb_add(unsigned* p, unsigned v) { return __hip_atomic_fetch_add(p, v, __ATOMIC_RELAXED, __HIP_MEMORY_SCOPE_AGENT); }
__device__ __forceinline__ unsigned xb_xcc_id() { return (unsigned)__builtin_amdgcn_s_getreg((3 << 11) | 20) & 0xFu; }
#define XB_SPIN(cond, bar) do { unsigned _sp = 0; while (cond) { __builtin_amdgcn_s_sleep(1); \
    if ((++_sp & 255u) == 0u) { if (xb_ld(&(bar)[XB_TMO])) break; if (_sp > XB_SPIN_CAP) { atomicAdd(&(bar)[XB_TMO], 1u); break; } } } } while (0)

struct XcdBarrier {
    unsigned* bar; unsigned x;
    volatile LAS unsigned* st;
};

__device__ __forceinline__ XcdBarrier xcd_barrier_post(unsigned* bar, volatile LAS unsigned* st) {
    XcdBarrier b; b.bar = bar; b.x = xb_xcc_id(); b.st = st;
    if (threadIdx.x == 0) (void)xb_add(&bar[XB_XCNT(b.x)], 1u);
    return b;
}
__device__ __forceinline__ void xcd_barrier_complete(unsigned* bar, unsigned x, unsigned& nloc, unsigned& nx) {
    const unsigned G = gridDim.x * gridDim.y * gridDim.z;
    unsigned sum, cnt, mine, sp = 0u;
    for (;;) {
        sum = 0u; cnt = 0u; mine = 0u;
#pragma unroll
        for (unsigned j = 0; j < 16; ++j) { const unsigned c = xb_ld(&bar[XB_XCNT(j)]); sum += c; cnt += (c > 0u) ? 1u : 0u; mine = (j == x) ? c : mine; }
        if (sum == G) break;
        __builtin_amdgcn_s_sleep(1);
        if ((++sp & 255u) == 0u) { if (xb_ld(&bar[XB_TMO])) break; if (sp > XB_SPIN_CAP) { atomicAdd(&bar[XB_TMO], 1u); break; } }
    }
    nloc = mine > 0u ? mine : 1u; nx = cnt > 0u ? cnt : 1u;
}

__device__ __forceinline__ void xcd_barrier(const XcdBarrier& b) {
    asm volatile("s_waitcnt vmcnt(0)" ::: "memory");
    __syncthreads();
    if (threadIdx.x == 0) {
        unsigned* bar = b.bar;
        __builtin_amdgcn_s_waitcnt(0);
        unsigned nloc = b.st[0], nx = b.st[1];
        if (nloc == 0u) { xcd_barrier_complete(bar, b.x, nloc, nx); b.st[0] = nloc; b.st[1] = nx; }
        const unsigned old = xb_add(&bar[XB_XSUB(b.x)], 1u);
        const unsigned gen = old / nloc;
        if (old + 1u == (gen + 1u) * nloc) {
            __builtin_amdgcn_fence(__ATOMIC_RELEASE, "agent");
            asm volatile("s_waitcnt vmcnt(0)" ::: "memory");
            const unsigned og = xb_add(&bar[XB_TOP], 1u);
            const unsigned tg = og / nx;
            if (og + 1u == (tg + 1u) * nx) xb_add(&bar[XB_TOPGEN], 1u);
            else XB_SPIN(xb_ld(&bar[XB_TOPGEN]) == tg, bar);
            __builtin_amdgcn_fence(__ATOMIC_ACQUIRE, "agent");
            xb_add(&bar[XB_XGEN(b.x)], 1u);
            asm volatile("s_waitcnt vmcnt(0)" ::: "memory");
        } else {
            XB_SPIN(xb_ld(&bar[XB_XGEN(b.x)]) == gen, bar);
            __builtin_amdgcn_fence(__ATOMIC_ACQUIRE, "agent");
            asm volatile("s_waitcnt vmcnt(0)" ::: "memory");
        }
    }
    __syncthreads();
}

#endif

#ifndef PROBE_MASK
#define PROBE_MASK 0
#endif
#if PROBE_MASK
#define RUNPH(ph) do { int reps_ = 1 + ((PROBE_MASK >> ph) & 1); asm volatile("" : "+s"(reps_)); for (int q_ = 0; q_ < reps_; ++q_) { run_phase(p, ph, l, s, lds); GSYNC(); } } while (0)
#else
#define RUNPH(ph) do { run_phase(p, ph, l, s, lds); GSYNC(); } while (0)
#endif
#ifndef CPU_EMU
__global__ void __launch_bounds__(256, 2) k_mega(P p) {
  __shared__ __attribute__((aligned(16))) bf16_t lds[24576];
  __shared__ uint4 xb_words;
  cg::grid_group grid = cg::this_grid();
  if (threadIdx.x == 0) xb_words = make_uint4(0u, 0u, 0u, 0u);
  __syncthreads();
  XcdBarrier xb = xcd_barrier_post(p.bar, (volatile LAS unsigned*)&xb_words);
#define GSYNC() xcd_barrier(xb)
  run_phase(p, PH_PRO_A, 0, 0, lds);
  grid.sync();
  run_phase(p, PH_PRO_B, 0, 0, lds);
  GSYNC();
  run_phase(p, PH_PRO_C, 0, 0, lds);
  GSYNC();
  for (int l = 0; l < DEPTH; ++l)
    for (int s = 0; s < NSLICE; ++s)
    {
      if (l == 0 && s == 0) RUNPH(PH_LN0);
      RUNPH(PH_GEMM_IN);
      RUNPH(PH_PREP);
      RUNPH(PH_SCAN);
      RUNPH(PH_FIN);
      RUNPH(PH_GEMM_OUT);
      RUNPH(PH_LN1);
      RUNPH(PH_GEMM_UP);
      RUNPH(PH_ACT);
      RUNPH(PH_GEMM_DN);
      {
        run_phase(p, PH_LN2, l, s, lds);
        const int ns = (s + 1 == NSLICE) ? 0 : s + 1, nl = (s + 1 == NSLICE) ? l + 1 : l;
        if (nl < DEPTH) { run_phase(p, PH_LN0, nl, ns, lds); GSYNC(); }
      }
    }
}
#endif

static size_t ws_take(size_t& off, size_t bytes) { size_t o = off; off += (bytes + 255) & ~(size_t)255; return o; }

static void build_params(P& p, void* const* d_in, void* d_out, void* d_ws) {
  const float** f = (const float**)&p;
  for (int i = 0; i < 39; ++i) f[i] = (const float*)d_in[i];
  p.out = (float*)d_out;
  char* w = (char*)d_ws;
  size_t off = 0;
  p.wt_in = (bf16_t*)(w + ws_take(off, (size_t)DEPTH * LDP * DM * 2));
  p.wt_out = (bf16_t*)(w + ws_take(off, (size_t)DEPTH * DM * DM * 2));
  p.wt_up = (bf16_t*)(w + ws_take(off, (size_t)DEPTH * 2 * DFF * DM * 2));
  p.wt_dn = (bf16_t*)(w + ws_take(off, (size_t)DEPTH * DM * DFF * 2));
  p.kf_lat = (float*)(w + ws_take(off, (size_t)DEPTH * 2 * 2 * SEQ * GW * 4));
  p.kf_ctx = (float*)(w + ws_take(off, (size_t)DEPTH * 2 * 2 * CTX * GW * 4));
  p.kt_lat = (bf16_t*)(w + ws_take(off, (size_t)DEPTH * 2 * 2 * SEQ * GW * 2));
  p.kt_ctx = (bf16_t*)(w + ws_take(off, (size_t)DEPTH * 2 * 2 * CTX * GW * 2));
  p.ropec = (float*)(w + ws_take(off, 64 * 16 * 4));
  p.ropes = (float*)(w + ws_take(off, 64 * 16 * 4));
  p.hyh1 = (float*)(w + ws_take(off, (size_t)DEPTH * 2 * SEQ * 64 * 4));
  p.hyh2 = (float*)(w + ws_take(off, (size_t)DEPTH * 2 * SEQ * 64 * 4));
  p.scv = (float*)(w + ws_take(off, (size_t)NMOD * DM * 4));
  p.modtab = (float*)(w + ws_take(off, (size_t)DEPTH * NMOD * 6 * DM * 4));
  p.xc = (float*)(w + ws_take(off, (size_t)NB * CTX * DM * 4));
  p.ctr = (int*)(w + ws_take(off, 256));
  p.bar = (unsigned*)(w + ws_take(off, 16384));
  p.U = (bf16_t*)(w + ws_take(off, (size_t)RS * DM * 2));
  size_t arena = off;
  p.PROJ = (bf16_t*)(w + ws_take(off, (size_t)RS * LDP * 2));
  p.MQK = (float*)(w + ws_take(off, (size_t)RS * 2 * GW * 4));
  p.MG = (float*)(w + ws_take(off, (size_t)RS * 4 * NH * 4));
  p.RQK = (float*)(w + ws_take(off, (size_t)RS * 2 * GW * 4));
  p.RW = (float*)(w + ws_take(off, (size_t)8 * RS * GW * 4));
  p.HF = (float*)(w + ws_take(off, (size_t)RS * 3 * GW * 4));
  p.HB = (float*)(w + ws_take(off, (size_t)RS * 3 * GW * 4));
  p.Z2 = (float*)(w + ws_take(off, (size_t)RS * GW * 4));
  p.HY = (float*)(w + ws_take(off, (size_t)RS * GW * 4));
  p.BON = (float*)(w + ws_take(off, (size_t)RS * GW * 4));
  p.GG = (float*)(w + ws_take(off, (size_t)RS * GW * 4));
  size_t off2 = arena;
  p.OUTF = (float*)(w + ws_take(off2, (size_t)RS * DM * 4));
  p.HFF = (bf16_t*)(w + ws_take(off2, (size_t)RS * 2 * DFF * 2));
  p.ACT = (bf16_t*)(w + ws_take(off2, (size_t)RS * DFF * 2));
}

#ifndef CPU_EMU
extern "C" void kernel_launch(void* const* d_in, const int* in_sizes, int n_in, void* d_out, int out_size, void* d_ws, size_t ws_size,
                              hipStream_t stream) {
  static int grid_blocks = 0;
  if (!grid_blocks) {
    int dev = 0, cus = 0, per_cu = 0;
    hipGetDevice(&dev);
    hipDeviceGetAttribute(&cus, hipDeviceAttributeMultiprocessorCount, dev);
    hipOccupancyMaxActiveBlocksPerMultiprocessor(&per_cu, k_mega, 256, 0);
    if (per_cu < 1) per_cu = 1;
    grid_blocks = cus * per_cu;
  }
  P p;
  memset(&p, 0, sizeof(p));
  build_params(p, d_in, d_out, d_ws);
  hipMemsetAsync(p.bar, 0, XCD_BAR_WORDS * sizeof(unsigned), stream);
  void* args[] = {&p};
  hipError_t e = hipLaunchCooperativeKernel((void*)k_mega, dim3(grid_blocks), dim3(256), args, 0, stream);
  if (e != hipSuccess) fprintf(stderr, "cooperative launch failed: %s (grid %d)\n", hipGetErrorString(e), grid_blocks);
}
#endif
```

```cpp
#ifndef CPU_EMU
#include <hip/hip_runtime.h>
#include <hip/hip_cooperative_groups.h>
#include <cstdio>
#include <cstring>
namespace cg = cooperative_groups;
#endif
#include <stdint.h>
#include <stddef.h>

#if !defined(CFG_SMALL) && !defined(CFG_CONVTEST)
#define DM 1024
#define NB 32
#define SEQ 2048
#define CTX 256
#define DFF 2816
#define SB 8
#elif defined(CFG_CONVTEST)
#define DM 512
#define NB 8
#define SEQ 256
#define CTX 128
#define DFF 192
#define SB 8
#else
#define DM 512
#define NB 2
#define SEQ 256
#define CTX 128
#define DFF 192
#define SB 1
#endif
#define DEPTH 2
#define GRIDW 64
#define HD 64
#define GW (DM / 4)
#define NH (GW / HD)
#define DPROJ (14 * GW + 4 * NH + 128)
#define LDP ((DPROJ + 127) / 128 * 128)
#define OFF_ML 0
#define OFF_HY (4 * GW + 4 * NH)
#define OFF_RT (OFF_HY + 3 * GW)
#define OFF_RW (OFF_RT + 4 * GW)
#define RWSH (3 * GW + 128)
#define RPB (CTX + SEQ)
#define RS (SB * RPB)
#define NSLICE (NB / SB)
#define ALPHA 1.41421356237309515f
#define NMOD 33
#ifdef CPU_EMU
#define WL 1
#else
#define WL 64
#endif

typedef unsigned short bf16_t;

struct P {
  const float *x, *c, *ctx, *c_ctx, *ada_w, *ada_b, *w_in, *ml_cw, *ml_cb, *ml_gb, *hy_cw, *hy_cb, *hy_w1, *hy_b1, *hy_w2, *hy_b2, *hy_w3,
      *hy_freq, *hy_d, *rw_mu, *rw_w0, *rw_w2, *rw_a0, *rw_a2, *rw_g2, *rw_kk, *rw_ka, *rw_rk, *ng, *nb, *w_out, *ln1g, *ln1b, *w_up, *f_cw,
      *f_cb, *w_dn, *ln2g, *ln2b;
  float* out;
  bf16_t *wt_in, *wt_out, *wt_up, *wt_dn;
  float *kf_lat, *kf_ctx, *hyh1, *hyh2, *scv, *modtab, *xc;
  bf16_t *kt_lat, *kt_ctx;
  float *ropec, *ropes;
  bf16_t *U, *PROJ;
  float *MQK, *MG, *RQK, *RW, *HF, *HB, *Z2, *HY, *BON, *GG;
  float* OUTF;
  bf16_t *HFF, *ACT;
  int* ctr;
  unsigned* bar;
};

__device__ __forceinline__ bf16_t f2bf(float f) {
  unsigned u = __float_as_uint(f);
  u += 0x7fffu + ((u >> 16) & 1u);
  return (bf16_t)(u >> 16);
}
#ifndef CPU_EMU
typedef __bf16 bf16v2_t __attribute__((ext_vector_type(2)));
typedef float f32x2_t __attribute__((ext_vector_type(2)));
#endif
__device__ __forceinline__ unsigned pack_bf16(float lo, float hi) {
#ifndef CPU_EMU
  f32x2_t v = {lo, hi};
  bf16v2_t b = __builtin_convertvector(v, bf16v2_t);
  return __builtin_bit_cast(unsigned, b);
#else
  return f2bf(lo) | ((unsigned)f2bf(hi) << 16);
#endif
}
__device__ __forceinline__ float bf2f(bf16_t h) { return __uint_as_float(((unsigned)h) << 16); }
#ifndef CPU_EMU
__device__ __forceinline__ float fexp_(float x) { return __expf(x); }
__device__ __forceinline__ float frcp_(float x) { return __builtin_amdgcn_rcpf(x); }
#else
__device__ __forceinline__ float fexp_(float x) { return expf(x); }
__device__ __forceinline__ float frcp_(float x) { return 1.0f / x; }
#endif
#ifndef CPU_EMU
__device__ __forceinline__ float sigmoidf_(float x) { return frcp_(1.0f + fexp_(-x)); }
__device__ __forceinline__ float siluf_(float x) { return x * frcp_(1.0f + fexp_(-x)); }
__device__ __forceinline__ float softplusf_(float x) { return fmaxf(x, 0.0f) + log1pf(expf(-fabsf(x))); }
__device__ __forceinline__ float tanhf_(float x) { return 1.0f - 2.0f * frcp_(1.0f + fexp_(2.0f * x)); }
#else
__device__ __forceinline__ float sigmoidf_(float x) { return 1.0f / (1.0f + expf(-x)); }
__device__ __forceinline__ float siluf_(float x) { return x / (1.0f + expf(-x)); }
__device__ __forceinline__ float softplusf_(float x) { return fmaxf(x, 0.0f) + log1pf(expf(-fabsf(x))); }
__device__ __forceinline__ float tanhf_(float x) { return tanhf(x); }
#endif
__device__ __forceinline__ float logsigmoidf_(float x) { return -softplusf_(-x); }

__device__ __forceinline__ float wave_sum(float v) {
#ifndef CPU_EMU
  v += __int_as_float(__builtin_amdgcn_mov_dpp(__float_as_int(v), 0xB1, 0xF, 0xF, true));
  v += __int_as_float(__builtin_amdgcn_mov_dpp(__float_as_int(v), 0x4E, 0xF, 0xF, true));
  v += __int_as_float(__builtin_amdgcn_mov_dpp(__float_as_int(v), 0x141, 0xF, 0xF, true));
  v += __int_as_float(__builtin_amdgcn_mov_dpp(__float_as_int(v), 0x140, 0xF, 0xF, true));
  const float r0 = __int_as_float(__builtin_amdgcn_readlane(__float_as_int(v), 0));
  const float r1 = __int_as_float(__builtin_amdgcn_readlane(__float_as_int(v), 16));
  const float r2 = __int_as_float(__builtin_amdgcn_readlane(__float_as_int(v), 32));
  const float r3 = __int_as_float(__builtin_amdgcn_readlane(__float_as_int(v), 48));
  v = (r0 + r1) + (r2 + r3);
#endif
  return v;
}

#ifndef CPU_EMU
typedef float f4 __attribute__((ext_vector_type(4)));
typedef unsigned u2v __attribute__((ext_vector_type(2)));
__device__ __forceinline__ f4 ld4(const float* a) { return *(const f4*)a; }
__device__ __forceinline__ void st4(float* a, f4 v) { *(f4*)a = v; }
__device__ __forceinline__ f4 ldbf4(const bf16_t* a) {
  u2v u = *(const u2v*)a;
  f4 r;
  r.x = __uint_as_float(u.x << 16); r.y = __uint_as_float(u.x & 0xffff0000u);
  r.z = __uint_as_float(u.y << 16); r.w = __uint_as_float(u.y & 0xffff0000u);
  return r;
}
#else
struct f4 { float x, y, z, w; };
__device__ __forceinline__ f4 ld4(const float* a) { f4 r; r.x = a[0]; r.y = a[1]; r.z = a[2]; r.w = a[3]; return r; }
__device__ __forceinline__ void st4(float* a, f4 v) { a[0] = v.x; a[1] = v.y; a[2] = v.z; a[3] = v.w; }
__device__ __forceinline__ f4 ldbf4(const bf16_t* a) { f4 r; r.x = bf2f(a[0]); r.y = bf2f(a[1]); r.z = bf2f(a[2]); r.w = bf2f(a[3]); return r; }
#endif
#ifndef CPU_EMU
typedef unsigned u4 __attribute__((ext_vector_type(4)));
__device__ __forceinline__ u4 ldu4(const bf16_t* a) { return *(const u4*)a; }
__device__ __forceinline__ void stu4(bf16_t* a, u4 v) { *(u4*)a = v; }
#else
struct u4 { unsigned x, y, z, w; };
__device__ __forceinline__ u4 ldu4(const bf16_t* a) { u4 r; const unsigned* q = (const unsigned*)a; r.x = q[0]; r.y = q[1]; r.z = q[2]; r.w = q[3]; return r; }
__device__ __forceinline__ void stu4(bf16_t* a, u4 v) { unsigned* q = (unsigned*)a; q[0] = v.x; q[1] = v.y; q[2] = v.z; q[3] = v.w; }
#endif
__device__ __forceinline__ void ld8(float* dst, const float* src) {
#pragma unroll
  for (int j = 0; j < 2; ++j) { f4 v = ld4(src + 4 * j); dst[4 * j] = v.x; dst[4 * j + 1] = v.y; dst[4 * j + 2] = v.z; dst[4 * j + 3] = v.w; }
}
__device__ __forceinline__ void ld16(float* dst, const float* src) {
#pragma unroll
  for (int j = 0; j < 4; ++j) { f4 v = ld4(src + 4 * j); dst[4 * j] = v.x; dst[4 * j + 1] = v.y; dst[4 * j + 2] = v.z; dst[4 * j + 3] = v.w; }
}


__device__ __forceinline__ const float* xsrc_row(const P& p, int l, int b, int pp) {
  if (pp < CTX) return (l == 0 ? p.ctx : p.xc) + ((size_t)b * CTX + pp) * DM;
  return (l == 0 ? p.x : p.out) + ((size_t)b * SEQ + (pp - CTX)) * DM;
}
__device__ __forceinline__ float* xdst_row(const P& p, int b, int pp) {
  if (pp < CTX) return p.xc + ((size_t)b * CTX + pp) * DM;
  return p.out + ((size_t)b * SEQ + (pp - CTX)) * DM;
}
__device__ __forceinline__ bool has_prev(int pp) { return pp != 0 && pp != CTX; }
__device__ __forceinline__ bool has_next(int pp) { return pp != CTX - 1 && pp != RPB - 1; }

__device__ __forceinline__ void cvt_weight(const float* W, bf16_t* Wt, int K, int N, int Npad, int gtid, int gsize) {
  const int nk8 = K / 8;
  for (long it = gtid; it < (long)nk8 * Npad; it += gsize) {
    int n = (int)(it % Npad), k8 = (int)(it / Npad);
    bf16_t v[8];
#pragma unroll
    for (int j = 0; j < 8; ++j) v[j] = (n < N) ? f2bf(W[(size_t)(k8 * 8 + j) * N + n]) : (bf16_t)0;
    uint4 o;
    o.x = v[0] | ((unsigned)v[1] << 16); o.y = v[2] | ((unsigned)v[3] << 16);
    o.z = v[4] | ((unsigned)v[5] << 16); o.w = v[6] | ((unsigned)v[7] << 16);
    *(uint4*)(Wt + (size_t)n * K + k8 * 8) = o;
  }
}
__device__ __forceinline__ void hy_feat_h1(const P& p, int gtid, int gsize) {
  const int per_l = (SEQ + CTX) * 64;
  for (int it = gtid; it < DEPTH * per_l; it += gsize) {
    int l = it / per_l, r = it % per_l;
    int i, L, seg;
    int j = r % 64; r /= 64;
    if (r < SEQ) { seg = 0; i = r; L = SEQ; } else { seg = 1; i = r - SEQ; L = CTX; }
    const float* w1 = p.hy_w1 + (size_t)l * 33 * 64;
    float t = (float)i / (float)(L - 1);
    float ang = 6.283185307179586f * (float)i / (float)L;
    float acc = t * w1[j];
    for (int b = 0; b < 16; ++b) {
      float band = 1e-4f + (float)b * ((15.0f - 1e-4f) / 15.0f);
      float a = band * ang;
      acc += cosf(a) * w1[(1 + b) * 64 + j];
      acc -= sinf(a) * w1[(17 + b) * 64 + j];
    }
    float h = sinf(p.hy_freq[l * 64 + j] * (acc + p.hy_b1[l * 64 + j]));
    p.hyh1[((size_t)(l * 2 + seg) * SEQ + i) * 64 + j] = h;
  }
}
__device__ __forceinline__ void ph_pro_a(const P& p, int gtid, int gsize) {
  for (int l = 0; l < DEPTH; ++l) {
    cvt_weight(p.w_in + (size_t)l * DM * DPROJ, p.wt_in + (size_t)l * LDP * DM, DM, DPROJ, LDP, gtid, gsize);
    cvt_weight(p.w_out + (size_t)l * DM * DM, p.wt_out + (size_t)l * DM * DM, DM, DM, DM, gtid, gsize);
    cvt_weight(p.w_up + (size_t)l * DM * 2 * DFF, p.wt_up + (size_t)l * 2 * DFF * DM, DM, 2 * DFF, 2 * DFF, gtid, gsize);
    cvt_weight(p.w_dn + (size_t)l * DFF * DM, p.wt_dn + (size_t)l * DM * DFF, DFF, DM, DM, gtid, gsize);
  }
  for (int it = gtid; it < NMOD * DM; it += gsize) {
    int r = it / DM, k = it % DM;
    float v = (r < NB) ? p.c[(size_t)r * DM + k] : p.c_ctx[k];
    p.scv[it] = siluf_(v);
  }
  hy_feat_h1(p, gtid, gsize);
  for (int it = gtid; it < 64 * 16; it += gsize) {
    float a = (float)(it / 16) * powf(10000.0f, -(float)(it % 16) / 16.0f);
    p.ropec[it] = cosf(a);
    p.ropes[it] = sinf(a);
  }
}
__device__ __forceinline__ void ph_pro_b(const P& p, int gtid, int gsize) {
  for (int it = gtid; it < DEPTH * NMOD * 6 * DM; it += gsize) {
    int j = it % (6 * DM), r = (it / (6 * DM)) % NMOD, l = it / (6 * DM * NMOD);
    const float* w = p.ada_w + (size_t)l * DM * 6 * DM + j;
    const float* sv = p.scv + r * DM;
    float acc = 0.f;
    for (int k = 0; k < DM; ++k) acc += sv[k] * w[(size_t)k * 6 * DM];
    p.modtab[it] = acc + p.ada_b[l * 6 * DM + j];
  }
  const int per_l = (SEQ + CTX) * 64;
  for (int it = gtid; it < DEPTH * per_l; it += gsize) {
    int l = it / per_l, r = it % per_l;
    int j = r % 64; r /= 64;
    int seg = r < SEQ ? 0 : 1, i = r < SEQ ? r : r - SEQ;
    const float* h1 = p.hyh1 + ((size_t)(l * 2 + seg) * SEQ + i) * 64;
    const float* w2 = p.hy_w2 + (size_t)l * 64 * 64;
    float acc = 0.f;
    for (int k = 0; k < 64; ++k) acc += h1[k] * w2[k * 64 + j];
    p.hyh2[((size_t)(l * 2 + seg) * SEQ + i) * 64 + j] = sinf(p.hy_freq[l * 64 + j] * (acc + p.hy_b2[l * 64 + j]));
  }
}
__device__ __forceinline__ void ph_pro_c(const P& p, int gtid, int gsize) {
  const int per_l = 2 * (2 * SEQ + 2 * CTX) * GW;
  const float max_decay = -4.605170185988091f / 0.3f, min_decay = -4.605170185988091f / 1.5f;
  for (int it = gtid; it < DEPTH * per_l; it += gsize) {
    int l = it / per_l, r = it % per_l;
    int c = r % GW; r /= GW;
    int ord = r & 1; r >>= 1;
    int seg, idx, L;
    if (r < 2 * SEQ) { seg = 0; idx = r; L = SEQ; } else { seg = 1; idx = r - 2 * SEQ; L = CTX; }
    int d = idx - L;
    float val = 0.f;
    if (idx != 0) {
      int i = d < 0 ? -d : d;
      float ti = (float)i / (float)(L - 1);
      float delta = fabsf(min_decay + (float)c * ((max_decay - min_decay) / (float)(GW - 1)));
      float win = expf(-ti * delta);
      const float* h2 = p.hyh2 + ((size_t)(l * 2 + seg) * SEQ + i) * 64;
      const float* w3 = p.hy_w3 + (size_t)l * 64 * 4 * GW;
      float af = 0.f, ab = 0.f;
      for (int k = 0; k < 64; ++k) {
        float hv = h2[k];
        af += hv * w3[k * 4 * GW + 0 * 2 * GW + ord * GW + c];
        ab += hv * w3[k * 4 * GW + 1 * 2 * GW + ord * GW + c];
      }
      if (d > 0) val = af * win;
      else if (d < 0) val = ab * win;
      else val = (af + ab) * win + p.hy_d[(l * 2 + ord) * GW + c];
    }
    float* kf = seg == 0 ? p.kf_lat + ((size_t)(l * 2 + ord) * 2 * SEQ + idx) * GW : p.kf_ctx + ((size_t)(l * 2 + ord) * 2 * CTX + idx) * GW;
    kf[c] = val;
    if (seg == 0) p.kt_lat[((size_t)(l * 2 + ord) * GW + c) * 2 * SEQ + idx] = f2bf(val);
    else p.kt_ctx[((size_t)(l * 2 + ord) * GW + c) * 2 * CTX + idx] = f2bf(val);
  }
}

#define NV (DM / WL)
__device__ __forceinline__ void ln_inplace(float* v, int lane) {
  float s = 0.f;
#pragma unroll
  for (int i = 0; i < NV; ++i) s += v[i];
  s = wave_sum(s);
  float mu = s * (1.0f / DM);
  float q = 0.f;
#pragma unroll
  for (int i = 0; i < NV; ++i) { float d = v[i] - mu; q += d * d; }
  q = wave_sum(q);
  float rs = 1.0f / sqrtf(q * (1.0f / DM) + 1e-5f);
#pragma unroll
  for (int i = 0; i < NV; ++i) v[i] = (v[i] - mu) * rs;
}
__device__ __forceinline__ void ph_ln0(const P& p, int l, int s, int gtid, int gsize) {
  const int lane = gtid % WL, gw = gtid / WL, nw = gsize / WL;
  if (gtid == 0) *p.ctr = 0;
  for (int row = gw; row < RS; row += nw) {
    int bl = row / RPB, pp = row % RPB, b = s * SB + bl;
    const float* xr = xsrc_row(p, l, b, pp);
    const float* mod = p.modtab + ((size_t)l * NMOD + (pp < CTX ? NB : b)) * 6 * DM;
    float v[NV];
#pragma unroll
    for (int i = 0; i < NV; ++i) v[i] = xr[i * WL + lane];
    ln_inplace(v, lane);
#pragma unroll
    for (int i = 0; i < NV; ++i) {
      int k = i * WL + lane;
      p.U[(size_t)row * DM + k] = f2bf(v[i] * (1.0f + mod[DM + k]) + mod[k]);
    }
  }
}
__device__ __forceinline__ void ph_ln1(const P& p, int l, int s, int gtid, int gsize) {
  const int lane = gtid % WL, gw = gtid / WL, nw = gsize / WL;
  const bool last = (l == DEPTH - 1);
  for (int row = gw; row < RS; row += nw) {
    int bl = row / RPB, pp = row % RPB, b = s * SB + bl;
    if (last && pp < CTX) continue;
    const float* xr = xsrc_row(p, l, b, pp);
    float* xd = xdst_row(p, b, pp);
    const float* mod = p.modtab + ((size_t)l * NMOD + (pp < CTX ? NB : b)) * 6 * DM;
    const float* o = p.OUTF + (size_t)row * DM;
    float v[NV];
#pragma unroll
    for (int i = 0; i < NV; ++i) { int k = i * WL + lane; v[i] = ALPHA * xr[k] + mod[2 * DM + k] * o[k]; }
    ln_inplace(v, lane);
#pragma unroll
    for (int i = 0; i < NV; ++i) { int k = i * WL + lane; v[i] = v[i] * p.ln1g[l * DM + k] + p.ln1b[l * DM + k]; xd[k] = v[i]; }
    ln_inplace(v, lane);
#pragma unroll
    for (int i = 0; i < NV; ++i) {
      int k = i * WL + lane;
      p.U[(size_t)row * DM + k] = f2bf(v[i] * (1.0f + mod[4 * DM + k]) + mod[3 * DM + k]);
    }
  }
}
__device__ __forceinline__ void ph_ln2(const P& p, int l, int s, int gtid, int gsize) {
  const int lane = gtid % WL, gw = gtid / WL, nw = gsize / WL;
  const bool last = (l == DEPTH - 1);
  for (int row = gw; row < RS; row += nw) {
    int bl = row / RPB, pp = row % RPB, b = s * SB + bl;
    if (last && pp < CTX) continue;
    float* xd = xdst_row(p, b, pp);
    const float* mod = p.modtab + ((size_t)l * NMOD + (pp < CTX ? NB : b)) * 6 * DM;
    const float* o = p.OUTF + (size_t)row * DM;
    float v[NV];
#pragma unroll
    for (int i = 0; i < NV; ++i) { int k = i * WL + lane; v[i] = ALPHA * xd[k] + mod[5 * DM + k] * o[k]; }
    ln_inplace(v, lane);
#pragma unroll
    for (int i = 0; i < NV; ++i) { int k = i * WL + lane; xd[k] = v[i] * p.ln2g[l * DM + k] + p.ln2b[l * DM + k]; }
  }
}

#ifndef CPU_EMU
typedef short bf16x8 __attribute__((ext_vector_type(8)));
typedef float f32x4 __attribute__((ext_vector_type(4)));
typedef unsigned u32x4 __attribute__((ext_vector_type(4)));
__device__ __forceinline__ f32x4 mfma16(bf16x8 a, bf16x8 b, f32x4 c) { return __builtin_amdgcn_mfma_f32_16x16x32_bf16(a, b, c, 0, 0, 0); }
#define GBM 128
#define GBN 128
#define GBK 64
#define GLD (GBK + 8)
template <bool OUT_BF16>
__device__ __forceinline__ void gemm_phase(const bf16_t* __restrict__ A, const bf16_t* __restrict__ Bt, void* __restrict__ Cv, int M, int N, int K, int ldc,
                           bool skip_ctx, bf16_t* lds, int tid) {
  bf16_t* sA = lds;
  bf16_t* sB = lds + GBM * GLD;
  const int lane = tid & 63, wave = tid >> 6;
  const int wm = wave >> 1, wn = wave & 1;
  const int ntm = M / GBM, ntn = N / GBN;
  const int KT = K / GBK;
  const int lr = lane & 15, lq = lane >> 4;
  for (int tile = blockIdx.x; tile < ntm * ntn; tile += gridDim.x) {
    const int tm = tile / ntn, tn = tile % ntn;
    if (skip_ctx && (tm % (RPB / GBM)) < (CTX / GBM)) continue;
    const int m0 = tm * GBM, n0 = tn * GBN;
    f32x4 acc[4][4];
#pragma unroll
    for (int i = 0; i < 4; ++i)
#pragma unroll
      for (int j = 0; j < 4; ++j) acc[i][j] = (f32x4){0.f, 0.f, 0.f, 0.f};
    u32x4 ra[4], rb[4];
#pragma unroll
    for (int i = 0; i < 4; ++i) {
      int id = tid + i * 256, r = id >> 3, ch = id & 7;
      ra[i] = *(const u32x4*)(A + (size_t)(m0 + r) * K + ch * 8);
      rb[i] = *(const u32x4*)(Bt + (size_t)(n0 + r) * K + ch * 8);
    }
    for (int kt = 0; kt < KT; ++kt) {
      __syncthreads();
#pragma unroll
      for (int i = 0; i < 4; ++i) {
        int id = tid + i * 256, r = id >> 3, ch = id & 7;
        *(u32x4*)(sA + r * GLD + ch * 8) = ra[i];
        *(u32x4*)(sB + r * GLD + ch * 8) = rb[i];
      }
      __syncthreads();
      if (kt + 1 < KT) {
#pragma unroll
        for (int i = 0; i < 4; ++i) {
          int id = tid + i * 256, r = id >> 3, ch = id & 7;
          ra[i] = *(const u32x4*)(A + (size_t)(m0 + r) * K + (kt + 1) * GBK + ch * 8);
          rb[i] = *(const u32x4*)(Bt + (size_t)(n0 + r) * K + (kt + 1) * GBK + ch * 8);
        }
      }
      __builtin_amdgcn_sched_barrier(0);
      {
        bf16x8 fa[2][4], fb[2][4];
#pragma unroll
        for (int kh = 0; kh < 2; ++kh) {
#pragma unroll
          for (int i = 0; i < 4; ++i) fa[kh][i] = *(const bf16x8*)(sA + (wm * 64 + i * 16 + lr) * GLD + kh * 32 + lq * 8);
#pragma unroll
          for (int j = 0; j < 4; ++j) fb[kh][j] = *(const bf16x8*)(sB + (wn * 64 + j * 16 + lr) * GLD + kh * 32 + lq * 8);
        }
        __builtin_amdgcn_sched_barrier(0);
#pragma unroll
        for (int kh = 0; kh < 2; ++kh)
#pragma unroll
          for (int i = 0; i < 4; ++i)
#pragma unroll
            for (int j = 0; j < 4; ++j) acc[i][j] = __builtin_amdgcn_mfma_f32_16x16x32_bf16(fb[kh][j], fa[kh][i], acc[i][j], 0, 0, 0);
      }
    }
#pragma unroll
    for (int i = 0; i < 4; ++i)
#pragma unroll
      for (int j = 0; j < 4; ++j) {
        size_t off = (size_t)(m0 + wm * 64 + i * 16 + lr) * ldc + n0 + wn * 64 + j * 16 + lq * 4;
        if (OUT_BF16) {
          uint2 o;
          o.x = pack_bf16(acc[i][j][0], acc[i][j][1]);
          o.y = pack_bf16(acc[i][j][2], acc[i][j][3]);
          *(uint2*)((bf16_t*)Cv + off) = o;
        } else {
          *(float4*)((float*)Cv + off) = make_float4(acc[i][j][0], acc[i][j][1], acc[i][j][2], acc[i][j][3]);
        }
      }
  }
}
#else
template <bool OUT_BF16>
void gemm_phase(const bf16_t* A, const bf16_t* Bt, void* Cv, int M, int N, int K, int ldc, bool skip_ctx, bf16_t* lds, int tid) {
  int gtid = blockIdx.x * blockDim.x + threadIdx.x, gsize = gridDim.x * blockDim.x;
  for (long it = gtid; it < (long)M * N; it += gsize) {
    int m = (int)(it / N), n = (int)(it % N);
    if (skip_ctx && (m % RPB) < CTX) continue;
    float acc = 0.f;
    for (int k = 0; k < K; ++k) acc += bf2f(A[(size_t)m * K + k]) * bf2f(Bt[(size_t)n * K + k]);
    if (OUT_BF16) ((bf16_t*)Cv)[(size_t)m * ldc + n] = f2bf(acc);
    else ((float*)Cv)[(size_t)m * ldc + n] = acc;
  }
}
#endif

#define PJ(row, col) bf2f(p.PROJ[(size_t)(row) * LDP + (col)])
template <int ORD>
__device__ __forceinline__ void hyena_conv_item(const P& p, int l, int it) {
  const bool need_ctx = (l != DEPTH - 1);
  const int ntb = (need_ctx ? CTX / 16 : 0) + SEQ / 16;
  int c = it % GW, r = it / GW;
  int tb = r % ntb, bl = r / ntb;
  int seg0, L, t0;
  const float* kf;
  if (need_ctx && tb < CTX / 16) { seg0 = 0; L = CTX; t0 = tb * 16; kf = p.kf_ctx + (size_t)(l * 2 + ORD) * 2 * CTX * GW; }
  else { int tb2 = tb - (need_ctx ? CTX / 16 : 0); seg0 = CTX; L = SEQ; t0 = tb2 * 16; kf = p.kf_lat + (size_t)(l * 2 + ORD) * 2 * SEQ * GW; }
  const int rowbase = bl * RPB + seg0;
  const float* cw = p.hy_cw + (size_t)l * 3 * 3 * GW;
  const float* cb = p.hy_cb + (size_t)l * 3 * GW;
  float acc[16], F[31], u[16];
#pragma unroll
  for (int i = 0; i < 16; ++i) acc[i] = 0.f;
#pragma unroll
  for (int m = 0; m < 15; ++m) F[m] = kf[(size_t)(L + t0 + 1 + m) * GW + c];
  const float w0 = cw[0 * 3 * GW + c], w1 = cw[1 * 3 * GW + c], w2 = cw[2 * 3 * GW + c], bb = cb[c];
  float nF[16], nin[18];
  auto fetch = [&](int s0) {
#pragma unroll
    for (int m = 0; m < 16; ++m) nF[m] = kf[(size_t)(L + t0 - s0 - 15 + m) * GW + c];
    if (ORD == 0) {
#pragma unroll
      for (int j = 0; j < 18; ++j) {
        int sp = s0 - 1 + j;
        nin[j] = (sp >= 0 && sp < L) ? PJ(rowbase + sp, OFF_HY + c) : 0.f;
      }
    } else {
#pragma unroll
      for (int j = 0; j < 16; ++j) nin[j] = p.Z2[(size_t)(rowbase + s0 + j) * GW + c];
    }
  };
  fetch(0);
  for (int s0 = 0; s0 < L; s0 += 16) {
#pragma unroll
    for (int m = 14; m >= 0; --m) F[m + 16] = F[m];
#pragma unroll
    for (int m = 0; m < 16; ++m) F[m] = nF[m];
    if (ORD == 0) {
#pragma unroll
      for (int j = 0; j < 16; ++j) u[j] = w0 * nin[j] + w1 * nin[j + 1] + w2 * nin[j + 2] + bb;
    } else {
#pragma unroll
      for (int j = 0; j < 16; ++j) u[j] = nin[j];
    }
    if (s0 + 16 < L) fetch(s0 + 16);
#pragma unroll
    for (int j = 0; j < 16; ++j)
#pragma unroll
      for (int i = 0; i < 16; ++i) acc[i] += F[i - j + 15] * u[j];
  }
  const int xc = (ORD == 0 ? GW : 2 * GW) + c;
  const float v0 = cw[0 * 3 * GW + xc], v1 = cw[1 * 3 * GW + xc], v2 = cw[2 * 3 * GW + xc], vb = cb[xc];
#pragma unroll
  for (int i = 0; i < 16; ++i) {
    int t = t0 + i;
    float xm = t > 0 ? PJ(rowbase + t - 1, OFF_HY + xc) : 0.f;
    float x0 = PJ(rowbase + t, OFF_HY + xc);
    float xp = t < L - 1 ? PJ(rowbase + t + 1, OFF_HY + xc) : 0.f;
    float g = v0 * xm + v1 * x0 + v2 * xp + vb;
    float o = g * acc[i];
    if (ORD == 0) p.Z2[(size_t)(rowbase + t) * GW + c] = o;
    else p.HY[(size_t)(rowbase + t) * GW + c] = o;
  }
}
__device__ __forceinline__ int hyena_items(int l) { return SB * ((l != DEPTH - 1 ? CTX / 16 : 0) + SEQ / 16) * GW; }

#if SB == 8
#define HC_KOFF (SEQ + 32)
#define HC_KLEN (2 * SEQ + 64)
#define HC_ULS ((SEQ / 16 + 4) * 16)
template <int ORD>
__device__ __forceinline__ void hyena_mfma_item(const P& p, int l, int item, bf16_t* lds, int tid) {
  const int c = item % GW, seg = item / GW;
  const int L = seg ? CTX : SEQ, seg0 = seg ? 0 : CTX, NTB = L / 16;
  const bf16_t* kt = (seg ? p.kt_ctx + ((size_t)(l * 2 + ORD) * GW + c) * 2 * CTX : p.kt_lat + ((size_t)(l * 2 + ORD) * GW + c) * 2 * SEQ);
  bf16_t* KL = lds;
  bf16_t* UL = lds + HC_KLEN;
  const float* cw = p.hy_cw + (size_t)l * 3 * 3 * GW;
  const float* cb = p.hy_cb + (size_t)l * 3 * GW;
  __syncthreads();
  for (int n = -(L + 32) + tid; n < L + 32; n += 256) KL[HC_KOFF + n] = (n > -L && n < L) ? kt[L - n] : (bf16_t)0;
  for (int q = tid; q < SB * 4; q += 256) {
    int b = q >> 2, w = q & 3;
    bf16_t* dst = UL + b * HC_ULS + (w < 2 ? w * 16 : (NTB + w) * 16);
    for (int j = 0; j < 16; ++j) dst[j] = 0;
  }
  {
    const float w0 = cw[0 * 3 * GW + c], w1 = cw[1 * 3 * GW + c], w2 = cw[2 * 3 * GW + c], bb = cb[c];
    for (int q = tid; q < SB * (L / 8); q += 256) {
      const int b = q / (L / 8), s8 = (q % (L / 8)) * 8;
      const int row = b * RPB + seg0 + s8;
      float u[8];
      if (ORD == 0) {
        float raw[10];
#pragma unroll
        for (int j = 0; j < 10; ++j) { int sp = s8 - 1 + j; raw[j] = (sp >= 0 && sp < L) ? PJ(row - 1 + j, OFF_HY + c) : 0.f; }
#pragma unroll
        for (int j = 0; j < 8; ++j) u[j] = w0 * raw[j] + w1 * raw[j + 1] + w2 * raw[j + 2] + bb;
      } else {
#pragma unroll
        for (int j = 0; j < 8; ++j) u[j] = p.Z2[(size_t)(row + j) * GW + c];
      }
      unsigned* dst = (unsigned*)(UL + b * HC_ULS + 32 + s8);
#pragma unroll
      for (int j = 0; j < 4; ++j) dst[j] = pack_bf16(u[2 * j], u[2 * j + 1]);
    }
  }
  __syncthreads();
  const int lane = tid & 63, wave = tid >> 6;
  const int ti = lane & 15, q4 = lane >> 4;
  const int NT = NTB / 2, TPW = NT / 4;
  const int T0 = wave * TPW * 2;
  f32x4 acc[16];
#pragma unroll
  for (int m = 0; m < 16; ++m) acc[m] = (f32x4){0.f, 0.f, 0.f, 0.f};
  const int nK = NTB / 2 + TPW;
  const int colb = (lane & 7) * HC_ULS + (q4 & 1) * 8;
  const int tbsel = (lane >> 3) & 1;
  for (int k = 0; k < nK; ++k) {
    const int dl = T0 - NTB + 2 * k + (q4 >> 1);
    const int nb = HC_KOFF - 16 * dl - ti + 8 * (q4 & 1);
    bf16x8 A;
#pragma unroll
    for (int j = 0; j < 8; ++j) A[j] = (short)KL[nb + j];
#pragma unroll
    for (int m = 0; m < 16; ++m) {
      if (m < TPW && k >= m && k <= m + NTB / 2) {
        const int sb = T0 + 2 * m + tbsel - dl;
        const bf16x8 B = *(const bf16x8*)(UL + colb + (sb + 2) * 16);
        acc[m] = mfma16(A, B, acc[m]);
      }
    }
  }
  const int xc = (ORD == 0 ? GW : 2 * GW) + c;
  const float v0 = cw[0 * 3 * GW + xc], v1 = cw[1 * 3 * GW + xc], v2 = cw[2 * 3 * GW + xc], vb = cb[xc];
  const int bn = lane & 7;
#pragma unroll
  for (int m = 0; m < 16; ++m) {
    if (m < TPW) {
      const int t0 = 16 * (T0 + 2 * m + tbsel) + q4 * 4;
      const int row = bn * RPB + seg0 + t0;
      float raw[6];
#pragma unroll
      for (int j = 0; j < 6; ++j) { int tp = t0 - 1 + j; raw[j] = (tp >= 0 && tp < L) ? PJ(row - 1 + j, OFF_HY + xc) : 0.f; }
#pragma unroll
      for (int r = 0; r < 4; ++r) {
        float g = v0 * raw[r] + v1 * raw[r + 1] + v2 * raw[r + 2] + vb;
        float o = g * acc[m][r];
        if (ORD == 0) p.Z2[(size_t)(row + r) * GW + c] = o;
        else p.HY[(size_t)(row + r) * GW + c] = o;
      }
    }
  }
}
__device__ __forceinline__ int hyena_mfma_items(int l) { return (l != DEPTH - 1 ? 2 : 1) * GW; }
#endif


__device__ __forceinline__ float rw_shift(const P& p, int l, int row, int pp, int j) {
  float x = PJ(row, OFF_RW + j);
  float xp = has_prev(pp) ? PJ(row - 1, OFF_RW + j) : 0.f;
  float xn = has_next(pp) ? PJ(row + 1, OFF_RW + j) : 0.f;
  return x + p.rw_mu[(size_t)(l * 2 + 0) * RWSH + j] * (xp - x) + p.rw_mu[(size_t)(l * 2 + 1) * RWSH + j] * (xn - x);
}
__device__ __forceinline__ void ph_prep(const P& p, int l, int s, int gtid, int gsize, float* lds, int tid) {
#pragma unroll 1
  for (int it = gtid; it < RS * (2 * GW / 4); it += gsize) {
    const int j = (it % (2 * GW / 4)) * 4, row = it / (2 * GW / 4), pp = row % RPB;
    const float* cw = p.ml_cw + (size_t)l * 3 * 2 * GW + j;
    const bf16_t* pr = p.PROJ + (size_t)row * LDP + OFF_ML + j;
    const f4 x0 = ldbf4(pr), xm = ldbf4(row > 0 ? pr - LDP : pr), xp = ldbf4(row < RS - 1 ? pr + LDP : pr);
    const float hp = has_prev(pp) ? 1.0f : 0.0f, hn = has_next(pp) ? 1.0f : 0.0f;
    f4 c0 = ld4(cw), c1 = ld4(cw + 2 * GW), c2 = ld4(cw + 4 * GW), cb = ld4(p.ml_cb + l * 2 * GW + j);
    c0.x *= hp; c0.y *= hp; c0.z *= hp; c0.w *= hp;
    c2.x *= hn; c2.y *= hn; c2.z *= hn; c2.w *= hn;
    const float sc = (j < GW) ? 0.125f : 1.0f;
    f4 o;
    o.x = siluf_(c0.x * xm.x + c1.x * x0.x + c2.x * xp.x + cb.x) * sc;
    o.y = siluf_(c0.y * xm.y + c1.y * x0.y + c2.y * xp.y + cb.y) * sc;
    o.z = siluf_(c0.z * xm.z + c1.z * x0.z + c2.z * xp.z + cb.z) * sc;
    o.w = siluf_(c0.w * xm.w + c1.w * x0.w + c2.w * xp.w + cb.w) * sc;
    st4(p.MQK + (size_t)row * 2 * GW + j, o);
  }
  for (int it = gtid; it < RS * 4 * NH; it += gsize) {
    int gj = it % (4 * NH), row = it / (4 * NH);
    float g = PJ(row, OFF_ML + 4 * GW + gj) + p.ml_gb[l * 4 * NH + gj];
    if ((gj / NH) & 1) g = logsigmoidf_(g);
    p.MG[(size_t)row * 4 * NH + gj] = g;
  }
#pragma unroll 1
  for (int it = gtid; it < RS * (2 * GW / 4); it += gsize) {
    const int j = (it % (2 * GW / 4)) * 4, row = it / (2 * GW / 4), pp = row % RPB;
    const int which = j / GW, c = j % GW, dd = c % HD, hb = c - dd;
    const bf16_t* pr = p.PROJ + (size_t)row * LDP + OFF_RT + which * GW;
    const f4 x = ldbf4(pr + c);
    f4 o;
    {
      const int t = pp >= CTX ? pp - CTX : 0, ri = t / GRIDW, ci = t % GRIDW;
      const int half = dd / 32, e = dd % 32, pi = e % 16;
      const bool first = e < 16;
      const int pos = pp >= CTX ? (half ? ci : ri) : 0;
      const f4 xo = ldbf4(pr + hb + (first ? dd + 16 : dd - 16));
      const f4 cs = ld4(p.ropec + pos * 16 + pi), sn = ld4(p.ropes + pos * 16 + pi);
      const float sg = first ? -1.0f : 1.0f;
      o.x = x.x * cs.x + sg * xo.x * sn.x;
      o.y = x.y * cs.y + sg * xo.y * sn.y;
      o.z = x.z * cs.z + sg * xo.z * sn.z;
      o.w = x.w * cs.w + sg * xo.w * sn.w;
    }
    if (which == 0) { o.x *= 0.125f; o.y *= 0.125f; o.z *= 0.125f; o.w *= 0.125f; }
    st4(p.RQK + (size_t)row * 2 * GW + j, o);
  }
  {
    float* zs = lds;
    float* part = lds + 8 * RWSH;
    const size_t AS = (size_t)RS * GW;
    for (int tile = blockIdx.x; tile < RS / 8; tile += gridDim.x) {
      const int row0 = tile * 8;
      __syncthreads();
      if (tid < RWSH / 4) {
        const int j4 = tid * 4;
        const f4 m0 = ld4(p.rw_mu + (size_t)(l * 2 + 0) * RWSH + j4), m1 = ld4(p.rw_mu + (size_t)(l * 2 + 1) * RWSH + j4);
        const int kind = (j4 >= 3 * GW && j4 < 3 * GW + 32) ? 1 : (j4 >= 3 * GW + 64 ? 2 : 0);
        const bf16_t* pr = p.PROJ + (size_t)row0 * LDP + OFF_RW + j4;
        f4 x[10];
#pragma unroll
        for (int r = 0; r < 10; ++r) {
          const int row = row0 - 1 + r;
          if (row >= 0 && row < RS) x[r] = ldbf4(pr + (ptrdiff_t)(r - 1) * LDP);
          else { x[r].x = 0.f; x[r].y = 0.f; x[r].z = 0.f; x[r].w = 0.f; }
        }
#pragma unroll
        for (int r = 0; r < 8; ++r) {
          const int pp = (row0 + r) % RPB;
          const float hp = has_prev(pp) ? 1.0f : 0.0f, hn = has_next(pp) ? 1.0f : 0.0f;
          const f4 c = x[r + 1];
          f4 z;
          z.x = c.x + m0.x * (hp * x[r].x - c.x) + m1.x * (hn * x[r + 2].x - c.x);
          z.y = c.y + m0.y * (hp * x[r].y - c.y) + m1.y * (hn * x[r + 2].y - c.y);
          z.z = c.z + m0.z * (hp * x[r].z - c.z) + m1.z * (hn * x[r + 2].z - c.z);
          z.w = c.w + m0.w * (hp * x[r].w - c.w) + m1.w * (hn * x[r + 2].w - c.w);
          if (kind == 1) { z.x = tanhf_(z.x); z.y = tanhf_(z.y); z.z = tanhf_(z.z); z.w = tanhf_(z.w); }
          else if (kind == 2) { z.x = sigmoidf_(z.x); z.y = sigmoidf_(z.y); z.z = sigmoidf_(z.z); z.w = sigmoidf_(z.w); }
          st4(zs + r * RWSH + j4, z);
        }
      }
      __syncthreads();
      {
        int pr = tid >> 3, sub = tid & 7;
        if (pr < 8 * NH) {
          int r = pr / NH, h = pr % NH;
          float ss = 0.f, bs = 0.f;
          for (int i = sub * 8; i < sub * 8 + 8; ++i) {
            float kv = zs[r * RWSH + GW + h * HD + i], rv = zs[r * RWSH + h * HD + i];
            float kk = kv * p.rw_kk[l * GW + h * HD + i];
            ss += kk * kk;
            bs += rv * kv * p.rw_rk[(l * NH + h) * HD + i];
          }
          part[pr * 8 + sub] = ss;
          part[256 + pr * 8 + sub] = bs;
        }
      }
      __syncthreads();
      for (int c = tid; c < GW; c += 256) {
        const int h = c / HD;
        float wa0[8], wa1[8], aa0[8], aa1[8], gg[8];
#pragma unroll
        for (int r = 0; r < 8; ++r) { wa0[r] = 0.f; wa1[r] = 0.f; aa0[r] = 0.f; aa1[r] = 0.f; gg[r] = 0.f; }
#pragma unroll 8
        for (int i = 0; i < 32; ++i) {
          float w20 = p.rw_w2[((size_t)(l * 2 + 0) * 32 + i) * GW + c], w21 = p.rw_w2[((size_t)(l * 2 + 1) * 32 + i) * GW + c];
          float a20 = p.rw_a2[((size_t)(l * 2 + 0) * 32 + i) * GW + c], a21 = p.rw_a2[((size_t)(l * 2 + 1) * 32 + i) * GW + c];
#pragma unroll
          for (int r = 0; r < 8; ++r) {
            float tw = zs[r * RWSH + 3 * GW + i], al = zs[r * RWSH + 3 * GW + 32 + i];
            wa0[r] = fmaf(tw, w20, wa0[r]); wa1[r] = fmaf(tw, w21, wa1[r]);
            aa0[r] = fmaf(al, a20, aa0[r]); aa1[r] = fmaf(al, a21, aa1[r]);
          }
        }
#pragma unroll 16
        for (int j = 0; j < 64; ++j) {
          float g2 = p.rw_g2[((size_t)l * 64 + j) * GW + c];
#pragma unroll
          for (int r = 0; r < 8; ++r) gg[r] = fmaf(zs[r * RWSH + 3 * GW + 64 + j], g2, gg[r]);
        }
        const float ka = p.rw_ka[l * GW + c], kks = p.rw_kk[l * GW + c];
        const float w00 = p.rw_w0[(l * 2 + 0) * GW + c], w01 = p.rw_w0[(l * 2 + 1) * GW + c];
        const float a00 = p.rw_a0[(l * 2 + 0) * GW + c], a01 = p.rw_a0[(l * 2 + 1) * GW + c];
#pragma unroll
        for (int r = 0; r < 8; ++r) {
          const int pr = r * NH + h;
          float ss = 0.f, bs = 0.f;
#pragma unroll
          for (int u = 0; u < 8; ++u) { ss += part[pr * 8 + u]; bs += part[256 + pr * 8 + u]; }
          const float rr = zs[r * RWSH + c], k = zs[r * RWSH + GW + c], v = zs[r * RWSH + 2 * GW + c];
          const float kkv = k * kks / sqrtf(ss + 1e-12f);
          const size_t o = (size_t)(row0 + r) * GW + c;
          p.RW[0 * AS + o] = rr;
          p.RW[1 * AS + o] = kkv;
          p.BON[o] = bs * v;
          p.GG[o] = gg[r];
#pragma unroll
          for (int d = 0; d < 2; ++d) {
            float wpre = (d ? w01 : w00) + (d ? wa1[r] : wa0[r]);
            float decay = expf(-expf(-softplusf_(-wpre) - 0.5f));
            float a = sigmoidf_((d ? a01 : a00) + (d ? aa1[r] : aa0[r]));
            p.RW[(2 + d) * AS + o] = decay;
            p.RW[(4 + d) * AS + o] = k * (1.0f + (a - 1.0f) * ka);
            p.RW[(6 + d) * AS + o] = kkv * a;
          }
        }
      }
    }
    __syncthreads();
  }
#if SB == 8
#else
  for (int it = gtid; it < hyena_items(l); it += gsize) hyena_conv_item<0>(p, l, it);
#endif
}

__device__ __forceinline__ int scan_pos(int dir, int step) {
  if (!dir) return step;
  return step < CTX ? CTX - 1 - step : RPB - 1 - (step - CTX);
}
#ifndef CPU_EMU
__device__ __forceinline__ float quad_sum(float v) {
  v += __int_as_float(__builtin_amdgcn_mov_dpp(__float_as_int(v), 0xB1, 0xF, 0xF, true));
  v += __int_as_float(__builtin_amdgcn_mov_dpp(__float_as_int(v), 0x4E, 0xF, 0xF, true));
  return v;
}
__device__ __forceinline__ float oct_sum(float v) {
  v = quad_sum(v);
  v += __int_as_float(__builtin_amdgcn_mov_dpp(__float_as_int(v), 0x141, 0xF, 0xF, true));
  return v;
}
#endif
#define SCT 16
#define NCHUNK (RPB / SCT)
__device__ __forceinline__ void bscan_rwkv(const P& p, int l, int bl, int h, int dir, int half, float* lds, int tid) {
  const int i = half * 32 + (tid >> 3), kq = tid & 7, st = tid >> 4, sp = tid & 15;
  float S[8];
#pragma unroll
  for (int d = 0; d < 8; ++d) S[d] = 0.f;
  float* H = dir ? p.HB : p.HF;
  const size_t AS = (size_t)RS * GW;
  const int vc = 2 * GW + h * HD + sp * 4;
  const f4 mu0 = ld4(p.rw_mu + (size_t)(l * 2 + 0) * RWSH + vc), mu1 = ld4(p.rw_mu + (size_t)(l * 2 + 1) * RWSH + vc);
  f4 rg[5], rv;
  auto load = [&](int c) {
    const int pp = scan_pos(dir, c * SCT + st), row = bl * RPB + pp;
    const size_t o = (size_t)row * GW + h * HD + sp * 4;
    rg[0] = ld4(p.RW + 0 * AS + o);
    rg[1] = ld4(p.RW + 1 * AS + o);
    rg[2] = ld4(p.RW + (size_t)(2 + dir) * AS + o);
    rg[3] = ld4(p.RW + (size_t)(4 + dir) * AS + o);
    rg[4] = ld4(p.RW + (size_t)(6 + dir) * AS + o);
    const bf16_t* pr = p.PROJ + (size_t)row * LDP + OFF_RW + vc;
    f4 x = ldbf4(pr), xm = x, xp = x;
    xm.x = xm.y = xm.z = xm.w = 0.f; xp = xm;
    if (has_prev(pp)) xm = ldbf4(pr - LDP);
    if (has_next(pp)) xp = ldbf4(pr + LDP);
    rv.x = x.x + mu0.x * (xm.x - x.x) + mu1.x * (xp.x - x.x);
    rv.y = x.y + mu0.y * (xm.y - x.y) + mu1.y * (xp.y - x.y);
    rv.z = x.z + mu0.z * (xm.z - x.z) + mu1.z * (xp.z - x.z);
    rv.w = x.w + mu0.w * (xm.w - x.w) + mu1.w * (xp.w - x.w);
  };
  load(0);
  for (int c = 0; c < NCHUNK; ++c) {
    __syncthreads();
#pragma unroll
    for (int a = 0; a < 5; ++a) st4(lds + (st * 6 + a) * 64 + sp * 4, rg[a]);
    st4(lds + (st * 6 + 5) * 64 + sp * 4, rv);
    __syncthreads();
    if (c + 1 < NCHUNK) load(c + 1);
    struct RwOps { float r[8], k[8], w[8], d[8], b[8], vv; };
    auto ldstep = [&](RwOps& o, int t) {
      const float* L = lds + t * 6 * 64 + kq * 8;
      o.vv = lds[(t * 6 + 5) * 64 + i];
      ld8(o.k, L + 1 * 64);
      ld8(o.w, L + 2 * 64);
      ld8(o.d, L + 3 * 64);
      ld8(o.b, L + 4 * 64);
      ld8(o.r, L + 0 * 64);
    };
    auto step = [&](const RwOps& o, int t) {
      float sa4[4] = {0.f, 0.f, 0.f, 0.f};
#pragma unroll
      for (int d = 0; d < 8; ++d) sa4[d & 3] = fmaf(S[d], o.k[d], sa4[d & 3]);
      const float sa = -oct_sum((sa4[0] + sa4[1]) + (sa4[2] + sa4[3]));
      float y4[4] = {0.f, 0.f, 0.f, 0.f};
#pragma unroll
      for (int d = 0; d < 8; ++d) {
        S[d] = fmaf(S[d], o.w[d], fmaf(sa, o.b[d], o.vv * o.d[d]));
        y4[d & 3] = fmaf(S[d], o.r[d], y4[d & 3]);
      }
      const float y = oct_sum((y4[0] + y4[1]) + (y4[2] + y4[3]));
      if (kq == 0) {
        const int row = bl * RPB + scan_pos(dir, c * SCT + t);
        H[(size_t)row * 3 * GW + 2 * GW + h * HD + i] = y;
      }
    };
    RwOps oa, ob;
    ldstep(oa, 0);
#pragma nounroll
    for (int t = 0; t < SCT; t += 2) {
      ldstep(ob, t + 1);
      step(oa, t);
      if (t + 2 < SCT) ldstep(oa, t + 2);
      step(ob, t + 1);
    }
  }
}
__device__ __forceinline__ void bscan_mlstm(const P& p, int bl, int h, int dir, int half, float* lds, int tid) {
  const int i = half * 32 + (tid >> 3), kq = tid & 7, st = tid >> 4, sp = tid & 15;
  float C[8], n[8];
#pragma unroll
  for (int d = 0; d < 8; ++d) { C[d] = 0.f; n[d] = 0.f; }
  float m = 0.f;
  float* H = dir ? p.HB : p.HF;
  f4 rq, rk, rv;
  float g0 = 0.f, g1 = 0.f;
  auto load = [&](int c) {
    const int pp = scan_pos(dir, c * SCT + st), row = bl * RPB + pp;
    const float* q = p.MQK + (size_t)row * 2 * GW + h * HD + sp * 4;
    rq = ld4(q);
    rk = ld4(q + GW);
    rv = ldbf4(p.PROJ + (size_t)row * LDP + OFF_ML + 2 * GW + h * HD + sp * 4);
    if (sp == 0) {
      const float* mg = p.MG + (size_t)row * 4 * NH;
      g0 = mg[(dir ? 2 : 0) * NH + h];
      g1 = mg[(dir ? 3 : 1) * NH + h];
    }
  };
  load(0);
  for (int c = 0; c < NCHUNK; ++c) {
    __syncthreads();
    st4(lds + (st * 4 + 0) * 64 + sp * 4, rq);
    st4(lds + (st * 4 + 1) * 64 + sp * 4, rk);
    st4(lds + (st * 4 + 2) * 64 + sp * 4, rv);
    if (sp == 0) { lds[(st * 4 + 3) * 64 + 0] = g0; lds[(st * 4 + 3) * 64 + 1] = g1; }
    __syncthreads();
    if (c + 1 < NCHUNK) load(c + 1);
    struct MlOps { float q[8], k[8], ig, lf, v; };
    auto ldstep = [&](MlOps& o, int t) {
      const float* L = lds + t * 4 * 64;
      o.ig = L[3 * 64 + 0]; o.lf = L[3 * 64 + 1]; o.v = L[2 * 64 + i];
      ld8(o.q, L + kq * 8);
      ld8(o.k, L + 64 + kq * 8);
    };
    auto step = [&](const MlOps& o, int t) {
      const float mn = fmaxf(o.lf + m, o.ig);
      const float f = fexp_(o.lf + m - mn), ii = fexp_(o.ig - mn), em = fexp_(-mn);
      m = mn;
      const float iv = ii * o.v;
      float num4[4] = {0.f, 0.f, 0.f, 0.f}, den4[4] = {0.f, 0.f, 0.f, 0.f};
#pragma unroll
      for (int d = 0; d < 8; ++d) {
        const float kd = o.k[d], qd = o.q[d];
        C[d] = fmaf(kd, iv, f * C[d]);
        n[d] = fmaf(kd, ii, f * n[d]);
        num4[d & 3] = fmaf(qd, C[d], num4[d & 3]);
        den4[d & 3] = fmaf(qd, n[d], den4[d & 3]);
      }
      const float num = oct_sum((num4[0] + num4[1]) + (num4[2] + num4[3]));
      const float den = oct_sum((den4[0] + den4[1]) + (den4[2] + den4[3]));
      if (kq == 0) {
        const int row = bl * RPB + scan_pos(dir, c * SCT + t);
        H[(size_t)row * 3 * GW + 0 * GW + h * HD + i] = num * frcp_(fmaxf(fabsf(den), em));
      }
    };
    MlOps oa, ob;
    ldstep(oa, 0);
#pragma nounroll
    for (int t = 0; t < SCT; t += 2) {
      ldstep(ob, t + 1);
      step(oa, t);
      if (t + 2 < SCT) ldstep(oa, t + 2);
      step(ob, t + 1);
    }
  }
}
__device__ __forceinline__ void bscan_ret(const P& p, int bl, int h, int dir, int half, float* lds, int tid) {
  const int i = half * 32 + (tid >> 3), kq = tid & 7, st = tid >> 4, sp = tid & 15;
  float S[8];
#pragma unroll
  for (int d = 0; d < 8; ++d) S[d] = 0.f;
  const int hh = dir ? NH - 1 - h : h;
  const float gamma = 1.0f - exp2f(-5.0f - (float)hh);
  float* H = dir ? p.HB : p.HF;
  f4 rq, rk, rv;
  auto load = [&](int c) {
    const int pp = scan_pos(dir, c * SCT + st), row = bl * RPB + pp;
    const float* q = p.RQK + (size_t)row * 2 * GW + h * HD + sp * 4;
    rq = ld4(q);
    rk = ld4(q + GW);
    rv = ldbf4(p.PROJ + (size_t)row * LDP + OFF_RT + 2 * GW + h * HD + sp * 4);
  };
  load(0);
  for (int c = 0; c < NCHUNK; ++c) {
    __syncthreads();
    st4(lds + (st * 4 + 0) * 64 + sp * 4, rq);
    st4(lds + (st * 4 + 1) * 64 + sp * 4, rk);
    st4(lds + (st * 4 + 2) * 64 + sp * 4, rv);
    __syncthreads();
    if (c + 1 < NCHUNK) load(c + 1);
    struct RtOps { float q[8], k[8], v; };
    auto ldstep = [&](RtOps& o, int t) {
      const float* L = lds + t * 4 * 64;
      o.v = L[2 * 64 + i];
      ld8(o.q, L + kq * 8);
      ld8(o.k, L + 64 + kq * 8);
    };
    auto step = [&](const RtOps& o, int t) {
      float o4[4] = {0.f, 0.f, 0.f, 0.f};
#pragma unroll
      for (int d = 0; d < 8; ++d) {
        S[d] = fmaf(S[d], gamma, o.k[d] * o.v);
        o4[d & 3] = fmaf(o.q[d], S[d], o4[d & 3]);
      }
      const float ov = oct_sum((o4[0] + o4[1]) + (o4[2] + o4[3]));
      if (kq == 0) {
        const int row = bl * RPB + scan_pos(dir, c * SCT + t);
        H[(size_t)row * 3 * GW + 1 * GW + h * HD + i] = ov;
      }
    };
    RtOps oa, ob;
    ldstep(oa, 0);
#pragma nounroll
    for (int t = 0; t < SCT; t += 2) {
      ldstep(ob, t + 1);
      step(oa, t);
      if (t + 2 < SCT) ldstep(oa, t + 2);
      step(ob, t + 1);
    }
  }
}
#define NSCAN (3 * SB * NH * 2 * 2)
__device__ __forceinline__ void ph_scan(const P& p, int l, int s, int gtid, int gsize, float* lds, int tid) {
  for (int w = blockIdx.x; w < NSCAN; w += gridDim.x) {
    int mixer = w / (SB * NH * 4), r = w % (SB * NH * 4);
    int half = r & 1, dir = (r >> 1) & 1, h = (r >> 2) % NH, bl = (r >> 2) / NH;
    if (mixer == 0) bscan_rwkv(p, l, bl, h, dir, half, lds, tid);
    else if (mixer == 1) bscan_mlstm(p, bl, h, dir, half, lds, tid);
    else bscan_ret(p, bl, h, dir, half, lds, tid);
    __syncthreads();
  }
#if SB == 8
  {
    int* sh = (int*)lds;
    const int nitem = hyena_mfma_items(l);
    for (;;) {
      __syncthreads();
      if (tid == 0) sh[0] = atomicAdd(p.ctr, 1);
      __syncthreads();
      const int it = sh[0];
      if (it >= nitem) break;
      hyena_mfma_item<0>(p, l, it, (bf16_t*)lds, tid);
      __threadfence();
      hyena_mfma_item<1>(p, l, it, (bf16_t*)lds, tid);
    }
  }
#else
  for (int it = gtid; it < hyena_items(l); it += gsize) hyena_conv_item<1>(p, l, it);
#endif
}

#define NE (HD / WL)
__device__ __forceinline__ void ph_fin(const P& p, int l, int s, int gtid, int gsize) {
  const bool last = (l == DEPTH - 1);
  const int lane = gtid % WL, gw = gtid / WL, nw = gsize / WL;
  for (int item = gw; item < (RS / 4) * 4 * NH; item += nw) {
    const int hg = item % (4 * NH), row0 = (item / (4 * NH)) * 4, pp0 = row0 % RPB;
    if (last && pp0 < CTX) continue;
    const int g = hg / NH, h = hg % NH;
    const int c0 = g * GW + h * HD;
    float val[4][NE];
#pragma unroll
    for (int r = 0; r < 4; ++r) {
      const int row = row0 + r;
#pragma unroll
      for (int e = 0; e < NE; ++e) {
        const int i = e * WL + lane;
        float v;
        if (g == 1) v = p.HY[(size_t)row * GW + h * HD + i];
        else {
          const int slot = (g == 0) ? 0 : (g == 2 ? 1 : 2);
          const size_t o = (size_t)row * 3 * GW + slot * GW + h * HD + i;
          v = p.HF[o] + p.HB[o];
        }
        val[r][e] = v;
      }
    }
    float mu[4], rs[4];
#pragma unroll
    for (int r = 0; r < 4; ++r) {
      float sm = 0.f;
#pragma unroll
      for (int e = 0; e < NE; ++e) sm += val[r][e];
      mu[r] = wave_sum(sm) * (1.0f / HD);
    }
#pragma unroll
    for (int r = 0; r < 4; ++r) {
      float q = 0.f;
#pragma unroll
      for (int e = 0; e < NE; ++e) { float d = val[r][e] - mu[r]; q += d * d; }
      rs[r] = 1.0f / sqrtf(wave_sum(q) * (1.0f / HD) + 1e-5f);
    }
#pragma unroll
    for (int r = 0; r < 4; ++r) {
      const int row = row0 + r;
#pragma unroll
      for (int e = 0; e < NE; ++e) {
        const int i = e * WL + lane;
        float v = (val[r][e] - mu[r]) * rs[r] * p.ng[l * DM + c0 + i] + p.nb[l * DM + c0 + i];
        if (g == 0) v *= sigmoidf_(PJ(row, OFF_ML + 3 * GW + h * HD + i));
        else if (g == 2) v *= siluf_(PJ(row, OFF_RT + 3 * GW + h * HD + i));
        else if (g == 3) v = p.GG[(size_t)row * GW + h * HD + i] * (v + p.BON[(size_t)row * GW + h * HD + i]);
        p.U[(size_t)row * DM + c0 + i] = f2bf(v);
      }
    }
  }
}

__device__ __forceinline__ void ph_act(const P& p, int l, int s, int gtid, int gsize) {
  const bool last = (l == DEPTH - 1);
  const float* cw = p.f_cw + (size_t)l * 3 * DFF;
  const float* cb = p.f_cb + (size_t)l * DFF;
#pragma unroll 2
  for (int it = gtid; it < RS * (DFF / 8); it += gsize) {
    const int j = (it % (DFF / 8)) * 8, row = it / (DFF / 8), pp = row % RPB;
    if (last && pp < CTX) continue;
    const bf16_t* hr = p.HFF + (size_t)row * 2 * DFF;
    const bf16_t* hm = row > 0 ? hr - 2 * DFF : hr;
    const bf16_t* hp = row < RS - 1 ? hr + 2 * DFF : hr;
    const unsigned mprev = has_prev(pp) ? 0xffffffffu : 0u, mnext = has_next(pp) ? 0xffffffffu : 0u;
    const u4 qa = ldu4(hr + j), qb = ldu4(hr + DFF + j), qm = ldu4(hm + j), qp = ldu4(hp + j);
    const unsigned a0[4] = {qa.x, qa.y, qa.z, qa.w}, bv[4] = {qb.x, qb.y, qb.z, qb.w};
    const unsigned am[4] = {qm.x & mprev, qm.y & mprev, qm.z & mprev, qm.w & mprev}, ap[4] = {qp.x & mnext, qp.y & mnext, qp.z & mnext, qp.w & mnext};
    float w0[8], w1[8], w2[8], wb[8];
    ld8(w0, cw + j); ld8(w1, cw + DFF + j); ld8(w2, cw + 2 * DFF + j); ld8(wb, cb + j);
    unsigned ov[4];
#pragma unroll
    for (int e = 0; e < 4; ++e) {
      float o[2];
#pragma unroll
      for (int hh = 0; hh < 2; ++hh) {
        const int jj = 2 * e + hh;
        float xm = bf2f((bf16_t)(am[e] >> (16 * hh))), x0 = bf2f((bf16_t)(a0[e] >> (16 * hh))), xp = bf2f((bf16_t)(ap[e] >> (16 * hh)));
        float v = w0[jj] * xm + w1[jj] * x0 + w2[jj] * xp + wb[jj];
        o[hh] = siluf_(v) * bf2f((bf16_t)(bv[e] >> (16 * hh)));
      }
      ov[e] = pack_bf16(o[0], o[1]);
    }
    u4 qo; qo.x = ov[0]; qo.y = ov[1]; qo.z = ov[2]; qo.w = ov[3];
    stu4(p.ACT + (size_t)row * DFF + j, qo);
  }
}

enum { PH_PRO_A = 0, PH_PRO_B, PH_PRO_C, PH_LN0, PH_GEMM_IN, PH_PREP, PH_SCAN, PH_FIN, PH_GEMM_OUT, PH_LN1, PH_GEMM_UP, PH_ACT, PH_GEMM_DN, PH_LN2, PH_COUNT };

__device__ __forceinline__ void run_phase(const P& p, int ph, int l, int s, bf16_t* lds) {
  int tid = threadIdx.x;
#ifndef CPU_EMU
  asm volatile("" : "+v"(tid));
#endif
  const int gtid = blockIdx.x * blockDim.x + tid;
  const int gsize = gridDim.x * blockDim.x;
  const bool last = (l == DEPTH - 1);
  switch (ph) {
    case PH_PRO_A: ph_pro_a(p, gtid, gsize); break;
    case PH_PRO_B: ph_pro_b(p, gtid, gsize); break;
    case PH_PRO_C: ph_pro_c(p, gtid, gsize); break;
    case PH_LN0: ph_ln0(p, l, s, gtid, gsize); break;
    case PH_GEMM_IN: gemm_phase<true>(p.U, p.wt_in + (size_t)l * LDP * DM, p.PROJ, RS, LDP, DM, LDP, false, lds, tid); break;
    case PH_PREP: ph_prep(p, l, s, gtid, gsize, (float*)lds, tid); break;
    case PH_SCAN: ph_scan(p, l, s, gtid, gsize, (float*)lds, tid); break;
    case PH_FIN: ph_fin(p, l, s, gtid, gsize); break;
    case PH_GEMM_OUT: gemm_phase<false>(p.U, p.wt_out + (size_t)l * DM * DM, p.OUTF, RS, DM, DM, DM, last, lds, tid); break;
    case PH_LN1: ph_ln1(p, l, s, gtid, gsize); break;
    case PH_GEMM_UP: gemm_phase<true>(p.U, p.wt_up + (size_t)l * 2 * DFF * DM, p.HFF, RS, 2 * DFF, DM, 2 * DFF, last, lds, tid); break;
    case PH_ACT: ph_act(p, l, s, gtid, gsize); break;
    case PH_GEMM_DN: gemm_phase<false>(p.ACT, p.wt_dn + (size_t)l * DM * DFF, p.OUTF, RS, DM, DFF, DM, last, lds, tid); break;
    case PH_LN2: ph_ln2(p, l, s, gtid, gsize); break;
  }
}

#ifndef CPU_EMU
#define XB_TMO      128
#define XB_XCNT(j)  (256  + 64 * (j))
#define XB_XSUB(j)  (1280 + 64 * (j))
#define XB_XGEN(j)  (2304 + 64 * (j))
#define XB_TOP      3328
#define XB_TOPGEN   3392
#define XCD_BAR_WORDS 3456
#define XB_SPIN_CAP (1u << 22)
#define LAS __attribute__((address_space(3)))

__device__ __forceinline__ unsigned xb_ld(unsigned* p)              { return __hip_atomic_load(p, __ATOMIC_RELAXED, __HIP_MEMORY_SCOPE_AGENT); }
__device__ __forceinline__ unsigned xb_add(unsigned* p, unsigned v) { return __hip_atomic_fetch_add(p, v, __ATOMIC_RELAXED, __HIP_MEMORY_SCOPE_AGENT); }
__device__ __forceinline__ unsigned xb_xcc_id() { return (unsigned)__builtin_amdgcn_s_getreg((3 << 11) | 20) & 0xFu; }
#define XB_SPIN(cond, bar) do { unsigned _sp = 0; while (cond) { __builtin_amdgcn_s_sleep(1); \
    if ((++_sp & 255u) == 0u) { if (xb_ld(&(bar)[XB_TMO])) break; if (_sp > XB_SPIN_CAP) { atomicAdd(&(bar)[XB_TMO], 1u); break; } } } } while (0)

struct XcdBarrier {
    unsigned* bar; unsigned x;
    volatile LAS unsigned* st;
};

__device__ __forceinline__ XcdBarrier xcd_barrier_post(unsigned* bar, volatile LAS unsigned* st) {
    XcdBarrier b; b.bar = bar; b.x = xb_xcc_id(); b.st = st;
    if (threadIdx.x == 0) (void)xb_add(&bar[XB_XCNT(b.x)], 1u);
    return b;
}
__device__ __forceinline__ void xcd_barrier_complete(unsigned* bar, unsigned x, unsigned& nloc, unsigned& nx) {
    const unsigned G = gridDim.x * gridDim.y * gridDim.z;
    unsigned sum, cnt, mine, sp = 0u;
    for (;;) {
        sum = 0u; cnt = 0u; mine = 0u;
#pragma unroll
        for (unsigned j = 0; j < 16; ++j) { const unsigned c = xb_ld(&bar[XB_XCNT(j)]); sum += c; cnt += (c > 0u) ? 1u : 0u; mine = (j == x) ? c : mine; }
        if (sum == G) break;
        __builtin_amdgcn_s_sleep(1);
        if ((++sp & 255u) == 0u) { if (xb_ld(&bar[XB_TMO])) break; if (sp > XB_SPIN_CAP) { atomicAdd(&bar[XB_TMO], 1u); break; } }
    }
    nloc = mine > 0u ? mine : 1u; nx = cnt > 0u ? cnt : 1u;
}

__device__ __forceinline__ void xcd_barrier(const XcdBarrier& b) {
    asm volatile("s_waitcnt vmcnt(0)" ::: "memory");
    __syncthreads();
    if (threadIdx.x == 0) {
        unsigned* bar = b.bar;
        __builtin_amdgcn_s_waitcnt(0);
        unsigned nloc = b.st[0], nx = b.st[1];
        if (nloc == 0u) { xcd_barrier_complete(bar, b.x, nloc, nx); b.st[0] = nloc; b.st[1] = nx; }
        const unsigned old = xb_add(&bar[XB_XSUB(b.x)], 1u);
        const unsigned gen = old / nloc;
        if (old + 1u == (gen + 1u) * nloc) {
            __builtin_amdgcn_fence(__ATOMIC_RELEASE, "agent");
            asm volatile("s_waitcnt vmcnt(0)" ::: "memory");
            const unsigned og = xb_add(&bar[XB_TOP], 1u);
            const unsigned tg = og / nx;
            if (og + 1u == (tg + 1u) * nx) xb_add(&bar[XB_TOPGEN], 1u);
            else XB_SPIN(xb_ld(&bar[XB_TOPGEN]) == tg, bar);
            __builtin_amdgcn_fence(__ATOMIC_ACQUIRE, "agent");
            xb_add(&bar[XB_XGEN(b.x)], 1u);
            asm volatile("s_waitcnt vmcnt(0)" ::: "memory");
        } else {
            XB_SPIN(xb_ld(&bar[XB_XGEN(b.x)]) == gen, bar);
            __builtin_amdgcn_fence(__ATOMIC_ACQUIRE, "agent");
            asm volatile("s_waitcnt vmcnt(0)" ::: "memory");
        }
    }
    __syncthreads();
}

#endif

#ifndef PROBE_MASK
#define PROBE_MASK 0
#endif
#if PROBE_MASK
#define RUNPH(ph) do { int reps_ = 1 + ((PROBE_MASK >> ph) & 1); asm volatile("" : "+s"(reps_)); for (int q_ = 0; q_ < reps_; ++q_) { run_phase(p, ph, l, s, lds); GSYNC(); } } while (0)
#else
#define RUNPH(ph) do { run_phase(p, ph, l, s, lds); GSYNC(); } while (0)
#endif
#ifndef CPU_EMU
__global__ void __launch_bounds__(256, 2) k_mega(P p) {
  __shared__ __attribute__((aligned(16))) bf16_t lds[24576];
  __shared__ uint4 xb_words;
  cg::grid_group grid = cg::this_grid();
  if (threadIdx.x == 0) xb_words = make_uint4(0u, 0u, 0u, 0u);
  __syncthreads();
  XcdBarrier xb = xcd_barrier_post(p.bar, (volatile LAS unsigned*)&xb_words);
#define GSYNC() xcd_barrier(xb)
  run_phase(p, PH_PRO_A, 0, 0, lds);
  grid.sync();
  run_phase(p, PH_PRO_B, 0, 0, lds);
  GSYNC();
  run_phase(p, PH_PRO_C, 0, 0, lds);
  GSYNC();
  for (int l = 0; l < DEPTH; ++l)
    for (int s = 0; s < NSLICE; ++s)
    {
      if (l == 0 && s == 0) RUNPH(PH_LN0);
      RUNPH(PH_GEMM_IN);
      RUNPH(PH_PREP);
      RUNPH(PH_SCAN);
      RUNPH(PH_FIN);
      RUNPH(PH_GEMM_OUT);
      RUNPH(PH_LN1);
      RUNPH(PH_GEMM_UP);
      RUNPH(PH_ACT);
      RUNPH(PH_GEMM_DN);
      {
        run_phase(p, PH_LN2, l, s, lds);
        const int ns = (s + 1 == NSLICE) ? 0 : s + 1, nl = (s + 1 == NSLICE) ? l + 1 : l;
        if (nl < DEPTH) { run_phase(p, PH_LN0, nl, ns, lds); GSYNC(); }
      }
    }
}
#endif

static size_t ws_take(size_t& off, size_t bytes) { size_t o = off; off += (bytes + 255) & ~(size_t)255; return o; }

static void build_params(P& p, void* const* d_in, void* d_out, void* d_ws) {
  const float** f = (const float**)&p;
  for (int i = 0; i < 39; ++i) f[i] = (const float*)d_in[i];
  p.out = (float*)d_out;
  char* w = (char*)d_ws;
  size_t off = 0;
  p.wt_in = (bf16_t*)(w + ws_take(off, (size_t)DEPTH * LDP * DM * 2));
  p.wt_out = (bf16_t*)(w + ws_take(off, (size_t)DEPTH * DM * DM * 2));
  p.wt_up = (bf16_t*)(w + ws_take(off, (size_t)DEPTH * 2 * DFF * DM * 2));
  p.wt_dn = (bf16_t*)(w + ws_take(off, (size_t)DEPTH * DM * DFF * 2));
  p.kf_lat = (float*)(w + ws_take(off, (size_t)DEPTH * 2 * 2 * SEQ * GW * 4));
  p.kf_ctx = (float*)(w + ws_take(off, (size_t)DEPTH * 2 * 2 * CTX * GW * 4));
  p.kt_lat = (bf16_t*)(w + ws_take(off, (size_t)DEPTH * 2 * 2 * SEQ * GW * 2));
  p.kt_ctx = (bf16_t*)(w + ws_take(off, (size_t)DEPTH * 2 * 2 * CTX * GW * 2));
  p.ropec = (float*)(w + ws_take(off, 64 * 16 * 4));
  p.ropes = (float*)(w + ws_take(off, 64 * 16 * 4));
  p.hyh1 = (float*)(w + ws_take(off, (size_t)DEPTH * 2 * SEQ * 64 * 4));
  p.hyh2 = (float*)(w + ws_take(off, (size_t)DEPTH * 2 * SEQ * 64 * 4));
  p.scv = (float*)(w + ws_take(off, (size_t)NMOD * DM * 4));
  p.modtab = (float*)(w + ws_take(off, (size_t)DEPTH * NMOD * 6 * DM * 4));
  p.xc = (float*)(w + ws_take(off, (size_t)NB * CTX * DM * 4));
  p.ctr = (int*)(w + ws_take(off, 256));
  p.bar = (unsigned*)(w + ws_take(off, 16384));
  p.U = (bf16_t*)(w + ws_take(off, (size_t)RS * DM * 2));
  size_t arena = off;
  p.PROJ = (bf16_t*)(w + ws_take(off, (size_t)RS * LDP * 2));
  p.MQK = (float*)(w + ws_take(off, (size_t)RS * 2 * GW * 4));
  p.MG = (float*)(w + ws_take(off, (size_t)RS * 4 * NH * 4));
  p.RQK = (float*)(w + ws_take(off, (size_t)RS * 2 * GW * 4));
  p.RW = (float*)(w + ws_take(off, (size_t)8 * RS * GW * 4));
  p.HF = (float*)(w + ws_take(off, (size_t)RS * 3 * GW * 4));
  p.HB = (float*)(w + ws_take(off, (size_t)RS * 3 * GW * 4));
  p.Z2 = (float*)(w + ws_take(off, (size_t)RS * GW * 4));
  p.HY = (float*)(w + ws_take(off, (size_t)RS * GW * 4));
  p.BON = (float*)(w + ws_take(off, (size_t)RS * GW * 4));
  p.GG = (float*)(w + ws_take(off, (size_t)RS * GW * 4));
  size_t off2 = arena;
  p.OUTF = (float*)(w + ws_take(off2, (size_t)RS * DM * 4));
  p.HFF = (bf16_t*)(w + ws_take(off2, (size_t)RS * 2 * DFF * 2));
  p.ACT = (bf16_t*)(w + ws_take(off2, (size_t)RS * DFF * 2));
}

#ifndef CPU_EMU
extern "C" void kernel_launch(void* const* d_in, const int* in_sizes, int n_in, void* d_out, int out_size, void* d_ws, size_t ws_size,
                              hipStream_t stream) {
  static int grid_blocks = 0;
  if (!grid_blocks) {
    int dev = 0, cus = 0, per_cu = 0;
    hipGetDevice(&dev);
    hipDeviceGetAttribute(&cus, hipDeviceAttributeMultiprocessorCount, dev);
    hipOccupancyMaxActiveBlocksPerMultiprocessor(&per_cu, k_mega, 256, 0);
    if (per_cu < 1) per_cu = 1;
    grid_blocks = cus * per_cu;
  }
  P p;
  memset(&p, 0, sizeof(p));
  build_params(p, d_in, d_out, d_ws);
  hipMemsetAsync(p.bar, 0, XCD_BAR_WORDS * sizeof(unsigned), stream);
  void* args[] = {&p};
  hipError_t e = hipLaunchCooperativeKernel((void*)k_mega, dim3(grid_blocks), dim3(256), args, 0, stream);
  if (e != hipSuccess) fprintf(stderr, "cooperative launch failed: %s (grid %d)\n", hipGetErrorString(e), grid_blocks);
}
#endif
```

```cpp
#ifndef CPU_EMU
#include <hip/hip_runtime.h>
#include <hip/hip_cooperative_groups.h>
#include <cstdio>
#include <cstring>
namespace cg = cooperative_groups;
#endif
#include <stdint.h>
#include <stddef.h>

#if !defined(CFG_SMALL) && !defined(CFG_CONVTEST)
#define DM 1024
#define NB 32
#define SEQ 2048
#define CTX 256
#define DFF 2816
#define SB 8
#elif defined(CFG_CONVTEST)
#define DM 512
#define NB 8
#define SEQ 256
#define CTX 128
#define DFF 192
#define SB 8
#else
#define DM 512
#define NB 2
#define SEQ 256
#define CTX 128
#define DFF 192
#define SB 1
#endif
#define DEPTH 2
#define GRIDW 64
#define HD 64
#define GW (DM / 4)
#define NH (GW / HD)
#define DPROJ (14 * GW + 4 * NH + 128)
#define LDP ((DPROJ + 127) / 128 * 128)
#define OFF_ML 0
#define OFF_HY (4 * GW + 4 * NH)
#define OFF_RT (OFF_HY + 3 * GW)
#define OFF_RW (OFF_RT + 4 * GW)
#define RWSH (3 * GW + 128)
#define RPB (CTX + SEQ)
#define RS (SB * RPB)
#define NSLICE (NB / SB)
#define ALPHA 1.41421356237309515f
#define NMOD 33
#ifdef CPU_EMU
#define WL 1
#else
#define WL 64
#endif

typedef unsigned short bf16_t;

struct P {
  const float *x, *c, *ctx, *c_ctx, *ada_w, *ada_b, *w_in, *ml_cw, *ml_cb, *ml_gb, *hy_cw, *hy_cb, *hy_w1, *hy_b1, *hy_w2, *hy_b2, *hy_w3,
      *hy_freq, *hy_d, *rw_mu, *rw_w0, *rw_w2, *rw_a0, *rw_a2, *rw_g2, *rw_kk, *rw_ka, *rw_rk, *ng, *nb, *w_out, *ln1g, *ln1b, *w_up, *f_cw,
      *f_cb, *w_dn, *ln2g, *ln2b;
  float* out;
  bf16_t *wt_in, *wt_out, *wt_up, *wt_dn;
  float *kf_lat, *kf_ctx, *hyh1, *hyh2, *scv, *modtab, *xc;
  bf16_t *kt_lat, *kt_ctx;
  float *ropec, *ropes;
  bf16_t *U, *PROJ;
  float *MQK, *MG, *RQK, *RW, *HF, *HB, *Z2, *HY, *BON, *GG;
  float* OUTF;
  bf16_t *HFF, *ACT;
  int* ctr;
  unsigned* bar;
};

__device__ __forceinline__ bf16_t f2bf(float f) {
  unsigned u = __float_as_uint(f);
  u += 0x7fffu + ((u >> 16) & 1u);
  return (bf16_t)(u >> 16);
}
#ifndef CPU_EMU
typedef __bf16 bf16v2_t __attribute__((ext_vector_type(2)));
typedef float f32x2_t __attribute__((ext_vector_type(2)));
#endif
__device__ __forceinline__ unsigned pack_bf16(float lo, float hi) {
#ifndef CPU_EMU
  f32x2_t v = {lo, hi};
  bf16v2_t b = __builtin_convertvector(v, bf16v2_t);
  return __builtin_bit_cast(unsigned, b);
#else
  return f2bf(lo) | ((unsigned)f2bf(hi) << 16);
#endif
}
__device__ __forceinline__ float bf2f(bf16_t h) { return __uint_as_float(((unsigned)h) << 16); }
#ifndef CPU_EMU
__device__ __forceinline__ float fexp_(float x) { return __expf(x); }
__device__ __forceinline__ float frcp_(float x) { return __builtin_amdgcn_rcpf(x); }
#else
__device__ __forceinline__ float fexp_(float x) { return expf(x); }
__device__ __forceinline__ float frcp_(float x) { return 1.0f / x; }
#endif
#ifndef CPU_EMU
__device__ __forceinline__ float sigmoidf_(float x) { return frcp_(1.0f + fexp_(-x)); }
__device__ __forceinline__ float siluf_(float x) { return x * frcp_(1.0f + fexp_(-x)); }
__device__ __forceinline__ float softplusf_(float x) { return fmaxf(x, 0.0f) + log1pf(expf(-fabsf(x))); }
__device__ __forceinline__ float tanhf_(float x) { return 1.0f - 2.0f * frcp_(1.0f + fexp_(2.0f * x)); }
#else
__device__ __forceinline__ float sigmoidf_(float x) { return 1.0f / (1.0f + expf(-x)); }
__device__ __forceinline__ float siluf_(float x) { return x / (1.0f + expf(-x)); }
__device__ __forceinline__ float softplusf_(float x) { return fmaxf(x, 0.0f) + log1pf(expf(-fabsf(x))); }
__device__ __forceinline__ float tanhf_(float x) { return tanhf(x); }
#endif
__device__ __forceinline__ float logsigmoidf_(float x) { return -softplusf_(-x); }

__device__ __forceinline__ float wave_sum(float v) {
#ifndef CPU_EMU
  v += __int_as_float(__builtin_amdgcn_mov_dpp(__float_as_int(v), 0xB1, 0xF, 0xF, true));
  v += __int_as_float(__builtin_amdgcn_mov_dpp(__float_as_int(v), 0x4E, 0xF, 0xF, true));
  v += __int_as_float(__builtin_amdgcn_mov_dpp(__float_as_int(v), 0x141, 0xF, 0xF, true));
  v += __int_as_float(__builtin_amdgcn_mov_dpp(__float_as_int(v), 0x140, 0xF, 0xF, true));
  const float r0 = __int_as_float(__builtin_amdgcn_readlane(__float_as_int(v), 0));
  const float r1 = __int_as_float(__builtin_amdgcn_readlane(__float_as_int(v), 16));
  const float r2 = __int_as_float(__builtin_amdgcn_readlane(__float_as_int(v), 32));
  const float r3 = __int_as_float(__builtin_amdgcn_readlane(__float_as_int(v), 48));
  v = (r0 + r1) + (r2 + r3);
#endif
  return v;
}

#ifndef CPU_EMU
typedef float f4 __attribute__((ext_vector_type(4)));
typedef unsigned u2v __attribute__((ext_vector_type(2)));
__device__ __forceinline__ f4 ld4(const float* a) { return *(const f4*)a; }
__device__ __forceinline__ void st4(float* a, f4 v) { *(f4*)a = v; }
__device__ __forceinline__ f4 ldbf4(const bf16_t* a) {
  u2v u = *(const u2v*)a;
  f4 r;
  r.x = __uint_as_float(u.x << 16); r.y = __uint_as_float(u.x & 0xffff0000u);
  r.z = __uint_as_float(u.y << 16); r.w = __uint_as_float(u.y & 0xffff0000u);
  return r;
}
#else
struct f4 { float x, y, z, w; };
__device__ __forceinline__ f4 ld4(const float* a) { f4 r; r.x = a[0]; r.y = a[1]; r.z = a[2]; r.w = a[3]; return r; }
__device__ __forceinline__ void st4(float* a, f4 v) { a[0] = v.x; a[1] = v.y; a[2] = v.z; a[3] = v.w; }
__device__ __forceinline__ f4 ldbf4(const bf16_t* a) { f4 r; r.x = bf2f(a[0]); r.y = bf2f(a[1]); r.z = bf2f(a[2]); r.w = bf2f(a[3]); return r; }
#endif
#ifndef CPU_EMU
typedef unsigned u4 __attribute__((ext_vector_type(4)));
__device__ __forceinline__ u4 ldu4(const bf16_t* a) { return *(const u4*)a; }
__device__ __forceinline__ void stu4(bf16_t* a, u4 v) { *(u4*)a = v; }
#else
struct u4 { unsigned x, y, z, w; };
__device__ __forceinline__ u4 ldu4(const bf16_t* a) { u4 r; const unsigned* q = (const unsigned*)a; r.x = q[0]; r.y = q[1]; r.z = q[2]; r.w = q[3]; return r; }
__device__ __forceinline__ void stu4(bf16_t* a, u4 v) { unsigned* q = (unsigned*)a; q[0] = v.x; q[1] = v.y; q[2] = v.z; q[3] = v.w; }
#endif
__device__ __forceinline__ void ld8(float* dst, const float* src) {
#pragma unroll
  for (int j = 0; j < 2; ++j) { f4 v = ld4(src + 4 * j); dst[4 * j] = v.x; dst[4 * j + 1] = v.y; dst[4 * j + 2] = v.z; dst[4 * j + 3] = v.w; }
}
__device__ __forceinline__ void ld16(float* dst, const float* src) {
#pragma unroll
  for (int j = 0; j < 4; ++j) { f4 v = ld4(src + 4 * j); dst[4 * j] = v.x; dst[4 * j + 1] = v.y; dst[4 * j + 2] = v.z; dst[4 * j + 3] = v.w; }
}


__device__ __forceinline__ const float* xsrc_row(const P& p, int l, int b, int pp) {
  if (pp < CTX) return (l == 0 ? p.ctx : p.xc) + ((size_t)b * CTX + pp) * DM;
  return (l == 0 ? p.x : p.out) + ((size_t)b * SEQ + (pp - CTX)) * DM;
}
__device__ __forceinline__ float* xdst_row(const P& p, int b, int pp) {
  if (pp < CTX) return p.xc + ((size_t)b * CTX + pp) * DM;
  return p.out + ((size_t)b * SEQ + (pp - CTX)) * DM;
}
__device__ __forceinline__ bool has_prev(int pp) { return pp != 0 && pp != CTX; }
__device__ __forceinline__ bool has_next(int pp) { return pp != CTX - 1 && pp != RPB - 1; }

__device__ __forceinline__ void cvt_weight(const float* W, bf16_t* Wt, int K, int N, int Npad, int gtid, int gsize) {
  const int nk8 = K / 8;
  for (long it = gtid; it < (long)nk8 * Npad; it += gsize) {
    int n = (int)(it % Npad), k8 = (int)(it / Npad);
    bf16_t v[8];
#pragma unroll
    for (int j = 0; j < 8; ++j) v[j] = (n < N) ? f2bf(W[(size_t)(k8 * 8 + j) * N + n]) : (bf16_t)0;
    uint4 o;
    o.x = v[0] | ((unsigned)v[1] << 16); o.y = v[2] | ((unsigned)v[3] << 16);
    o.z = v[4] | ((unsigned)v[5] << 16); o.w = v[6] | ((unsigned)v[7] << 16);
    *(uint4*)(Wt + (size_t)n * K + k8 * 8) = o;
  }
}
__device__ __forceinline__ void hy_feat_h1(const P& p, int gtid, int gsize) {
  const int per_l = (SEQ + CTX) * 64;
  for (int it = gtid; it < DEPTH * per_l; it += gsize) {
    int l = it / per_l, r = it % per_l;
    int i, L, seg;
    int j = r % 64; r /= 64;
    if (r < SEQ) { seg = 0; i = r; L = SEQ; } else { seg = 1; i = r - SEQ; L = CTX; }
    const float* w1 = p.hy_w1 + (size_t)l * 33 * 64;
    float t = (float)i / (float)(L - 1);
    float ang = 6.283185307179586f * (float)i / (float)L;
    float acc = t * w1[j];
    for (int b = 0; b < 16; ++b) {
      float band = 1e-4f + (float)b * ((15.0f - 1e-4f) / 15.0f);
      float a = band * ang;
      acc += cosf(a) * w1[(1 + b) * 64 + j];
      acc -= sinf(a) * w1[(17 + b) * 64 + j];
    }
    float h = sinf(p.hy_freq[l * 64 + j] * (acc + p.hy_b1[l * 64 + j]));
    p.hyh1[((size_t)(l * 2 + seg) * SEQ + i) * 64 + j] = h;
  }
}
__device__ __forceinline__ void ph_pro_a(const P& p, int gtid, int gsize) {
  for (int l = 0; l < DEPTH; ++l) {
    cvt_weight(p.w_in + (size_t)l * DM * DPROJ, p.wt_in + (size_t)l * LDP * DM, DM, DPROJ, LDP, gtid, gsize);
    cvt_weight(p.w_out + (size_t)l * DM * DM, p.wt_out + (size_t)l * DM * DM, DM, DM, DM, gtid, gsize);
    cvt_weight(p.w_up + (size_t)l * DM * 2 * DFF, p.wt_up + (size_t)l * 2 * DFF * DM, DM, 2 * DFF, 2 * DFF, gtid, gsize);
    cvt_weight(p.w_dn + (size_t)l * DFF * DM, p.wt_dn + (size_t)l * DM * DFF, DFF, DM, DM, gtid, gsize);
  }
  for (int it = gtid; it < NMOD * DM; it += gsize) {
    int r = it / DM, k = it % DM;
    float v = (r < NB) ? p.c[(size_t)r * DM + k] : p.c_ctx[k];
    p.scv[it] = siluf_(v);
  }
  hy_feat_h1(p, gtid, gsize);
  for (int it = gtid; it < 64 * 16; it += gsize) {
    float a = (float)(it / 16) * powf(10000.0f, -(float)(it % 16) / 16.0f);
    p.ropec[it] = cosf(a);
    p.ropes[it] = sinf(a);
  }
}
__device__ __forceinline__ void ph_pro_b(const P& p, int gtid, int gsize) {
  for (int it = gtid; it < DEPTH * NMOD * 6 * DM; it += gsize) {
    int j = it % (6 * DM), r = (it / (6 * DM)) % NMOD, l = it / (6 * DM * NMOD);
    const float* w = p.ada_w + (size_t)l * DM * 6 * DM + j;
    const float* sv = p.scv + r * DM;
    float acc = 0.f;
    for (int k = 0; k < DM; ++k) acc += sv[k] * w[(size_t)k * 6 * DM];
    p.modtab[it] = acc + p.ada_b[l * 6 * DM + j];
  }
  const int per_l = (SEQ + CTX) * 64;
  for (int it = gtid; it < DEPTH * per_l; it += gsize) {
    int l = it / per_l, r = it % per_l;
    int j = r % 64; r /= 64;
    int seg = r < SEQ ? 0 : 1, i = r < SEQ ? r : r - SEQ;
    const float* h1 = p.hyh1 + ((size_t)(l * 2 + seg) * SEQ + i) * 64;
    const float* w2 = p.hy_w2 + (size_t)l * 64 * 64;
    float acc = 0.f;
    for (int k = 0; k < 64; ++k) acc += h1[k] * w2[k * 64 + j];
    p.hyh2[((size_t)(l * 2 + seg) * SEQ + i) * 64 + j] = sinf(p.hy_freq[l * 64 + j] * (acc + p.hy_b2[l * 64 + j]));
  }
}
__device__ __forceinline__ void ph_pro_c(const P& p, int gtid, int gsize) {
  const int per_l = 2 * (2 * SEQ + 2 * CTX) * GW;
  const float max_decay = -4.605170185988091f / 0.3f, min_decay = -4.605170185988091f / 1.5f;
  for (int it = gtid; it < DEPTH * per_l; it += gsize) {
    int l = it / per_l, r = it % per_l;
    int c = r % GW; r /= GW;
    int ord = r & 1; r >>= 1;
    int seg, idx, L;
    if (r < 2 * SEQ) { seg = 0; idx = r; L = SEQ; } else { seg = 1; idx = r - 2 * SEQ; L = CTX; }
    int d = idx - L;
    float val = 0.f;
    if (idx != 0) {
      int i = d < 0 ? -d : d;
      float ti = (float)i / (float)(L - 1);
      float delta = fabsf(min_decay + (float)c * ((max_decay - min_decay) / (float)(GW - 1)));
      float win = expf(-ti * delta);
      const float* h2 = p.hyh2 + ((size_t)(l * 2 + seg) * SEQ + i) * 64;
      const float* w3 = p.hy_w3 + (size_t)l * 64 * 4 * GW;
      float af = 0.f, ab = 0.f;
      for (int k = 0; k < 64; ++k) {
        float hv = h2[k];
        af += hv * w3[k * 4 * GW + 0 * 2 * GW + ord * GW + c];
        ab += hv * w3[k * 4 * GW + 1 * 2 * GW + ord * GW + c];
      }
      if (d > 0) val = af * win;
      else if (d < 0) val = ab * win;
      else val = (af + ab) * win + p.hy_d[(l * 2 + ord) * GW + c];
    }
    float* kf = seg == 0 ? p.kf_lat + ((size_t)(l * 2 + ord) * 2 * SEQ + idx) * GW : p.kf_ctx + ((size_t)(l * 2 + ord) * 2 * CTX + idx) * GW;
    kf[c] = val;
    if (seg == 0) p.kt_lat[((size_t)(l * 2 + ord) * GW + c) * 2 * SEQ + idx] = f2bf(val);
    else p.kt_ctx[((size_t)(l * 2 + ord) * GW + c) * 2 * CTX + idx] = f2bf(val);
  }
}

#define NV (DM / WL)
__device__ __forceinline__ void ln_inplace(float* v, int lane) {
  float s = 0.f;
#pragma unroll
  for (int i = 0; i < NV; ++i) s += v[i];
  s = wave_sum(s);
  float mu = s * (1.0f / DM);
  float q = 0.f;
#pragma unroll
  for (int i = 0; i < NV; ++i) { float d = v[i] - mu; q += d * d; }
  q = wave_sum(q);
  float rs = 1.0f / sqrtf(q * (1.0f / DM) + 1e-5f);
#pragma unroll
  for (int i = 0; i < NV; ++i) v[i] = (v[i] - mu) * rs;
}
__device__ __forceinline__ void ph_ln0(const P& p, int l, int s, int gtid, int gsize) {
  const int lane = gtid % WL, gw = gtid / WL, nw = gsize / WL;
  if (gtid == 0) *p.ctr = 0;
  for (int row = gw; row < RS; row += nw) {
    int bl = row / RPB, pp = row % RPB, b = s * SB + bl;
    const float* xr = xsrc_row(p, l, b, pp);
    const float* mod = p.modtab + ((size_t)l * NMOD + (pp < CTX ? NB : b)) * 6 * DM;
    float v[NV];
#pragma unroll
    for (int i = 0; i < NV; ++i) v[i] = xr[i * WL + lane];
    ln_inplace(v, lane);
#pragma unroll
    for (int i = 0; i < NV; ++i) {
      int k = i * WL + lane;
      p.U[(size_t)row * DM + k] = f2bf(v[i] * (1.0f + mod[DM + k]) + mod[k]);
    }
  }
}
__device__ __forceinline__ void ph_ln1(const P& p, int l, int s, int gtid, int gsize) {
  const int lane = gtid % WL, gw = gtid / WL, nw = gsize / WL;
  const bool last = (l == DEPTH - 1);
  for (int row = gw; row < RS; row += nw) {
    int bl = row / RPB, pp = row % RPB, b = s * SB + bl;
    if (last && pp < CTX) continue;
    const float* xr = xsrc_row(p, l, b, pp);
    float* xd = xdst_row(p, b, pp);
    const float* mod = p.modtab + ((size_t)l * NMOD + (pp < CTX ? NB : b)) * 6 * DM;
    const float* o = p.OUTF + (size_t)row * DM;
    float v[NV];
#pragma unroll
    for (int i = 0; i < NV; ++i) { int k = i * WL + lane; v[i] = ALPHA * xr[k] + mod[2 * DM + k] * o[k]; }
    ln_inplace(v, lane);
#pragma unroll
    for (int i = 0; i < NV; ++i) { int k = i * WL + lane; v[i] = v[i] * p.ln1g[l * DM + k] + p.ln1b[l * DM + k]; xd[k] = v[i]; }
    ln_inplace(v, lane);
#pragma unroll
    for (int i = 0; i < NV; ++i) {
      int k = i * WL + lane;
      p.U[(size_t)row * DM + k] = f2bf(v[i] * (1.0f + mod[4 * DM + k]) + mod[3 * DM + k]);
    }
  }
}
__device__ __forceinline__ void ph_ln2(const P& p, int l, int s, int gtid, int gsize) {
  const int lane = gtid % WL, gw = gtid / WL, nw = gsize / WL;
  const bool last = (l == DEPTH - 1);
  for (int row = gw; row < RS; row += nw) {
    int bl = row / RPB, pp = row % RPB, b = s * SB + bl;
    if (last && pp < CTX) continue;
    float* xd = xdst_row(p, b, pp);
    const float* mod = p.modtab + ((size_t)l * NMOD + (pp < CTX ? NB : b)) * 6 * DM;
    const float* o = p.OUTF + (size_t)row * DM;
    float v[NV];
#pragma unroll
    for (int i = 0; i < NV; ++i) { int k = i * WL + lane; v[i] = ALPHA * xd[k] + mod[5 * DM + k] * o[k]; }
    ln_inplace(v, lane);
#pragma unroll
    for (int i = 0; i < NV; ++i) { int k = i * WL + lane; xd[k] = v[i] * p.ln2g[l * DM + k] + p.ln2b[l * DM + k]; }
  }
}

#ifndef CPU_EMU
typedef short bf16x8 __attribute__((ext_vector_type(8)));
typedef float f32x4 __attribute__((ext_vector_type(4)));
typedef unsigned u32x4 __attribute__((ext_vector_type(4)));
__device__ __forceinline__ f32x4 mfma16(bf16x8 a, bf16x8 b, f32x4 c) { return __builtin_amdgcn_mfma_f32_16x16x32_bf16(a, b, c, 0, 0, 0); }
#define GBM 128
#define GBN 128
#define GBK 64
#define GLD (GBK + 8)
template <bool OUT_BF16>
__device__ __forceinline__ void gemm_phase(const bf16_t* __restrict__ A, const bf16_t* __restrict__ Bt, void* __restrict__ Cv, int M, int N, int K, int ldc,
                           bool skip_ctx, bf16_t* lds, int tid) {
  bf16_t* sA = lds;
  bf16_t* sB = lds + GBM * GLD;
  const int lane = tid & 63, wave = tid >> 6;
  const int wm = wave >> 1, wn = wave & 1;
  const int ntm = M / GBM, ntn = N / GBN;
  const int KT = K / GBK;
  const int lr = lane & 15, lq = lane >> 4;
  for (int tile = blockIdx.x; tile < ntm * ntn; tile += gridDim.x) {
    const int tm = tile / ntn, tn = tile % ntn;
    if (skip_ctx && (tm % (RPB / GBM)) < (CTX / GBM)) continue;
    const int m0 = tm * GBM, n0 = tn * GBN;
    f32x4 acc[4][4];
#pragma unroll
    for (int i = 0; i < 4; ++i)
#pragma unroll
      for (int j = 0; j < 4; ++j) acc[i][j] = (f32x4){0.f, 0.f, 0.f, 0.f};
    u32x4 ra[4], rb[4];
#pragma unroll
    for (int i = 0; i < 4; ++i) {
      int id = tid + i * 256, r = id >> 3, ch = id & 7;
      ra[i] = *(const u32x4*)(A + (size_t)(m0 + r) * K + ch * 8);
      rb[i] = *(const u32x4*)(Bt + (size_t)(n0 + r) * K + ch * 8);
    }
    for (int kt = 0; kt < KT; ++kt) {
      __syncthreads();
#pragma unroll
      for (int i = 0; i < 4; ++i) {
        int id = tid + i * 256, r = id >> 3, ch = id & 7;
        *(u32x4*)(sA + r * GLD + ch * 8) = ra[i];
        *(u32x4*)(sB + r * GLD + ch * 8) = rb[i];
      }
      __syncthreads();
      if (kt + 1 < KT) {
#pragma unroll
        for (int i = 0; i < 4; ++i) {
          int id = tid + i * 256, r = id >> 3, ch = id & 7;
          ra[i] = *(const u32x4*)(A + (size_t)(m0 + r) * K + (kt + 1) * GBK + ch * 8);
          rb[i] = *(const u32x4*)(Bt + (size_t)(n0 + r) * K + (kt + 1) * GBK + ch * 8);
        }
      }
      __builtin_amdgcn_sched_barrier(0);
      {
        bf16x8 fa[2][4], fb[2][4];
#pragma unroll
        for (int kh = 0; kh < 2; ++kh) {
#pragma unroll
          for (int i = 0; i < 4; ++i) fa[kh][i] = *(const bf16x8*)(sA + (wm * 64 + i * 16 + lr) * GLD + kh * 32 + lq * 8);
#pragma unroll
          for (int j = 0; j < 4; ++j) fb[kh][j] = *(const bf16x8*)(sB + (wn * 64 + j * 16 + lr) * GLD + kh * 32 + lq * 8);
        }
        __builtin_amdgcn_sched_barrier(0);
#pragma unroll
        for (int kh = 0; kh < 2; ++kh)
#pragma unroll
          for (int i = 0; i < 4; ++i)
#pragma unroll
            for (int j = 0; j < 4; ++j) acc[i][j] = __builtin_amdgcn_mfma_f32_16x16x32_bf16(fb[kh][j], fa[kh][i], acc[i][j], 0, 0, 0);
      }
    }
#pragma unroll
    for (int i = 0; i < 4; ++i)
#pragma unroll
      for (int j = 0; j < 4; ++j) {
        size_t off = (size_t)(m0 + wm * 64 + i * 16 + lr) * ldc + n0 + wn * 64 + j * 16 + lq * 4;
        if (OUT_BF16) {
          uint2 o;
          o.x = pack_bf16(acc[i][j][0], acc[i][j][1]);
          o.y = pack_bf16(acc[i][j][2], acc[i][j][3]);
          *(uint2*)((bf16_t*)Cv + off) = o;
        } else {
          *(float4*)((float*)Cv + off) = make_float4(acc[i][j][0], acc[i][j][1], acc[i][j][2], acc[i][j][3]);
        }
      }
  }
}
#else
template <bool OUT_BF16>
void gemm_phase(const bf16_t* A, const bf16_t* Bt, void* Cv, int M, int N, int K, int ldc, bool skip_ctx, bf16_t* lds, int tid) {
  int gtid = blockIdx.x * blockDim.x + threadIdx.x, gsize = gridDim.x * blockDim.x;
  for (long it = gtid; it < (long)M * N; it += gsize) {
    int m = (int)(it / N), n = (int)(it % N);
    if (skip_ctx && (m % RPB) < CTX) continue;
    float acc = 0.f;
    for (int k = 0; k < K; ++k) acc += bf2f(A[(size_t)m * K + k]) * bf2f(Bt[(size_t)n * K + k]);
    if (OUT_BF16) ((bf16_t*)Cv)[(size_t)m * ldc + n] = f2bf(acc);
    else ((float*)Cv)[(size_t)m * ldc + n] = acc;
  }
}
#endif

#define PJ(row, col) bf2f(p.PROJ[(size_t)(row) * LDP + (col)])
template <int ORD>
__device__ __forceinline__ void hyena_conv_item(const P& p, int l, int it) {
  const bool need_ctx = (l != DEPTH - 1);
  const int ntb = (need_ctx ? CTX / 16 : 0) + SEQ / 16;
  int c = it % GW, r = it / GW;
  int tb = r % ntb, bl = r / ntb;
  int seg0, L, t0;
  const float* kf;
  if (need_ctx && tb < CTX / 16) { seg0 = 0; L = CTX; t0 = tb * 16; kf = p.kf_ctx + (size_t)(l * 2 + ORD) * 2 * CTX * GW; }
  else { int tb2 = tb - (need_ctx ? CTX / 16 : 0); seg0 = CTX; L = SEQ; t0 = tb2 * 16; kf = p.kf_lat + (size_t)(l * 2 + ORD) * 2 * SEQ * GW; }
  const int rowbase = bl * RPB + seg0;
  const float* cw = p.hy_cw + (size_t)l * 3 * 3 * GW;
  const float* cb = p.hy_cb + (size_t)l * 3 * GW;
  float acc[16], F[31], u[16];
#pragma unroll
  for (int i = 0; i < 16; ++i) acc[i] = 0.f;
#pragma unroll
  for (int m = 0; m < 15; ++m) F[m] = kf[(size_t)(L + t0 + 1 + m) * GW + c];
  const float w0 = cw[0 * 3 * GW + c], w1 = cw[1 * 3 * GW + c], w2 = cw[2 * 3 * GW + c], bb = cb[c];
  float nF[16], nin[18];
  auto fetch = [&](int s0) {
#pragma unroll
    for (int m = 0; m < 16; ++m) nF[m] = kf[(size_t)(L + t0 - s0 - 15 + m) * GW + c];
    if (ORD == 0) {
#pragma unroll
      for (int j = 0; j < 18; ++j) {
        int sp = s0 - 1 + j;
        nin[j] = (sp >= 0 && sp < L) ? PJ(rowbase + sp, OFF_HY + c) : 0.f;
      }
    } else {
#pragma unroll
      for (int j = 0; j < 16; ++j) nin[j] = p.Z2[(size_t)(rowbase + s0 + j) * GW + c];
    }
  };
  fetch(0);
  for (int s0 = 0; s0 < L; s0 += 16) {
#pragma unroll
    for (int m = 14; m >= 0; --m) F[m + 16] = F[m];
#pragma unroll
    for (int m = 0; m < 16; ++m) F[m] = nF[m];
    if (ORD == 0) {
#pragma unroll
      for (int j = 0; j < 16; ++j) u[j] = w0 * nin[j] + w1 * nin[j + 1] + w2 * nin[j + 2] + bb;
    } else {
#pragma unroll
      for (int j = 0; j < 16; ++j) u[j] = nin[j];
    }
    if (s0 + 16 < L) fetch(s0 + 16);
#pragma unroll
    for (int j = 0; j < 16; ++j)
#pragma unroll
      for (int i = 0; i < 16; ++i) acc[i] += F[i - j + 15] * u[j];
  }
  const int xc = (ORD == 0 ? GW : 2 * GW) + c;
  const float v0 = cw[0 * 3 * GW + xc], v1 = cw[1 * 3 * GW + xc], v2 = cw[2 * 3 * GW + xc], vb = cb[xc];
#pragma unroll
  for (int i = 0; i < 16; ++i) {
    int t = t0 + i;
    float xm = t > 0 ? PJ(rowbase + t - 1, OFF_HY + xc) : 0.f;
    float x0 = PJ(rowbase + t, OFF_HY + xc);
    float xp = t < L - 1 ? PJ(rowbase + t + 1, OFF_HY + xc) : 0.f;
    float g = v0 * xm + v1 * x0 + v2 * xp + vb;
    float o = g * acc[i];
    if (ORD == 0) p.Z2[(size_t)(rowbase + t) * GW + c] = o;
    else p.HY[(size_t)(rowbase + t) * GW + c] = o;
  }
}
__device__ __forceinline__ int hyena_items(int l) { return SB * ((l != DEPTH - 1 ? CTX / 16 : 0) + SEQ / 16) * GW; }

#if SB == 8
#define HC_KOFF (SEQ + 32)
#define HC_KLEN (2 * SEQ + 64)
#define HC_ULS ((SEQ / 16 + 4) * 16)
template <int ORD, bool FUSED>
__device__ __forceinline__ void hyena_mfma_item(const P& p, int l, int item, bf16_t* lds, int tid) {
  const int c = item % GW, seg = item / GW;
  const int L = seg ? CTX : SEQ, seg0 = seg ? 0 : CTX, NTB = L / 16;
  const bf16_t* kt = (seg ? p.kt_ctx + ((size_t)(l * 2 + ORD) * GW + c) * 2 * CTX : p.kt_lat + ((size_t)(l * 2 + ORD) * GW + c) * 2 * SEQ);
  bf16_t* KL = lds;
  bf16_t* UL = lds + HC_KLEN;
  const float* cw = p.hy_cw + (size_t)l * 3 * 3 * GW;
  const float* cb = p.hy_cb + (size_t)l * 3 * GW;
  __syncthreads();
  for (int n = -(L + 32) + tid; n < L + 32; n += 256) KL[HC_KOFF + n] = (n > -L && n < L) ? kt[L - n] : (bf16_t)0;
  if (!(FUSED && ORD == 1))
  for (int q = tid; q < SB * 4; q += 256) {
    int b = q >> 2, w = q & 3;
    bf16_t* dst = UL + b * HC_ULS + (w < 2 ? w * 16 : (NTB + w) * 16);
    for (int j = 0; j < 16; ++j) dst[j] = 0;
  }
  if (!(FUSED && ORD == 1)) {
    const float w0 = cw[0 * 3 * GW + c], w1 = cw[1 * 3 * GW + c], w2 = cw[2 * 3 * GW + c], bb = cb[c];
    for (int q = tid; q < SB * (L / 8); q += 256) {
      const int b = q / (L / 8), s8 = (q % (L / 8)) * 8;
      const int row = b * RPB + seg0 + s8;
      float u[8];
      if (ORD == 0) {
        float raw[10];
#pragma unroll
        for (int j = 0; j < 10; ++j) { int sp = s8 - 1 + j; raw[j] = (sp >= 0 && sp < L) ? PJ(row - 1 + j, OFF_HY + c) : 0.f; }
#pragma unroll
        for (int j = 0; j < 8; ++j) u[j] = w0 * raw[j] + w1 * raw[j + 1] + w2 * raw[j + 2] + bb;
      } else {
#pragma unroll
        for (int j = 0; j < 8; ++j) u[j] = p.Z2[(size_t)(row + j) * GW + c];
      }
      unsigned* dst = (unsigned*)(UL + b * HC_ULS + 32 + s8);
#pragma unroll
      for (int j = 0; j < 4; ++j) dst[j] = pack_bf16(u[2 * j], u[2 * j + 1]);
    }
  }
  __syncthreads();
  const int lane = tid & 63, wave = tid >> 6;
  const int ti = lane & 15, q4 = lane >> 4;
  const int NT = NTB / 2, TPW = NT / 4;
  const int T0 = wave * TPW * 2;
  f32x4 acc[16];
#pragma unroll
  for (int m = 0; m < 16; ++m) acc[m] = (f32x4){0.f, 0.f, 0.f, 0.f};
  const int nK = NTB / 2 + TPW;
  const int colb = (lane & 7) * HC_ULS + (q4 & 1) * 8;
  const int tbsel = (lane >> 3) & 1;
  for (int k = 0; k < nK; ++k) {
    const int dl = T0 - NTB + 2 * k + (q4 >> 1);
    const int nb = HC_KOFF - 16 * dl - ti + 8 * (q4 & 1);
    bf16x8 A;
#pragma unroll
    for (int j = 0; j < 8; ++j) A[j] = (short)KL[nb + j];
#pragma unroll
    for (int m = 0; m < 16; ++m) {
      if (m < TPW && k >= m && k <= m + NTB / 2) {
        const int sb = T0 + 2 * m + tbsel - dl;
        const bf16x8 B = *(const bf16x8*)(UL + colb + (sb + 2) * 16);
        acc[m] = mfma16(A, B, acc[m]);
      }
    }
  }
  if (FUSED && ORD == 0) __syncthreads();
  const int xc = (ORD == 0 ? GW : 2 * GW) + c;
  const float v0 = cw[0 * 3 * GW + xc], v1 = cw[1 * 3 * GW + xc], v2 = cw[2 * 3 * GW + xc], vb = cb[xc];
  const int bn = lane & 7;
#pragma unroll
  for (int m = 0; m < 16; ++m) {
    if (m < TPW) {
      const int t0 = 16 * (T0 + 2 * m + tbsel) + q4 * 4;
      const int row = bn * RPB + seg0 + t0;
      float raw[6];
#pragma unroll
      for (int j = 0; j < 6; ++j) { int tp = t0 - 1 + j; raw[j] = (tp >= 0 && tp < L) ? PJ(row - 1 + j, OFF_HY + xc) : 0.f; }
      float o4[4];
#pragma unroll
      for (int r = 0; r < 4; ++r) {
        float g = v0 * raw[r] + v1 * raw[r + 1] + v2 * raw[r + 2] + vb;
        o4[r] = g * acc[m][r];
        if (ORD == 1) p.HY[(size_t)(row + r) * GW + c] = o4[r];
        else if (!FUSED) p.Z2[(size_t)(row + r) * GW + c] = o4[r];
      }
      if (FUSED && ORD == 0) {
        unsigned* dst = (unsigned*)(UL + bn * HC_ULS + 32 + t0);
        dst[0] = pack_bf16(o4[0], o4[1]);
        dst[1] = pack_bf16(o4[2], o4[3]);
      }
    }
  }
}
__device__ __forceinline__ int hyena_mfma_items(int l) { return (l != DEPTH - 1 ? 2 : 1) * GW; }
#endif


__device__ __forceinline__ float rw_shift(const P& p, int l, int row, int pp, int j) {
  float x = PJ(row, OFF_RW + j);
  float xp = has_prev(pp) ? PJ(row - 1, OFF_RW + j) : 0.f;
  float xn = has_next(pp) ? PJ(row + 1, OFF_RW + j) : 0.f;
  return x + p.rw_mu[(size_t)(l * 2 + 0) * RWSH + j] * (xp - x) + p.rw_mu[(size_t)(l * 2 + 1) * RWSH + j] * (xn - x);
}
__device__ __forceinline__ void ph_prep(const P& p, int l, int s, int gtid, int gsize, float* lds, int tid) {
#pragma unroll 1
  for (int it = gtid; it < RS * (2 * GW / 4); it += gsize) {
    const int j = (it % (2 * GW / 4)) * 4, row = it / (2 * GW / 4), pp = row % RPB;
    const float* cw = p.ml_cw + (size_t)l * 3 * 2 * GW + j;
    const bf16_t* pr = p.PROJ + (size_t)row * LDP + OFF_ML + j;
    const f4 x0 = ldbf4(pr), xm = ldbf4(row > 0 ? pr - LDP : pr), xp = ldbf4(row < RS - 1 ? pr + LDP : pr);
    const float hp = has_prev(pp) ? 1.0f : 0.0f, hn = has_next(pp) ? 1.0f : 0.0f;
    f4 c0 = ld4(cw), c1 = ld4(cw + 2 * GW), c2 = ld4(cw + 4 * GW), cb = ld4(p.ml_cb + l * 2 * GW + j);
    c0.x *= hp; c0.y *= hp; c0.z *= hp; c0.w *= hp;
    c2.x *= hn; c2.y *= hn; c2.z *= hn; c2.w *= hn;
    const float sc = (j < GW) ? 0.125f : 1.0f;
    f4 o;
    o.x = siluf_(c0.x * xm.x + c1.x * x0.x + c2.x * xp.x + cb.x) * sc;
    o.y = siluf_(c0.y * xm.y + c1.y * x0.y + c2.y * xp.y + cb.y) * sc;
    o.z = siluf_(c0.z * xm.z + c1.z * x0.z + c2.z * xp.z + cb.z) * sc;
    o.w = siluf_(c0.w * xm.w + c1.w * x0.w + c2.w * xp.w + cb.w) * sc;
    st4(p.MQK + (size_t)row * 2 * GW + j, o);
  }
  for (int it = gtid; it < RS * 4 * NH; it += gsize) {
    int gj = it % (4 * NH), row = it / (4 * NH);
    float g = PJ(row, OFF_ML + 4 * GW + gj) + p.ml_gb[l * 4 * NH + gj];
    if ((gj / NH) & 1) g = logsigmoidf_(g);
    p.MG[(size_t)row * 4 * NH + gj] = g;
  }
#pragma unroll 1
  for (int it = gtid; it < RS * (2 * GW / 4); it += gsize) {
    const int j = (it % (2 * GW / 4)) * 4, row = it / (2 * GW / 4), pp = row % RPB;
    const int which = j / GW, c = j % GW, dd = c % HD, hb = c - dd;
    const bf16_t* pr = p.PROJ + (size_t)row * LDP + OFF_RT + which * GW;
    const f4 x = ldbf4(pr + c);
    f4 o;
    {
      const int t = pp >= CTX ? pp - CTX : 0, ri = t / GRIDW, ci = t % GRIDW;
      const int half = dd / 32, e = dd % 32, pi = e % 16;
      const bool first = e < 16;
      const int pos = pp >= CTX ? (half ? ci : ri) : 0;
      const f4 xo = ldbf4(pr + hb + (first ? dd + 16 : dd - 16));
      const f4 cs = ld4(p.ropec + pos * 16 + pi), sn = ld4(p.ropes + pos * 16 + pi);
      const float sg = first ? -1.0f : 1.0f;
      o.x = x.x * cs.x + sg * xo.x * sn.x;
      o.y = x.y * cs.y + sg * xo.y * sn.y;
      o.z = x.z * cs.z + sg * xo.z * sn.z;
      o.w = x.w * cs.w + sg * xo.w * sn.w;
    }
    if (which == 0) { o.x *= 0.125f; o.y *= 0.125f; o.z *= 0.125f; o.w *= 0.125f; }
    st4(p.RQK + (size_t)row * 2 * GW + j, o);
  }
  {
    float* zs = lds;
    float* part = lds + 8 * RWSH;
    const size_t AS = (size_t)RS * GW;
    for (int tile = blockIdx.x; tile < RS / 8; tile += gridDim.x) {
      const int row0 = tile * 8;
      __syncthreads();
      if (tid < RWSH / 4) {
        const int j4 = tid * 4;
        const f4 m0 = ld4(p.rw_mu + (size_t)(l * 2 + 0) * RWSH + j4), m1 = ld4(p.rw_mu + (size_t)(l * 2 + 1) * RWSH + j4);
        const int kind = (j4 >= 3 * GW && j4 < 3 * GW + 32) ? 1 : (j4 >= 3 * GW + 64 ? 2 : 0);
        const bf16_t* pr = p.PROJ + (size_t)row0 * LDP + OFF_RW + j4;
        f4 x[10];
#pragma unroll
        for (int r = 0; r < 10; ++r) {
          const int row = row0 - 1 + r;
          if (row >= 0 && row < RS) x[r] = ldbf4(pr + (ptrdiff_t)(r - 1) * LDP);
          else { x[r].x = 0.f; x[r].y = 0.f; x[r].z = 0.f; x[r].w = 0.f; }
        }
#pragma unroll
        for (int r = 0; r < 8; ++r) {
          const int pp = (row0 + r) % RPB;
          const float hp = has_prev(pp) ? 1.0f : 0.0f, hn = has_next(pp) ? 1.0f : 0.0f;
          const f4 c = x[r + 1];
          f4 z;
          z.x = c.x + m0.x * (hp * x[r].x - c.x) + m1.x * (hn * x[r + 2].x - c.x);
          z.y = c.y + m0.y * (hp * x[r].y - c.y) + m1.y * (hn * x[r + 2].y - c.y);
          z.z = c.z + m0.z * (hp * x[r].z - c.z) + m1.z * (hn * x[r + 2].z - c.z);
          z.w = c.w + m0.w * (hp * x[r].w - c.w) + m1.w * (hn * x[r + 2].w - c.w);
          if (kind == 1) { z.x = tanhf_(z.x); z.y = tanhf_(z.y); z.z = tanhf_(z.z); z.w = tanhf_(z.w); }
          else if (kind == 2) { z.x = sigmoidf_(z.x); z.y = sigmoidf_(z.y); z.z = sigmoidf_(z.z); z.w = sigmoidf_(z.w); }
          st4(zs + r * RWSH + j4, z);
        }
      }
      __syncthreads();
      {
        int pr = tid >> 3, sub = tid & 7;
        if (pr < 8 * NH) {
          int r = pr / NH, h = pr % NH;
          float ss = 0.f, bs = 0.f;
          for (int i = sub * 8; i < sub * 8 + 8; ++i) {
            float kv = zs[r * RWSH + GW + h * HD + i], rv = zs[r * RWSH + h * HD + i];
            float kk = kv * p.rw_kk[l * GW + h * HD + i];
            ss += kk * kk;
            bs += rv * kv * p.rw_rk[(l * NH + h) * HD + i];
          }
          part[pr * 8 + sub] = ss;
          part[256 + pr * 8 + sub] = bs;
        }
      }
      __syncthreads();
      for (int c = tid; c < GW; c += 256) {
        const int h = c / HD;
        float wa0[8], wa1[8], aa0[8], aa1[8], gg[8];
#pragma unroll
        for (int r = 0; r < 8; ++r) { wa0[r] = 0.f; wa1[r] = 0.f; aa0[r] = 0.f; aa1[r] = 0.f; gg[r] = 0.f; }
#pragma unroll 8
        for (int i = 0; i < 32; ++i) {
          float w20 = p.rw_w2[((size_t)(l * 2 + 0) * 32 + i) * GW + c], w21 = p.rw_w2[((size_t)(l * 2 + 1) * 32 + i) * GW + c];
          float a20 = p.rw_a2[((size_t)(l * 2 + 0) * 32 + i) * GW + c], a21 = p.rw_a2[((size_t)(l * 2 + 1) * 32 + i) * GW + c];
#pragma unroll
          for (int r = 0; r < 8; ++r) {
            float tw = zs[r * RWSH + 3 * GW + i], al = zs[r * RWSH + 3 * GW + 32 + i];
            wa0[r] = fmaf(tw, w20, wa0[r]); wa1[r] = fmaf(tw, w21, wa1[r]);
            aa0[r] = fmaf(al, a20, aa0[r]); aa1[r] = fmaf(al, a21, aa1[r]);
          }
        }
#pragma unroll 16
        for (int j = 0; j < 64; ++j) {
          float g2 = p.rw_g2[((size_t)l * 64 + j) * GW + c];
#pragma unroll
          for (int r = 0; r < 8; ++r) gg[r] = fmaf(zs[r * RWSH + 3 * GW + 64 + j], g2, gg[r]);
        }
        const float ka = p.rw_ka[l * GW + c], kks = p.rw_kk[l * GW + c];
        const float w00 = p.rw_w0[(l * 2 + 0) * GW + c], w01 = p.rw_w0[(l * 2 + 1) * GW + c];
        const float a00 = p.rw_a0[(l * 2 + 0) * GW + c], a01 = p.rw_a0[(l * 2 + 1) * GW + c];
#pragma unroll
        for (int r = 0; r < 8; ++r) {
          const int pr = r * NH + h;
          float ss = 0.f, bs = 0.f;
#pragma unroll
          for (int u = 0; u < 8; ++u) { ss += part[pr * 8 + u]; bs += part[256 + pr * 8 + u]; }
          const float rr = zs[r * RWSH + c], k = zs[r * RWSH + GW + c], v = zs[r * RWSH + 2 * GW + c];
          const float kkv = k * kks / sqrtf(ss + 1e-12f);
          const size_t o = (size_t)(row0 + r) * GW + c;
          p.RW[0 * AS + o] = rr;
          p.RW[1 * AS + o] = kkv;
          p.BON[o] = bs * v;
          p.GG[o] = gg[r];
#pragma unroll
          for (int d = 0; d < 2; ++d) {
            float wpre = (d ? w01 : w00) + (d ? wa1[r] : wa0[r]);
            float decay = expf(-expf(-softplusf_(-wpre) - 0.5f));
            float a = sigmoidf_((d ? a01 : a00) + (d ? aa1[r] : aa0[r]));
            p.RW[(2 + d) * AS + o] = decay;
            p.RW[(4 + d) * AS + o] = k * (1.0f + (a - 1.0f) * ka);
            p.RW[(6 + d) * AS + o] = kkv * a;
          }
        }
      }
    }
    __syncthreads();
  }
#if SB == 8
#else
  for (int it = gtid; it < hyena_items(l); it += gsize) hyena_conv_item<0>(p, l, it);
#endif
}

__device__ __forceinline__ int scan_pos(int dir, int step) {
  if (!dir) return step;
  return step < CTX ? CTX - 1 - step : RPB - 1 - (step - CTX);
}
#ifndef CPU_EMU
__device__ __forceinline__ float quad_sum(float v) {
  v += __int_as_float(__builtin_amdgcn_mov_dpp(__float_as_int(v), 0xB1, 0xF, 0xF, true));
  v += __int_as_float(__builtin_amdgcn_mov_dpp(__float_as_int(v), 0x4E, 0xF, 0xF, true));
  return v;
}
__device__ __forceinline__ float oct_sum(float v) {
  v = quad_sum(v);
  v += __int_as_float(__builtin_amdgcn_mov_dpp(__float_as_int(v), 0x141, 0xF, 0xF, true));
  return v;
}
#endif
#define SCT 16
#define NCHUNK (RPB / SCT)
__device__ __forceinline__ void bscan_rwkv(const P& p, int l, int bl, int h, int dir, int half, float* lds, int tid) {
  const int i = half * 32 + (tid >> 3), kq = tid & 7, st = tid >> 4, sp = tid & 15;
  float S[8];
#pragma unroll
  for (int d = 0; d < 8; ++d) S[d] = 0.f;
  float* H = dir ? p.HB : p.HF;
  const size_t AS = (size_t)RS * GW;
  const int vc = 2 * GW + h * HD + sp * 4;
  const f4 mu0 = ld4(p.rw_mu + (size_t)(l * 2 + 0) * RWSH + vc), mu1 = ld4(p.rw_mu + (size_t)(l * 2 + 1) * RWSH + vc);
  f4 rg[5], rv;
  auto load = [&](int c) {
    const int pp = scan_pos(dir, c * SCT + st), row = bl * RPB + pp;
    const size_t o = (size_t)row * GW + h * HD + sp * 4;
    rg[0] = ld4(p.RW + 0 * AS + o);
    rg[1] = ld4(p.RW + 1 * AS + o);
    rg[2] = ld4(p.RW + (size_t)(2 + dir) * AS + o);
    rg[3] = ld4(p.RW + (size_t)(4 + dir) * AS + o);
    rg[4] = ld4(p.RW + (size_t)(6 + dir) * AS + o);
    const bf16_t* pr = p.PROJ + (size_t)row * LDP + OFF_RW + vc;
    f4 x = ldbf4(pr), xm = x, xp = x;
    xm.x = xm.y = xm.z = xm.w = 0.f; xp = xm;
    if (has_prev(pp)) xm = ldbf4(pr - LDP);
    if (has_next(pp)) xp = ldbf4(pr + LDP);
    rv.x = x.x + mu0.x * (xm.x - x.x) + mu1.x * (xp.x - x.x);
    rv.y = x.y + mu0.y * (xm.y - x.y) + mu1.y * (xp.y - x.y);
    rv.z = x.z + mu0.z * (xm.z - x.z) + mu1.z * (xp.z - x.z);
    rv.w = x.w + mu0.w * (xm.w - x.w) + mu1.w * (xp.w - x.w);
  };
  load(0);
  for (int c = 0; c < NCHUNK; ++c) {
    __syncthreads();
#pragma unroll
    for (int a = 0; a < 5; ++a) st4(lds + (st * 6 + a) * 64 + sp * 4, rg[a]);
    st4(lds + (st * 6 + 5) * 64 + sp * 4, rv);
    __syncthreads();
    if (c + 1 < NCHUNK) load(c + 1);
    struct RwOps { float r[8], k[8], w[8], d[8], b[8], vv; };
    auto ldstep = [&](RwOps& o, int t) {
      const float* L = lds + t * 6 * 64 + kq * 8;
      o.vv = lds[(t * 6 + 5) * 64 + i];
      ld8(o.k, L + 1 * 64);
      ld8(o.w, L + 2 * 64);
      ld8(o.d, L + 3 * 64);
      ld8(o.b, L + 4 * 64);
      ld8(o.r, L + 0 * 64);
    };
    auto step = [&](const RwOps& o, int t) {
      float sa4[4] = {0.f, 0.f, 0.f, 0.f};
#pragma unroll
      for (int d = 0; d < 8; ++d) sa4[d & 3] = fmaf(S[d], o.k[d], sa4[d & 3]);
      const float sa = -oct_sum((sa4[0] + sa4[1]) + (sa4[2] + sa4[3]));
      float y4[4] = {0.f, 0.f, 0.f, 0.f};
#pragma unroll
      for (int d = 0; d < 8; ++d) {
        S[d] = fmaf(S[d], o.w[d], fmaf(sa, o.b[d], o.vv * o.d[d]));
        y4[d & 3] = fmaf(S[d], o.r[d], y4[d & 3]);
      }
      const float y = oct_sum((y4[0] + y4[1]) + (y4[2] + y4[3]));
      if (kq == 0) {
        const int row = bl * RPB + scan_pos(dir, c * SCT + t);
        H[(size_t)row * 3 * GW + 2 * GW + h * HD + i] = y;
      }
    };
    RwOps oa, ob;
    ldstep(oa, 0);
#pragma nounroll
    for (int t = 0; t < SCT; t += 2) {
      ldstep(ob, t + 1);
      step(oa, t);
      if (t + 2 < SCT) ldstep(oa, t + 2);
      step(ob, t + 1);
    }
  }
}
__device__ __forceinline__ void bscan_mlstm(const P& p, int bl, int h, int dir, int half, float* lds, int tid) {
  const int i = half * 32 + (tid >> 3), kq = tid & 7, st = tid >> 4, sp = tid & 15;
  float C[8], n[8];
#pragma unroll
  for (int d = 0; d < 8; ++d) { C[d] = 0.f; n[d] = 0.f; }
  float m = 0.f;
  float* H = dir ? p.HB : p.HF;
  f4 rq, rk, rv;
  float g0 = 0.f, g1 = 0.f;
  auto load = [&](int c) {
    const int pp = scan_pos(dir, c * SCT + st), row = bl * RPB + pp;
    const float* q = p.MQK + (size_t)row * 2 * GW + h * HD + sp * 4;
    rq = ld4(q);
    rk = ld4(q + GW);
    rv = ldbf4(p.PROJ + (size_t)row * LDP + OFF_ML + 2 * GW + h * HD + sp * 4);
    if (sp == 0) {
      const float* mg = p.MG + (size_t)row * 4 * NH;
      g0 = mg[(dir ? 2 : 0) * NH + h];
      g1 = mg[(dir ? 3 : 1) * NH + h];
    }
  };
  load(0);
  for (int c = 0; c < NCHUNK; ++c) {
    __syncthreads();
    st4(lds + (st * 4 + 0) * 64 + sp * 4, rq);
    st4(lds + (st * 4 + 1) * 64 + sp * 4, rk);
    st4(lds + (st * 4 + 2) * 64 + sp * 4, rv);
    if (sp == 0) { lds[(st * 4 + 3) * 64 + 0] = g0; lds[(st * 4 + 3) * 64 + 1] = g1; }
    __syncthreads();
    if (c + 1 < NCHUNK) load(c + 1);
    struct MlOps { float q[8], k[8], ig, lf, v; };
    auto ldstep = [&](MlOps& o, int t) {
      const float* L = lds + t * 4 * 64;
      o.ig = L[3 * 64 + 0]; o.lf = L[3 * 64 + 1]; o.v = L[2 * 64 + i];
      ld8(o.q, L + kq * 8);
      ld8(o.k, L + 64 + kq * 8);
    };
    auto step = [&](const MlOps& o, int t) {
      const float mn = fmaxf(o.lf + m, o.ig);
      const float f = fexp_(o.lf + m - mn), ii = fexp_(o.ig - mn), em = fexp_(-mn);
      m = mn;
      const float iv = ii * o.v;
      float num4[4] = {0.f, 0.f, 0.f, 0.f}, den4[4] = {0.f, 0.f, 0.f, 0.f};
#pragma unroll
      for (int d = 0; d < 8; ++d) {
        const float kd = o.k[d], qd = o.q[d];
        C[d] = fmaf(kd, iv, f * C[d]);
        n[d] = fmaf(kd, ii, f * n[d]);
        num4[d & 3] = fmaf(qd, C[d], num4[d & 3]);
        den4[d & 3] = fmaf(qd, n[d], den4[d & 3]);
      }
      const float num = oct_sum((num4[0] + num4[1]) + (num4[2] + num4[3]));
      const float den = oct_sum((den4[0] + den4[1]) + (den4[2] + den4[3]));
      if (kq == 0) {
        const int row = bl * RPB + scan_pos(dir, c * SCT + t);
        H[(size_t)row * 3 * GW + 0 * GW + h * HD + i] = num * frcp_(fmaxf(fabsf(den), em));
      }
    };
    MlOps oa, ob;
    ldstep(oa, 0);
#pragma nounroll
    for (int t = 0; t < SCT; t += 2) {
      ldstep(ob, t + 1);
      step(oa, t);
      if (t + 2 < SCT) ldstep(oa, t + 2);
      step(ob, t + 1);
    }
  }
}
__device__ __forceinline__ void bscan_ret(const P& p, int bl, int h, int dir, int half, float* lds, int tid) {
  const int i = half * 32 + (tid >> 3), kq = tid & 7, st = tid >> 4, sp = tid & 15;
  float S[8];
#pragma unroll
  for (int d = 0; d < 8; ++d) S[d] = 0.f;
  const int hh = dir ? NH - 1 - h : h;
  const float gamma = 1.0f - exp2f(-5.0f - (float)hh);
  float* H = dir ? p.HB : p.HF;
  f4 rq, rk, rv;
  auto load = [&](int c) {
    const int pp = scan_pos(dir, c * SCT + st), row = bl * RPB + pp;
    const float* q = p.RQK + (size_t)row * 2 * GW + h * HD + sp * 4;
    rq = ld4(q);
    rk = ld4(q + GW);
    rv = ldbf4(p.PROJ + (size_t)row * LDP + OFF_RT + 2 * GW + h * HD + sp * 4);
  };
  load(0);
  for (int c = 0; c < NCHUNK; ++c) {
    __syncthreads();
    st4(lds + (st * 4 + 0) * 64 + sp * 4, rq);
    st4(lds + (st * 4 + 1) * 64 + sp * 4, rk);
    st4(lds + (st * 4 + 2) * 64 + sp * 4, rv);
    __syncthreads();
    if (c + 1 < NCHUNK) load(c + 1);
    struct RtOps { float q[8], k[8], v; };
    auto ldstep = [&](RtOps& o, int t) {
      const float* L = lds + t * 4 * 64;
      o.v = L[2 * 64 + i];
      ld8(o.q, L + kq * 8);
      ld8(o.k, L + 64 + kq * 8);
    };
    auto step = [&](const RtOps& o, int t) {
      float o4[4] = {0.f, 0.f, 0.f, 0.f};
#pragma unroll
      for (int d = 0; d < 8; ++d) {
        S[d] = fmaf(S[d], gamma, o.k[d] * o.v);
        o4[d & 3] = fmaf(o.q[d], S[d], o4[d & 3]);
      }
      const float ov = oct_sum((o4[0] + o4[1]) + (o4[2] + o4[3]));
      if (kq == 0) {
        const int row = bl * RPB + scan_pos(dir, c * SCT + t);
        H[(size_t)row * 3 * GW + 1 * GW + h * HD + i] = ov;
      }
    };
    RtOps oa, ob;
    ldstep(oa, 0);
#pragma nounroll
    for (int t = 0; t < SCT; t += 2) {
      ldstep(ob, t + 1);
      step(oa, t);
      if (t + 2 < SCT) ldstep(oa, t + 2);
      step(ob, t + 1);
    }
  }
}
#define NSCAN (3 * SB * NH * 2 * 2)
__device__ __forceinline__ void ph_scan(const P& p, int l, int s, int gtid, int gsize, float* lds, int tid) {
  for (int w = blockIdx.x; w < NSCAN; w += gridDim.x) {
    int mixer = w / (SB * NH * 4), r = w % (SB * NH * 4);
    int half = r & 1, dir = (r >> 1) & 1, h = (r >> 2) % NH, bl = (r >> 2) / NH;
    if (mixer == 0) bscan_rwkv(p, l, bl, h, dir, half, lds, tid);
    else if (mixer == 1) bscan_mlstm(p, bl, h, dir, half, lds, tid);
    else bscan_ret(p, bl, h, dir, half, lds, tid);
    __syncthreads();
  }
#if SB == 8
  {
    int* sh = (int*)lds;
    const int nitem = hyena_mfma_items(l);
    for (;;) {
      __syncthreads();
      if (tid == 0) sh[0] = atomicAdd(p.ctr, 1);
      __syncthreads();
      const int it = sh[0];
      if (it >= nitem) break;
      hyena_mfma_item<0, true>(p, l, it, (bf16_t*)lds, tid);
      hyena_mfma_item<1, true>(p, l, it, (bf16_t*)lds, tid);
    }
  }
#else
  for (int it = gtid; it < hyena_items(l); it += gsize) hyena_conv_item<1>(p, l, it);
#endif
}

#define NE (HD / WL)
__device__ __forceinline__ void ph_fin(const P& p, int l, int s, int gtid, int gsize) {
  const bool last = (l == DEPTH - 1);
  const int lane = gtid % WL, gw = gtid / WL, nw = gsize / WL;
  for (int item = gw; item < (RS / 4) * 4 * NH; item += nw) {
    const int hg = item % (4 * NH), row0 = (item / (4 * NH)) * 4, pp0 = row0 % RPB;
    if (last && pp0 < CTX) continue;
    const int g = hg / NH, h = hg % NH;
    const int c0 = g * GW + h * HD;
    float val[4][NE];
#pragma unroll
    for (int r = 0; r < 4; ++r) {
      const int row = row0 + r;
#pragma unroll
      for (int e = 0; e < NE; ++e) {
        const int i = e * WL + lane;
        float v;
        if (g == 1) v = p.HY[(size_t)row * GW + h * HD + i];
        else {
          const int slot = (g == 0) ? 0 : (g == 2 ? 1 : 2);
          const size_t o = (size_t)row * 3 * GW + slot * GW + h * HD + i;
          v = p.HF[o] + p.HB[o];
        }
        val[r][e] = v;
      }
    }
    float mu[4], rs[4];
#pragma unroll
    for (int r = 0; r < 4; ++r) {
      float sm = 0.f;
#pragma unroll
      for (int e = 0; e < NE; ++e) sm += val[r][e];
      mu[r] = wave_sum(sm) * (1.0f / HD);
    }
#pragma unroll
    for (int r = 0; r < 4; ++r) {
      float q = 0.f;
#pragma unroll
      for (int e = 0; e < NE; ++e) { float d = val[r][e] - mu[r]; q += d * d; }
      rs[r] = 1.0f / sqrtf(wave_sum(q) * (1.0f / HD) + 1e-5f);
    }
#pragma unroll
    for (int r = 0; r < 4; ++r) {
      const int row = row0 + r;
#pragma unroll
      for (int e = 0; e < NE; ++e) {
        const int i = e * WL + lane;
        float v = (val[r][e] - mu[r]) * rs[r] * p.ng[l * DM + c0 + i] + p.nb[l * DM + c0 + i];
        if (g == 0) v *= sigmoidf_(PJ(row, OFF_ML + 3 * GW + h * HD + i));
        else if (g == 2) v *= siluf_(PJ(row, OFF_RT + 3 * GW + h * HD + i));
        else if (g == 3) v = p.GG[(size_t)row * GW + h * HD + i] * (v + p.BON[(size_t)row * GW + h * HD + i]);
        p.U[(size_t)row * DM + c0 + i] = f2bf(v);
      }
    }
  }
}

__device__ __forceinline__ void ph_act(const P& p, int l, int s, int gtid, int gsize) {
  const bool last = (l == DEPTH - 1);
  const float* cw = p.f_cw + (size_t)l * 3 * DFF;
  const float* cb = p.f_cb + (size_t)l * DFF;
#pragma unroll 2
  for (int it = gtid; it < RS * (DFF / 8); it += gsize) {
    const int j = (it % (DFF / 8)) * 8, row = it / (DFF / 8), pp = row % RPB;
    if (last && pp < CTX) continue;
    const bf16_t* hr = p.HFF + (size_t)row * 2 * DFF;
    const bf16_t* hm = row > 0 ? hr - 2 * DFF : hr;
    const bf16_t* hp = row < RS - 1 ? hr + 2 * DFF : hr;
    const unsigned mprev = has_prev(pp) ? 0xffffffffu : 0u, mnext = has_next(pp) ? 0xffffffffu : 0u;
    const u4 qa = ldu4(hr + j), qb = ldu4(hr + DFF + j), qm = ldu4(hm + j), qp = ldu4(hp + j);
    const unsigned a0[4] = {qa.x, qa.y, qa.z, qa.w}, bv[4] = {qb.x, qb.y, qb.z, qb.w};
    const unsigned am[4] = {qm.x & mprev, qm.y & mprev, qm.z & mprev, qm.w & mprev}, ap[4] = {qp.x & mnext, qp.y & mnext, qp.z & mnext, qp.w & mnext};
    float w0[8], w1[8], w2[8], wb[8];
    ld8(w0, cw + j); ld8(w1, cw + DFF + j); ld8(w2, cw + 2 * DFF + j); ld8(wb, cb + j);
    unsigned ov[4];
#pragma unroll
    for (int e = 0; e < 4; ++e) {
      float o[2];
#pragma unroll
      for (int hh = 0; hh < 2; ++hh) {
        const int jj = 2 * e + hh;
        float xm = bf2f((bf16_t)(am[e] >> (16 * hh))), x0 = bf2f((bf16_t)(a0[e] >> (16 * hh))), xp = bf2f((bf16_t)(ap[e] >> (16 * hh)));
        float v = w0[jj] * xm + w1[jj] * x0 + w2[jj] * xp + wb[jj];
        o[hh] = siluf_(v) * bf2f((bf16_t)(bv[e] >> (16 * hh)));
      }
      ov[e] = pack_bf16(o[0], o[1]);
    }
    u4 qo; qo.x = ov[0]; qo.y = ov[1]; qo.z = ov[2]; qo.w = ov[3];
    stu4(p.ACT + (size_t)row * DFF + j, qo);
  }
}

enum { PH_PRO_A = 0, PH_PRO_B, PH_PRO_C, PH_LN0, PH_GEMM_IN, PH_PREP, PH_SCAN, PH_FIN, PH_GEMM_OUT, PH_LN1, PH_GEMM_UP, PH_ACT, PH_GEMM_DN, PH_LN2, PH_COUNT };

__device__ __forceinline__ void run_phase(const P& p, int ph, int l, int s, bf16_t* lds) {
  int tid = threadIdx.x;
#ifndef CPU_EMU
  asm volatile("" : "+v"(tid));
#endif
  const int gtid = blockIdx.x * blockDim.x + tid;
  const int gsize = gridDim.x * blockDim.x;
  const bool last = (l == DEPTH - 1);
  switch (ph) {
    case PH_PRO_A: ph_pro_a(p, gtid, gsize); break;
    case PH_PRO_B: ph_pro_b(p, gtid, gsize); break;
    case PH_PRO_C: ph_pro_c(p, gtid, gsize); break;
    case PH_LN0: ph_ln0(p, l, s, gtid, gsize); break;
    case PH_GEMM_IN: gemm_phase<true>(p.U, p.wt_in + (size_t)l * LDP * DM, p.PROJ, RS, LDP, DM, LDP, false, lds, tid); break;
    case PH_PREP: ph_prep(p, l, s, gtid, gsize, (float*)lds, tid); break;
    case PH_SCAN: ph_scan(p, l, s, gtid, gsize, (float*)lds, tid); break;
    case PH_FIN: ph_fin(p, l, s, gtid, gsize); break;
    case PH_GEMM_OUT: gemm_phase<false>(p.U, p.wt_out + (size_t)l * DM * DM, p.OUTF, RS, DM, DM, DM, last, lds, tid); break;
    case PH_LN1: ph_ln1(p, l, s, gtid, gsize); break;
    case PH_GEMM_UP: gemm_phase<true>(p.U, p.wt_up + (size_t)l * 2 * DFF * DM, p.HFF, RS, 2 * DFF, DM, 2 * DFF, last, lds, tid); break;
    case PH_ACT: ph_act(p, l, s, gtid, gsize); break;
    case PH_GEMM_DN: gemm_phase<false>(p.ACT, p.wt_dn + (size_t)l * DM * DFF, p.OUTF, RS, DM, DFF, DM, last, lds, tid); break;
    case PH_LN2: ph_ln2(p, l, s, gtid, gsize); break;
  }
}

#ifndef CPU_EMU
#define XB_TMO      128
#define XB_XCNT(j)  (256  + 64 * (j))
#define XB_XSUB(j)  (1280 + 64 * (j))
#define XB_XGEN(j)  (2304 + 64 * (j))
#define XB_TOP      3328
#define XB_TOPGEN   3392
#define XCD_BAR_WORDS 3456
#define XB_SPIN_CAP (1u << 22)
#define LAS __attribute__((address_space(3)))

__device__ __forceinline__ unsigned xb_ld(unsigned* p)              { return __hip_atomic_load(p, __ATOMIC_RELAXED, __HIP_MEMORY_SCOPE_AGENT); }
__device__ __forceinline__ unsigned xb_add(unsigned* p, unsigned v) { return __hip_atomic_fetch_add(p, v, __ATOMIC_RELAXED, __HIP_MEMORY_SCOPE_AGENT); }
__device__ __forceinline__ unsigned xb_xcc_id() { return (unsigned)__builtin_amdgcn_s_getreg((3 << 11) | 20) & 0xFu; }
#define XB_SPIN(cond, bar) do { unsigned _sp = 0; while (cond) { __builtin_amdgcn_s_sleep(1); \
    if ((++_sp & 255u) == 0u) { if (xb_ld(&(bar)[XB_TMO])) break; if (_sp > XB_SPIN_CAP) { atomicAdd(&(bar)[XB_TMO], 1u); break; } } } } while (0)

struct XcdBarrier {
    unsigned* bar; unsigned x;
    volatile LAS unsigned* st;
};

__device__ __forceinline__ XcdBarrier xcd_barrier_post(unsigned* bar, volatile LAS unsigned* st) {
    XcdBarrier b; b.bar = bar; b.x = xb_xcc_id(); b.st = st;
    if (threadIdx.x == 0) (void)xb_add(&bar[XB_XCNT(b.x)], 1u);
    return b;
}
__device__ __forceinline__ void xcd_barrier_complete(unsigned* bar, unsigned x, unsigned& nloc, unsigned& nx) {
    const unsigned G = gridDim.x * gridDim.y * gridDim.z;
    unsigned sum, cnt, mine, sp = 0u;
    for (;;) {
        sum = 0u; cnt = 0u; mine = 0u;
#pragma unroll
        for (unsigned j = 0; j < 16; ++j) { const unsigned c = xb_ld(&bar[XB_XCNT(j)]); sum += c; cnt += (c > 0u) ? 1u : 0u; mine = (j == x) ? c : mine; }
        if (sum == G) break;
        __builtin_amdgcn_s_sleep(1);
        if ((++sp & 255u) == 0u) { if (xb_ld(&bar[XB_TMO])) break; if (sp > XB_SPIN_CAP) { atomicAdd(&bar[XB_TMO], 1u); break; } }
    }
    nloc = mine > 0u ? mine : 1u; nx = cnt > 0u ? cnt : 1u;
}

__device__ __forceinline__ void xcd_barrier(const XcdBarrier& b) {
    asm volatile("s_waitcnt vmcnt(0)" ::: "memory");
    __syncthreads();
    if (threadIdx.x == 0) {
        unsigned* bar = b.bar;
        __builtin_amdgcn_s_waitcnt(0);
        unsigned nloc = b.st[0], nx = b.st[1];
        if (nloc == 0u) { xcd_barrier_complete(bar, b.x, nloc, nx); b.st[0] = nloc; b.st[1] = nx; }
        const unsigned old = xb_add(&bar[XB_XSUB(b.x)], 1u);
        const unsigned gen = old / nloc;
        if (old + 1u == (gen + 1u) * nloc) {
            __builtin_amdgcn_fence(__ATOMIC_RELEASE, "agent");
            asm volatile("s_waitcnt vmcnt(0)" ::: "memory");
            const unsigned og = xb_add(&bar[XB_TOP], 1u);
            const unsigned tg = og / nx;
            if (og + 1u == (tg + 1u) * nx) xb_add(&bar[XB_TOPGEN], 1u);
            else XB_SPIN(xb_ld(&bar[XB_TOPGEN]) == tg, bar);
            __builtin_amdgcn_fence(__ATOMIC_ACQUIRE, "agent");
            xb_add(&bar[XB_XGEN(b.x)], 1u);
            asm volatile("s_waitcnt vmcnt(0)" ::: "memory");
        } else {
            XB_SPIN(xb_ld(&bar[XB_XGEN(b.x)]) == gen, bar);
            __builtin_amdgcn_fence(__ATOMIC_ACQUIRE, "agent");
            asm volatile("s_waitcnt vmcnt(0)" ::: "memory");
        }
    }
    __syncthreads();
}

#endif

#ifndef PROBE_MASK
#define PROBE_MASK 0
#endif
#if PROBE_MASK
#define RUNPH(ph) do { int reps_ = 1 + ((PROBE_MASK >> ph) & 1); asm volatile("" : "+s"(reps_)); for (int q_ = 0; q_ < reps_; ++q_) { run_phase(p, ph, l, s, lds); GSYNC(); } } while (0)
#else
#define RUNPH(ph) do { run_phase(p, ph, l, s, lds); GSYNC(); } while (0)
#endif
#ifndef CPU_EMU
__global__ void __launch_bounds__(256, 2) k_mega(P p) {
  __shared__ __attribute__((aligned(16))) bf16_t lds[24576];
  __shared__ uint4 xb_words;
  cg::grid_group grid = cg::this_grid();
  if (threadIdx.x == 0) xb_words = make_uint4(0u, 0u, 0u, 0u);
  __syncthreads();
  XcdBarrier xb = xcd_barrier_post(p.bar, (volatile LAS unsigned*)&xb_words);
#define GSYNC() xcd_barrier(xb)
  run_phase(p, PH_PRO_A, 0, 0, lds);
  grid.sync();
  run_phase(p, PH_PRO_B, 0, 0, lds);
  GSYNC();
  run_phase(p, PH_PRO_C, 0, 0, lds);
  GSYNC();
  for (int l = 0; l < DEPTH; ++l)
    for (int s = 0; s < NSLICE; ++s)
    {
      if (l == 0 && s == 0) RUNPH(PH_LN0);
      RUNPH(PH_GEMM_IN);
      RUNPH(PH_PREP);
      RUNPH(PH_SCAN);
      RUNPH(PH_FIN);
      RUNPH(PH_GEMM_OUT);
      RUNPH(PH_LN1);
      RUNPH(PH_GEMM_UP);
      RUNPH(PH_ACT);
      RUNPH(PH_GEMM_DN);
      {
        run_phase(p, PH_LN2, l, s, lds);
        const int ns = (s + 1 == NSLICE) ? 0 : s + 1, nl = (s + 1 == NSLICE) ? l + 1 : l;
        if (nl < DEPTH) { run_phase(p, PH_LN0, nl, ns, lds); GSYNC(); }
      }
    }
}
#endif

static size_t ws_take(size_t& off, size_t bytes) { size_t o = off; off += (bytes + 255) & ~(size_t)255; return o; }

static void build_params(P& p, void* const* d_in, void* d_out, void* d_ws) {
  const float** f = (const float**)&p;
  for (int i = 0; i < 39; ++i) f[i] = (const float*)d_in[i];
  p.out = (float*)d_out;
  char* w = (char*)d_ws;
  size_t off = 0;
  p.wt_in = (bf16_t*)(w + ws_take(off, (size_t)DEPTH * LDP * DM * 2));
  p.wt_out = (bf16_t*)(w + ws_take(off, (size_t)DEPTH * DM * DM * 2));
  p.wt_up = (bf16_t*)(w + ws_take(off, (size_t)DEPTH * 2 * DFF * DM * 2));
  p.wt_dn = (bf16_t*)(w + ws_take(off, (size_t)DEPTH * DM * DFF * 2));
  p.kf_lat = (float*)(w + ws_take(off, (size_t)DEPTH * 2 * 2 * SEQ * GW * 4));
  p.kf_ctx = (float*)(w + ws_take(off, (size_t)DEPTH * 2 * 2 * CTX * GW * 4));
  p.kt_lat = (bf16_t*)(w + ws_take(off, (size_t)DEPTH * 2 * 2 * SEQ * GW * 2));
  p.kt_ctx = (bf16_t*)(w + ws_take(off, (size_t)DEPTH * 2 * 2 * CTX * GW * 2));
  p.ropec = (float*)(w + ws_take(off, 64 * 16 * 4));
  p.ropes = (float*)(w + ws_take(off, 64 * 16 * 4));
  p.hyh1 = (float*)(w + ws_take(off, (size_t)DEPTH * 2 * SEQ * 64 * 4));
  p.hyh2 = (float*)(w + ws_take(off, (size_t)DEPTH * 2 * SEQ * 64 * 4));
  p.scv = (float*)(w + ws_take(off, (size_t)NMOD * DM * 4));
  p.modtab = (float*)(w + ws_take(off, (size_t)DEPTH * NMOD * 6 * DM * 4));
  p.xc = (float*)(w + ws_take(off, (size_t)NB * CTX * DM * 4));
  p.ctr = (int*)(w + ws_take(off, 256));
  p.bar = (unsigned*)(w + ws_take(off, 16384));
  p.U = (bf16_t*)(w + ws_take(off, (size_t)RS * DM * 2));
  size_t arena = off;
  p.PROJ = (bf16_t*)(w + ws_take(off, (size_t)RS * LDP * 2));
  p.MQK = (float*)(w + ws_take(off, (size_t)RS * 2 * GW * 4));
  p.MG = (float*)(w + ws_take(off, (size_t)RS * 4 * NH * 4));
  p.RQK = (float*)(w + ws_take(off, (size_t)RS * 2 * GW * 4));
  p.RW = (float*)(w + ws_take(off, (size_t)8 * RS * GW * 4));
  p.HF = (float*)(w + ws_take(off, (size_t)RS * 3 * GW * 4));
  p.HB = (float*)(w + ws_take(off, (size_t)RS * 3 * GW * 4));
  p.Z2 = (float*)(w + ws_take(off, (size_t)RS * GW * 4));
  p.HY = (float*)(w + ws_take(off, (size_t)RS * GW * 4));
  p.BON = (float*)(w + ws_take(off, (size_t)RS * GW * 4));
  p.GG = (float*)(w + ws_take(off, (size_t)RS * GW * 4));
  size_t off2 = arena;
  p.OUTF = (float*)(w + ws_take(off2, (size_t)RS * DM * 4));
  p.HFF = (bf16_t*)(w + ws_take(off2, (size_t)RS * 2 * DFF * 2));
  p.ACT = (bf16_t*)(w + ws_take(off2, (size_t)RS * DFF * 2));
}

#ifndef CPU_EMU
extern "C" void kernel_launch(void* const* d_in, const int* in_sizes, int n_in, void* d_out, int out_size, void* d_ws, size_t ws_size,
                              hipStream_t stream) {
  static int grid_blocks = 0;
  if (!grid_blocks) {
    int dev = 0, cus = 0, per_cu = 0;
    hipGetDevice(&dev);
    hipDeviceGetAttribute(&cus, hipDeviceAttributeMultiprocessorCount, dev);
    hipOccupancyMaxActiveBlocksPerMultiprocessor(&per_cu, k_mega, 256, 0);
    if (per_cu < 1) per_cu = 1;
    grid_blocks = cus * per_cu;
  }
  P p;
  memset(&p, 0, sizeof(p));
  build_params(p, d_in, d_out, d_ws);
  hipMemsetAsync(p.bar, 0, XCD_BAR_WORDS * sizeof(unsigned), stream);
  void* args[] = {&p};
  hipError_t e = hipLaunchCooperativeKernel((void*)k_mega, dim3(grid_blocks), dim3(256), args, 0, stream);
  if (e != hipSuccess) fprintf(stderr, "cooperative launch failed: %s (grid %d)\n", hipGetErrorString(e), grid_blocks);
}
#endif
```

```cpp
#ifndef CPU_EMU
#include <hip/hip_runtime.h>
#include <hip/hip_cooperative_groups.h>
#include <cstdio>
#include <cstring>
namespace cg = cooperative_groups;
#endif
#include <stdint.h>
#include <stddef.h>

#if !defined(CFG_SMALL) && !defined(CFG_CONVTEST)
#define DM 1024
#define NB 32
#define SEQ 2048
#define CTX 256
#define DFF 2816
#define SB 8
#elif defined(CFG_CONVTEST)
#define DM 512
#define NB 8
#define SEQ 256
#define CTX 128
#define DFF 192
#define SB 8
#else
#define DM 512
#define NB 2
#define SEQ 256
#define CTX 128
#define DFF 192
#define SB 1
#endif
#define DEPTH 2
#define GRIDW 64
#define HD 64
#define GW (DM / 4)
#define NH (GW / HD)
#define DPROJ (14 * GW + 4 * NH + 128)
#define LDP ((DPROJ + 127) / 128 * 128)
#define OFF_ML 0
#define OFF_HY (4 * GW + 4 * NH)
#define OFF_RT (OFF_HY + 3 * GW)
#define OFF_RW (OFF_RT + 4 * GW)
#define RWSH (3 * GW + 128)
#define RPB (CTX + SEQ)
#define RS (SB * RPB)
#define NSLICE (NB / SB)
#define ALPHA 1.41421356237309515f
#define NMOD 33
#ifdef CPU_EMU
#define WL 1
#else
#define WL 64
#endif

typedef unsigned short bf16_t;

struct P {
  const float *x, *c, *ctx, *c_ctx, *ada_w, *ada_b, *w_in, *ml_cw, *ml_cb, *ml_gb, *hy_cw, *hy_cb, *hy_w1, *hy_b1, *hy_w2, *hy_b2, *hy_w3,
      *hy_freq, *hy_d, *rw_mu, *rw_w0, *rw_w2, *rw_a0, *rw_a2, *rw_g2, *rw_kk, *rw_ka, *rw_rk, *ng, *nb, *w_out, *ln1g, *ln1b, *w_up, *f_cw,
      *f_cb, *w_dn, *ln2g, *ln2b;
  float* out;
  bf16_t *wt_in, *wt_out, *wt_up, *wt_dn;
  float *kf_lat, *kf_ctx, *hyh1, *hyh2, *scv, *modtab, *xc;
  bf16_t *kt_lat, *kt_ctx;
  float *ropec, *ropes;
  bf16_t *U, *PROJ;
  float *MQK, *MG, *RQK, *RW, *HF, *HB, *Z2, *HY, *BON, *GG;
  float* OUTF;
  bf16_t *HFF, *ACT;
  int* ctr;
  unsigned* bar;
};

__device__ __forceinline__ bf16_t f2bf(float f) {
  unsigned u = __float_as_uint(f);
  u += 0x7fffu + ((u >> 16) & 1u);
  return (bf16_t)(u >> 16);
}
#ifndef CPU_EMU
typedef __bf16 bf16v2_t __attribute__((ext_vector_type(2)));
typedef float f32x2_t __attribute__((ext_vector_type(2)));
#endif
__device__ __forceinline__ unsigned pack_bf16(float lo, float hi) {
#ifndef CPU_EMU
  f32x2_t v = {lo, hi};
  bf16v2_t b = __builtin_convertvector(v, bf16v2_t);
  return __builtin_bit_cast(unsigned, b);
#else
  return f2bf(lo) | ((unsigned)f2bf(hi) << 16);
#endif
}
__device__ __forceinline__ float bf2f(bf16_t h) { return __uint_as_float(((unsigned)h) << 16); }
#ifndef CPU_EMU
__device__ __forceinline__ float fexp_(float x) { return __expf(x); }
__device__ __forceinline__ float frcp_(float x) { return __builtin_amdgcn_rcpf(x); }
#else
__device__ __forceinline__ float fexp_(float x) { return expf(x); }
__device__ __forceinline__ float frcp_(float x) { return 1.0f / x; }
#endif
#ifndef CPU_EMU
__device__ __forceinline__ float sigmoidf_(float x) { return frcp_(1.0f + fexp_(-x)); }
__device__ __forceinline__ float siluf_(float x) { return x * frcp_(1.0f + fexp_(-x)); }
__device__ __forceinline__ float softplusf_(float x) { return fmaxf(x, 0.0f) + log1pf(expf(-fabsf(x))); }
__device__ __forceinline__ float tanhf_(float x) { return 1.0f - 2.0f * frcp_(1.0f + fexp_(2.0f * x)); }
#else
__device__ __forceinline__ float sigmoidf_(float x) { return 1.0f / (1.0f + expf(-x)); }
__device__ __forceinline__ float siluf_(float x) { return x / (1.0f + expf(-x)); }
__device__ __forceinline__ float softplusf_(float x) { return fmaxf(x, 0.0f) + log1pf(expf(-fabsf(x))); }
__device__ __forceinline__ float tanhf_(float x) { return tanhf(x); }
#endif
__device__ __forceinline__ float logsigmoidf_(float x) { return -softplusf_(-x); }

__device__ __forceinline__ float wave_sum(float v) {
#ifndef CPU_EMU
  v += __int_as_float(__builtin_amdgcn_mov_dpp(__float_as_int(v), 0xB1, 0xF, 0xF, true));
  v += __int_as_float(__builtin_amdgcn_mov_dpp(__float_as_int(v), 0x4E, 0xF, 0xF, true));
  v += __int_as_float(__builtin_amdgcn_mov_dpp(__float_as_int(v), 0x141, 0xF, 0xF, true));
  v += __int_as_float(__builtin_amdgcn_mov_dpp(__float_as_int(v), 0x140, 0xF, 0xF, true));
  const float r0 = __int_as_float(__builtin_amdgcn_readlane(__float_as_int(v), 0));
  const float r1 = __int_as_float(__builtin_amdgcn_readlane(__float_as_int(v), 16));
  const float r2 = __int_as_float(__builtin_amdgcn_readlane(__float_as_int(v), 32));
  const float r3 = __int_as_float(__builtin_amdgcn_readlane(__float_as_int(v), 48));
  v = (r0 + r1) + (r2 + r3);
#endif
  return v;
}

#ifndef CPU_EMU
typedef float f4 __attribute__((ext_vector_type(4)));
typedef unsigned u2v __attribute__((ext_vector_type(2)));
__device__ __forceinline__ f4 ld4(const float* a) { return *(const f4*)a; }
__device__ __forceinline__ void st4(float* a, f4 v) { *(f4*)a = v; }
__device__ __forceinline__ f4 ldbf4(const bf16_t* a) {
  u2v u = *(const u2v*)a;
  f4 r;
  r.x = __uint_as_float(u.x << 16); r.y = __uint_as_float(u.x & 0xffff0000u);
  r.z = __uint_as_float(u.y << 16); r.w = __uint_as_float(u.y & 0xffff0000u);
  return r;
}
#else
struct f4 { float x, y, z, w; };
__device__ __forceinline__ f4 ld4(const float* a) { f4 r; r.x = a[0]; r.y = a[1]; r.z = a[2]; r.w = a[3]; return r; }
__device__ __forceinline__ void st4(float* a, f4 v) { a[0] = v.x; a[1] = v.y; a[2] = v.z; a[3] = v.w; }
__device__ __forceinline__ f4 ldbf4(const bf16_t* a) { f4 r; r.x = bf2f(a[0]); r.y = bf2f(a[1]); r.z = bf2f(a[2]); r.w = bf2f(a[3]); return r; }
#endif
#ifndef CPU_EMU
typedef unsigned u4 __attribute__((ext_vector_type(4)));
__device__ __forceinline__ u4 ldu4(const bf16_t* a) { return *(const u4*)a; }
__device__ __forceinline__ void stu4(bf16_t* a, u4 v) { *(u4*)a = v; }
#else
struct u4 { unsigned x, y, z, w; };
__device__ __forceinline__ u4 ldu4(const bf16_t* a) { u4 r; const unsigned* q = (const unsigned*)a; r.x = q[0]; r.y = q[1]; r.z = q[2]; r.w = q[3]; return r; }
__device__ __forceinline__ void stu4(bf16_t* a, u4 v) { unsigned* q = (unsigned*)a; q[0] = v.x; q[1] = v.y; q[2] = v.z; q[3] = v.w; }
#endif
__device__ __forceinline__ void ld8(float* dst, const float* src) {
#pragma unroll
  for (int j = 0; j < 2; ++j) { f4 v = ld4(src + 4 * j); dst[4 * j] = v.x; dst[4 * j + 1] = v.y; dst[4 * j + 2] = v.z; dst[4 * j + 3] = v.w; }
}
__device__ __forceinline__ void ld16(float* dst, const float* src) {
#pragma unroll
  for (int j = 0; j < 4; ++j) { f4 v = ld4(src + 4 * j); dst[4 * j] = v.x; dst[4 * j + 1] = v.y; dst[4 * j + 2] = v.z; dst[4 * j + 3] = v.w; }
}


__device__ __forceinline__ const float* xsrc_row(const P& p, int l, int b, int pp) {
  if (pp < CTX) return (l == 0 ? p.ctx : p.xc) + ((size_t)b * CTX + pp) * DM;
  return (l == 0 ? p.x : p.out) + ((size_t)b * SEQ + (pp - CTX)) * DM;
}
__device__ __forceinline__ float* xdst_row(const P& p, int b, int pp) {
  if (pp < CTX) return p.xc + ((size_t)b * CTX + pp) * DM;
  return p.out + ((size_t)b * SEQ + (pp - CTX)) * DM;
}
__device__ __forceinline__ bool has_prev(int pp) { return pp != 0 && pp != CTX; }
__device__ __forceinline__ bool has_next(int pp) { return pp != CTX - 1 && pp != RPB - 1; }

__device__ __forceinline__ void cvt_weight(const float* W, bf16_t* Wt, int K, int N, int Npad, int gtid, int gsize) {
  const int nk8 = K / 8;
  for (long it = gtid; it < (long)nk8 * Npad; it += gsize) {
    int n = (int)(it % Npad), k8 = (int)(it / Npad);
    bf16_t v[8];
#pragma unroll
    for (int j = 0; j < 8; ++j) v[j] = (n < N) ? f2bf(W[(size_t)(k8 * 8 + j) * N + n]) : (bf16_t)0;
    uint4 o;
    o.x = v[0] | ((unsigned)v[1] << 16); o.y = v[2] | ((unsigned)v[3] << 16);
    o.z = v[4] | ((unsigned)v[5] << 16); o.w = v[6] | ((unsigned)v[7] << 16);
    *(uint4*)(Wt + (size_t)n * K + k8 * 8) = o;
  }
}
__device__ __forceinline__ void hy_feat_h1(const P& p, int gtid, int gsize) {
  const int per_l = (SEQ + CTX) * 64;
  for (int it = gtid; it < DEPTH * per_l; it += gsize) {
    int l = it / per_l, r = it % per_l;
    int i, L, seg;
    int j = r % 64; r /= 64;
    if (r < SEQ) { seg = 0; i = r; L = SEQ; } else { seg = 1; i = r - SEQ; L = CTX; }
    const float* w1 = p.hy_w1 + (size_t)l * 33 * 64;
    float t = (float)i / (float)(L - 1);
    float ang = 6.283185307179586f * (float)i / (float)L;
    float acc = t * w1[j];
    for (int b = 0; b < 16; ++b) {
      float band = 1e-4f + (float)b * ((15.0f - 1e-4f) / 15.0f);
      float a = band * ang;
      acc += cosf(a) * w1[(1 + b) * 64 + j];
      acc -= sinf(a) * w1[(17 + b) * 64 + j];
    }
    float h = sinf(p.hy_freq[l * 64 + j] * (acc + p.hy_b1[l * 64 + j]));
    p.hyh1[((size_t)(l * 2 + seg) * SEQ + i) * 64 + j] = h;
  }
}
__device__ __forceinline__ void ph_pro_a(const P& p, int gtid, int gsize) {
  for (int l = 0; l < DEPTH; ++l) {
    cvt_weight(p.w_in + (size_t)l * DM * DPROJ, p.wt_in + (size_t)l * LDP * DM, DM, DPROJ, LDP, gtid, gsize);
    cvt_weight(p.w_out + (size_t)l * DM * DM, p.wt_out + (size_t)l * DM * DM, DM, DM, DM, gtid, gsize);
    cvt_weight(p.w_up + (size_t)l * DM * 2 * DFF, p.wt_up + (size_t)l * 2 * DFF * DM, DM, 2 * DFF, 2 * DFF, gtid, gsize);
    cvt_weight(p.w_dn + (size_t)l * DFF * DM, p.wt_dn + (size_t)l * DM * DFF, DFF, DM, DM, gtid, gsize);
  }
  for (int it = gtid; it < NMOD * DM; it += gsize) {
    int r = it / DM, k = it % DM;
    float v = (r < NB) ? p.c[(size_t)r * DM + k] : p.c_ctx[k];
    p.scv[it] = siluf_(v);
  }
  hy_feat_h1(p, gtid, gsize);
  for (int it = gtid; it < 64 * 16; it += gsize) {
    float a = (float)(it / 16) * powf(10000.0f, -(float)(it % 16) / 16.0f);
    p.ropec[it] = cosf(a);
    p.ropes[it] = sinf(a);
  }
}
__device__ __forceinline__ void ph_pro_b(const P& p, int gtid, int gsize) {
  for (int it = gtid; it < DEPTH * NMOD * 6 * DM; it += gsize) {
    int j = it % (6 * DM), r = (it / (6 * DM)) % NMOD, l = it / (6 * DM * NMOD);
    const float* w = p.ada_w + (size_t)l * DM * 6 * DM + j;
    const float* sv = p.scv + r * DM;
    float acc = 0.f;
    for (int k = 0; k < DM; ++k) acc += sv[k] * w[(size_t)k * 6 * DM];
    p.modtab[it] = acc + p.ada_b[l * 6 * DM + j];
  }
  const int per_l = (SEQ + CTX) * 64;
  for (int it = gtid; it < DEPTH * per_l; it += gsize) {
    int l = it / per_l, r = it % per_l;
    int j = r % 64; r /= 64;
    int seg = r < SEQ ? 0 : 1, i = r < SEQ ? r : r - SEQ;
    const float* h1 = p.hyh1 + ((size_t)(l * 2 + seg) * SEQ + i) * 64;
    const float* w2 = p.hy_w2 + (size_t)l * 64 * 64;
    float acc = 0.f;
    for (int k = 0; k < 64; ++k) acc += h1[k] * w2[k * 64 + j];
    p.hyh2[((size_t)(l * 2 + seg) * SEQ + i) * 64 + j] = sinf(p.hy_freq[l * 64 + j] * (acc + p.hy_b2[l * 64 + j]));
  }
}
__device__ __forceinline__ void ph_pro_c(const P& p, int gtid, int gsize) {
  const int per_l = 2 * (2 * SEQ + 2 * CTX) * GW;
  const float max_decay = -4.605170185988091f / 0.3f, min_decay = -4.605170185988091f / 1.5f;
  for (int it = gtid; it < DEPTH * per_l; it += gsize) {
    int l = it / per_l, r = it % per_l;
    int c = r % GW; r /= GW;
    int ord = r & 1; r >>= 1;
    int seg, idx, L;
    if (r < 2 * SEQ) { seg = 0; idx = r; L = SEQ; } else { seg = 1; idx = r - 2 * SEQ; L = CTX; }
    int d = idx - L;
    float val = 0.f;
    if (idx != 0) {
      int i = d < 0 ? -d : d;
      float ti = (float)i / (float)(L - 1);
      float delta = fabsf(min_decay + (float)c * ((max_decay - min_decay) / (float)(GW - 1)));
      float win = expf(-ti * delta);
      const float* h2 = p.hyh2 + ((size_t)(l * 2 + seg) * SEQ + i) * 64;
      const float* w3 = p.hy_w3 + (size_t)l * 64 * 4 * GW;
      float af = 0.f, ab = 0.f;
      for (int k = 0; k < 64; ++k) {
        float hv = h2[k];
        af += hv * w3[k * 4 * GW + 0 * 2 * GW + ord * GW + c];
        ab += hv * w3[k * 4 * GW + 1 * 2 * GW + ord * GW + c];
      }
      if (d > 0) val = af * win;
      else if (d < 0) val = ab * win;
      else val = (af + ab) * win + p.hy_d[(l * 2 + ord) * GW + c];
    }
    float* kf = seg == 0 ? p.kf_lat + ((size_t)(l * 2 + ord) * 2 * SEQ + idx) * GW : p.kf_ctx + ((size_t)(l * 2 + ord) * 2 * CTX + idx) * GW;
    kf[c] = val;
    if (seg == 0) p.kt_lat[((size_t)(l * 2 + ord) * GW + c) * 2 * SEQ + idx] = f2bf(val);
    else p.kt_ctx[((size_t)(l * 2 + ord) * GW + c) * 2 * CTX + idx] = f2bf(val);
  }
}

#define NV (DM / WL)
__device__ __forceinline__ void ln_inplace(float* v, int lane) {
  float s = 0.f;
#pragma unroll
  for (int i = 0; i < NV; ++i) s += v[i];
  s = wave_sum(s);
  float mu = s * (1.0f / DM);
  float q = 0.f;
#pragma unroll
  for (int i = 0; i < NV; ++i) { float d = v[i] - mu; q += d * d; }
  q = wave_sum(q);
  float rs = 1.0f / sqrtf(q * (1.0f / DM) + 1e-5f);
#pragma unroll
  for (int i = 0; i < NV; ++i) v[i] = (v[i] - mu) * rs;
}
__device__ __forceinline__ void ph_ln0(const P& p, int l, int s, int gtid, int gsize) {
  const int lane = gtid % WL, gw = gtid / WL, nw = gsize / WL;
  if (gtid == 0) *p.ctr = 0;
  for (int row = gw; row < RS; row += nw) {
    int bl = row / RPB, pp = row % RPB, b = s * SB + bl;
    const float* xr = xsrc_row(p, l, b, pp);
    const float* mod = p.modtab + ((size_t)l * NMOD + (pp < CTX ? NB : b)) * 6 * DM;
    float v[NV];
#pragma unroll
    for (int i = 0; i < NV; ++i) v[i] = xr[i * WL + lane];
    ln_inplace(v, lane);
#pragma unroll
    for (int i = 0; i < NV; ++i) {
      int k = i * WL + lane;
      p.U[(size_t)row * DM + k] = f2bf(v[i] * (1.0f + mod[DM + k]) + mod[k]);
    }
  }
}
__device__ __forceinline__ void ph_ln1(const P& p, int l, int s, int gtid, int gsize) {
  const int lane = gtid % WL, gw = gtid / WL, nw = gsize / WL;
  const bool last = (l == DEPTH - 1);
  for (int row = gw; row < RS; row += nw) {
    int bl = row / RPB, pp = row % RPB, b = s * SB + bl;
    if (last && pp < CTX) continue;
    const float* xr = xsrc_row(p, l, b, pp);
    float* xd = xdst_row(p, b, pp);
    const float* mod = p.modtab + ((size_t)l * NMOD + (pp < CTX ? NB : b)) * 6 * DM;
    const float* o = p.OUTF + (size_t)row * DM;
    float v[NV];
#pragma unroll
    for (int i = 0; i < NV; ++i) { int k = i * WL + lane; v[i] = ALPHA * xr[k] + mod[2 * DM + k] * o[k]; }
    ln_inplace(v, lane);
#pragma unroll
    for (int i = 0; i < NV; ++i) { int k = i * WL + lane; v[i] = v[i] * p.ln1g[l * DM + k] + p.ln1b[l * DM + k]; xd[k] = v[i]; }
    ln_inplace(v, lane);
#pragma unroll
    for (int i = 0; i < NV; ++i) {
      int k = i * WL + lane;
      p.U[(size_t)row * DM + k] = f2bf(v[i] * (1.0f + mod[4 * DM + k]) + mod[3 * DM + k]);
    }
  }
}
__device__ __forceinline__ void ph_ln2(const P& p, int l, int s, int gtid, int gsize) {
  const int lane = gtid % WL, gw = gtid / WL, nw = gsize / WL;
  const bool last = (l == DEPTH - 1);
  for (int row = gw; row < RS; row += nw) {
    int bl = row / RPB, pp = row % RPB, b = s * SB + bl;
    if (last && pp < CTX) continue;
    float* xd = xdst_row(p, b, pp);
    const float* mod = p.modtab + ((size_t)l * NMOD + (pp < CTX ? NB : b)) * 6 * DM;
    const float* o = p.OUTF + (size_t)row * DM;
    float v[NV];
#pragma unroll
    for (int i = 0; i < NV; ++i) { int k = i * WL + lane; v[i] = ALPHA * xd[k] + mod[5 * DM + k] * o[k]; }
    ln_inplace(v, lane);
#pragma unroll
    for (int i = 0; i < NV; ++i) { int k = i * WL + lane; xd[k] = v[i] * p.ln2g[l * DM + k] + p.ln2b[l * DM + k]; }
  }
}

#ifndef CPU_EMU
typedef short bf16x8 __attribute__((ext_vector_type(8)));
typedef float f32x4 __attribute__((ext_vector_type(4)));
typedef unsigned u32x4 __attribute__((ext_vector_type(4)));
__device__ __forceinline__ f32x4 mfma16(bf16x8 a, bf16x8 b, f32x4 c) { return __builtin_amdgcn_mfma_f32_16x16x32_bf16(a, b, c, 0, 0, 0); }
#define GBM 128
#define GBN 128
#define GBK 64
#define GLD (GBK + 8)
template <bool OUT_BF16>
__device__ __forceinline__ void gemm_phase(const bf16_t* __restrict__ A, const bf16_t* __restrict__ Bt, void* __restrict__ Cv, int M, int N, int K, int ldc,
                           bool skip_ctx, bf16_t* lds, int tid) {
  bf16_t* sA = lds;
  bf16_t* sB = lds + GBM * GLD;
  const int lane = tid & 63, wave = tid >> 6;
  const int wm = wave >> 1, wn = wave & 1;
  const int ntm = M / GBM, ntn = N / GBN;
  const int KT = K / GBK;
  const int lr = lane & 15, lq = lane >> 4;
  for (int tile = blockIdx.x; tile < ntm * ntn; tile += gridDim.x) {
    const int tn = tile / ntm, tm = tile % ntm;
    if (skip_ctx && (tm % (RPB / GBM)) < (CTX / GBM)) continue;
    const int m0 = tm * GBM, n0 = tn * GBN;
    f32x4 acc[4][4];
#pragma unroll
    for (int i = 0; i < 4; ++i)
#pragma unroll
      for (int j = 0; j < 4; ++j) acc[i][j] = (f32x4){0.f, 0.f, 0.f, 0.f};
    u32x4 ra[4], rb[4];
#pragma unroll
    for (int i = 0; i < 4; ++i) {
      int id = tid + i * 256, r = id >> 3, ch = id & 7;
      ra[i] = *(const u32x4*)(A + (size_t)(m0 + r) * K + ch * 8);
      rb[i] = *(const u32x4*)(Bt + (size_t)(n0 + r) * K + ch * 8);
    }
    for (int kt = 0; kt < KT; ++kt) {
      __syncthreads();
#pragma unroll
      for (int i = 0; i < 4; ++i) {
        int id = tid + i * 256, r = id >> 3, ch = id & 7;
        *(u32x4*)(sA + r * GLD + ch * 8) = ra[i];
        *(u32x4*)(sB + r * GLD + ch * 8) = rb[i];
      }
      __syncthreads();
      if (kt + 1 < KT) {
#pragma unroll
        for (int i = 0; i < 4; ++i) {
          int id = tid + i * 256, r = id >> 3, ch = id & 7;
          ra[i] = *(const u32x4*)(A + (size_t)(m0 + r) * K + (kt + 1) * GBK + ch * 8);
          rb[i] = *(const u32x4*)(Bt + (size_t)(n0 + r) * K + (kt + 1) * GBK + ch * 8);
        }
      }
      __builtin_amdgcn_sched_barrier(0);
      {
        bf16x8 fa[2][4], fb[2][4];
#pragma unroll
        for (int kh = 0; kh < 2; ++kh) {
#pragma unroll
          for (int i = 0; i < 4; ++i) fa[kh][i] = *(const bf16x8*)(sA + (wm * 64 + i * 16 + lr) * GLD + kh * 32 + lq * 8);
#pragma unroll
          for (int j = 0; j < 4; ++j) fb[kh][j] = *(const bf16x8*)(sB + (wn * 64 + j * 16 + lr) * GLD + kh * 32 + lq * 8);
        }
        __builtin_amdgcn_sched_barrier(0);
#pragma unroll
        for (int kh = 0; kh < 2; ++kh)
#pragma unroll
          for (int i = 0; i < 4; ++i)
#pragma unroll
            for (int j = 0; j < 4; ++j) acc[i][j] = __builtin_amdgcn_mfma_f32_16x16x32_bf16(fb[kh][j], fa[kh][i], acc[i][j], 0, 0, 0);
      }
    }
#pragma unroll
    for (int i = 0; i < 4; ++i)
#pragma unroll
      for (int j = 0; j < 4; ++j) {
        size_t off = (size_t)(m0 + wm * 64 + i * 16 + lr) * ldc + n0 + wn * 64 + j * 16 + lq * 4;
        if (OUT_BF16) {
          uint2 o;
          o.x = pack_bf16(acc[i][j][0], acc[i][j][1]);
          o.y = pack_bf16(acc[i][j][2], acc[i][j][3]);
          *(uint2*)((bf16_t*)Cv + off) = o;
        } else {
          *(float4*)((float*)Cv + off) = make_float4(acc[i][j][0], acc[i][j][1], acc[i][j][2], acc[i][j][3]);
        }
      }
  }
}
#else
template <bool OUT_BF16>
void gemm_phase(const bf16_t* A, const bf16_t* Bt, void* Cv, int M, int N, int K, int ldc, bool skip_ctx, bf16_t* lds, int tid) {
  int gtid = blockIdx.x * blockDim.x + threadIdx.x, gsize = gridDim.x * blockDim.x;
  for (long it = gtid; it < (long)M * N; it += gsize) {
    int m = (int)(it / N), n = (int)(it % N);
    if (skip_ctx && (m % RPB) < CTX) continue;
    float acc = 0.f;
    for (int k = 0; k < K; ++k) acc += bf2f(A[(size_t)m * K + k]) * bf2f(Bt[(size_t)n * K + k]);
    if (OUT_BF16) ((bf16_t*)Cv)[(size_t)m * ldc + n] = f2bf(acc);
    else ((float*)Cv)[(size_t)m * ldc + n] = acc;
  }
}
#endif

#define PJ(row, col) bf2f(p.PROJ[(size_t)(row) * LDP + (col)])
template <int ORD>
__device__ __forceinline__ void hyena_conv_item(const P& p, int l, int it) {
  const bool need_ctx = (l != DEPTH - 1);
  const int ntb = (need_ctx ? CTX / 16 : 0) + SEQ / 16;
  int c = it % GW, r = it / GW;
  int tb = r % ntb, bl = r / ntb;
  int seg0, L, t0;
  const float* kf;
  if (need_ctx && tb < CTX / 16) { seg0 = 0; L = CTX; t0 = tb * 16; kf = p.kf_ctx + (size_t)(l * 2 + ORD) * 2 * CTX * GW; }
  else { int tb2 = tb - (need_ctx ? CTX / 16 : 0); seg0 = CTX; L = SEQ; t0 = tb2 * 16; kf = p.kf_lat + (size_t)(l * 2 + ORD) * 2 * SEQ * GW; }
  const int rowbase = bl * RPB + seg0;
  const float* cw = p.hy_cw + (size_t)l * 3 * 3 * GW;
  const float* cb = p.hy_cb + (size_t)l * 3 * GW;
  float acc[16], F[31], u[16];
#pragma unroll
  for (int i = 0; i < 16; ++i) acc[i] = 0.f;
#pragma unroll
  for (int m = 0; m < 15; ++m) F[m] = kf[(size_t)(L + t0 + 1 + m) * GW + c];
  const float w0 = cw[0 * 3 * GW + c], w1 = cw[1 * 3 * GW + c], w2 = cw[2 * 3 * GW + c], bb = cb[c];
  float nF[16], nin[18];
  auto fetch = [&](int s0) {
#pragma unroll
    for (int m = 0; m < 16; ++m) nF[m] = kf[(size_t)(L + t0 - s0 - 15 + m) * GW + c];
    if (ORD == 0) {
#pragma unroll
      for (int j = 0; j < 18; ++j) {
        int sp = s0 - 1 + j;
        nin[j] = (sp >= 0 && sp < L) ? PJ(rowbase + sp, OFF_HY + c) : 0.f;
      }
    } else {
#pragma unroll
      for (int j = 0; j < 16; ++j) nin[j] = p.Z2[(size_t)(rowbase + s0 + j) * GW + c];
    }
  };
  fetch(0);
  for (int s0 = 0; s0 < L; s0 += 16) {
#pragma unroll
    for (int m = 14; m >= 0; --m) F[m + 16] = F[m];
#pragma unroll
    for (int m = 0; m < 16; ++m) F[m] = nF[m];
    if (ORD == 0) {
#pragma unroll
      for (int j = 0; j < 16; ++j) u[j] = w0 * nin[j] + w1 * nin[j + 1] + w2 * nin[j + 2] + bb;
    } else {
#pragma unroll
      for (int j = 0; j < 16; ++j) u[j] = nin[j];
    }
    if (s0 + 16 < L) fetch(s0 + 16);
#pragma unroll
    for (int j = 0; j < 16; ++j)
#pragma unroll
      for (int i = 0; i < 16; ++i) acc[i] += F[i - j + 15] * u[j];
  }
  const int xc = (ORD == 0 ? GW : 2 * GW) + c;
  const float v0 = cw[0 * 3 * GW + xc], v1 = cw[1 * 3 * GW + xc], v2 = cw[2 * 3 * GW + xc], vb = cb[xc];
#pragma unroll
  for (int i = 0; i < 16; ++i) {
    int t = t0 + i;
    float xm = t > 0 ? PJ(rowbase + t - 1, OFF_HY + xc) : 0.f;
    float x0 = PJ(rowbase + t, OFF_HY + xc);
    float xp = t < L - 1 ? PJ(rowbase + t + 1, OFF_HY + xc) : 0.f;
    float g = v0 * xm + v1 * x0 + v2 * xp + vb;
    float o = g * acc[i];
    if (ORD == 0) p.Z2[(size_t)(rowbase + t) * GW + c] = o;
    else p.HY[(size_t)(rowbase + t) * GW + c] = o;
  }
}
__device__ __forceinline__ int hyena_items(int l) { return SB * ((l != DEPTH - 1 ? CTX / 16 : 0) + SEQ / 16) * GW; }

#if SB == 8
#define HC_KOFF (SEQ + 32)
#define HC_KLEN (2 * SEQ + 64)
#define HC_ULS ((SEQ / 16 + 4) * 16)
template <int ORD, bool FUSED>
__device__ __forceinline__ void hyena_mfma_item(const P& p, int l, int item, bf16_t* lds, int tid) {
  const int c = item % GW, seg = item / GW;
  const int L = seg ? CTX : SEQ, seg0 = seg ? 0 : CTX, NTB = L / 16;
  const bf16_t* kt = (seg ? p.kt_ctx + ((size_t)(l * 2 + ORD) * GW + c) * 2 * CTX : p.kt_lat + ((size_t)(l * 2 + ORD) * GW + c) * 2 * SEQ);
  bf16_t* KL = lds;
  bf16_t* UL = lds + HC_KLEN;
  const float* cw = p.hy_cw + (size_t)l * 3 * 3 * GW;
  const float* cb = p.hy_cb + (size_t)l * 3 * GW;
  __syncthreads();
  for (int n = -(L + 32) + tid; n < L + 32; n += 256) KL[HC_KOFF + n] = (n > -L && n < L) ? kt[L - n] : (bf16_t)0;
  if (!(FUSED && ORD == 1))
  for (int q = tid; q < SB * 4; q += 256) {
    int b = q >> 2, w = q & 3;
    bf16_t* dst = UL + b * HC_ULS + (w < 2 ? w * 16 : (NTB + w) * 16);
    for (int j = 0; j < 16; ++j) dst[j] = 0;
  }
  if (!(FUSED && ORD == 1)) {
    const float w0 = cw[0 * 3 * GW + c], w1 = cw[1 * 3 * GW + c], w2 = cw[2 * 3 * GW + c], bb = cb[c];
    for (int q = tid; q < SB * (L / 8); q += 256) {
      const int b = q / (L / 8), s8 = (q % (L / 8)) * 8;
      const int row = b * RPB + seg0 + s8;
      float u[8];
      if (ORD == 0) {
        float raw[10];
#pragma unroll
        for (int j = 0; j < 10; ++j) { int sp = s8 - 1 + j; raw[j] = (sp >= 0 && sp < L) ? PJ(row - 1 + j, OFF_HY + c) : 0.f; }
#pragma unroll
        for (int j = 0; j < 8; ++j) u[j] = w0 * raw[j] + w1 * raw[j + 1] + w2 * raw[j + 2] + bb;
      } else {
#pragma unroll
        for (int j = 0; j < 8; ++j) u[j] = p.Z2[(size_t)(row + j) * GW + c];
      }
      unsigned* dst = (unsigned*)(UL + b * HC_ULS + 32 + s8);
#pragma unroll
      for (int j = 0; j < 4; ++j) dst[j] = pack_bf16(u[2 * j], u[2 * j + 1]);
    }
  }
  __syncthreads();
  const int lane = tid & 63, wave = tid >> 6;
  const int ti = lane & 15, q4 = lane >> 4;
  const int NT = NTB / 2, TPW = NT / 4;
  const int T0 = wave * TPW * 2;
  f32x4 acc[16];
#pragma unroll
  for (int m = 0; m < 16; ++m) acc[m] = (f32x4){0.f, 0.f, 0.f, 0.f};
  const int nK = NTB / 2 + TPW;
  const int colb = (lane & 7) * HC_ULS + (q4 & 1) * 8;
  const int tbsel = (lane >> 3) & 1;
  for (int k = 0; k < nK; ++k) {
    const int dl = T0 - NTB + 2 * k + (q4 >> 1);
    const int nb = HC_KOFF - 16 * dl - ti + 8 * (q4 & 1);
    bf16x8 A;
#pragma unroll
    for (int j = 0; j < 8; ++j) A[j] = (short)KL[nb + j];
#pragma unroll
    for (int m = 0; m < 16; ++m) {
      if (m < TPW && k >= m && k <= m + NTB / 2) {
        const int sb = T0 + 2 * m + tbsel - dl;
        const bf16x8 B = *(const bf16x8*)(UL + colb + (sb + 2) * 16);
        acc[m] = mfma16(A, B, acc[m]);
      }
    }
  }
  if (FUSED && ORD == 0) __syncthreads();
  const int xc = (ORD == 0 ? GW : 2 * GW) + c;
  const float v0 = cw[0 * 3 * GW + xc], v1 = cw[1 * 3 * GW + xc], v2 = cw[2 * 3 * GW + xc], vb = cb[xc];
  const int bn = lane & 7;
#pragma unroll
  for (int m = 0; m < 16; ++m) {
    if (m < TPW) {
      const int t0 = 16 * (T0 + 2 * m + tbsel) + q4 * 4;
      const int row = bn * RPB + seg0 + t0;
      float raw[6];
#pragma unroll
      for (int j = 0; j < 6; ++j) { int tp = t0 - 1 + j; raw[j] = (tp >= 0 && tp < L) ? PJ(row - 1 + j, OFF_HY + xc) : 0.f; }
      float o4[4];
#pragma unroll
      for (int r = 0; r < 4; ++r) {
        float g = v0 * raw[r] + v1 * raw[r + 1] + v2 * raw[r + 2] + vb;
        o4[r] = g * acc[m][r];
        if (ORD == 1) p.HY[(size_t)(row + r) * GW + c] = o4[r];
        else if (!FUSED) p.Z2[(size_t)(row + r) * GW + c] = o4[r];
      }
      if (FUSED && ORD == 0) {
        unsigned* dst = (unsigned*)(UL + bn * HC_ULS + 32 + t0);
        dst[0] = pack_bf16(o4[0], o4[1]);
        dst[1] = pack_bf16(o4[2], o4[3]);
      }
    }
  }
}
__device__ __forceinline__ int hyena_mfma_items(int l) { return (l != DEPTH - 1 ? 2 : 1) * GW; }
#endif


__device__ __forceinline__ float rw_shift(const P& p, int l, int row, int pp, int j) {
  float x = PJ(row, OFF_RW + j);
  float xp = has_prev(pp) ? PJ(row - 1, OFF_RW + j) : 0.f;
  float xn = has_next(pp) ? PJ(row + 1, OFF_RW + j) : 0.f;
  return x + p.rw_mu[(size_t)(l * 2 + 0) * RWSH + j] * (xp - x) + p.rw_mu[(size_t)(l * 2 + 1) * RWSH + j] * (xn - x);
}
__device__ __forceinline__ void ph_prep(const P& p, int l, int s, int gtid, int gsize, float* lds, int tid) {
#pragma unroll 1
  for (int it = gtid; it < RS * (2 * GW / 4); it += gsize) {
    const int j = (it % (2 * GW / 4)) * 4, row = it / (2 * GW / 4), pp = row % RPB;
    const float* cw = p.ml_cw + (size_t)l * 3 * 2 * GW + j;
    const bf16_t* pr = p.PROJ + (size_t)row * LDP + OFF_ML + j;
    const f4 x0 = ldbf4(pr), xm = ldbf4(row > 0 ? pr - LDP : pr), xp = ldbf4(row < RS - 1 ? pr + LDP : pr);
    const float hp = has_prev(pp) ? 1.0f : 0.0f, hn = has_next(pp) ? 1.0f : 0.0f;
    f4 c0 = ld4(cw), c1 = ld4(cw + 2 * GW), c2 = ld4(cw + 4 * GW), cb = ld4(p.ml_cb + l * 2 * GW + j);
    c0.x *= hp; c0.y *= hp; c0.z *= hp; c0.w *= hp;
    c2.x *= hn; c2.y *= hn; c2.z *= hn; c2.w *= hn;
    const float sc = (j < GW) ? 0.125f : 1.0f;
    f4 o;
    o.x = siluf_(c0.x * xm.x + c1.x * x0.x + c2.x * xp.x + cb.x) * sc;
    o.y = siluf_(c0.y * xm.y + c1.y * x0.y + c2.y * xp.y + cb.y) * sc;
    o.z = siluf_(c0.z * xm.z + c1.z * x0.z + c2.z * xp.z + cb.z) * sc;
    o.w = siluf_(c0.w * xm.w + c1.w * x0.w + c2.w * xp.w + cb.w) * sc;
    st4(p.MQK + (size_t)row * 2 * GW + j, o);
  }
  for (int it = gtid; it < RS * 4 * NH; it += gsize) {
    int gj = it % (4 * NH), row = it / (4 * NH);
    float g = PJ(row, OFF_ML + 4 * GW + gj) + p.ml_gb[l * 4 * NH + gj];
    if ((gj / NH) & 1) g = logsigmoidf_(g);
    p.MG[(size_t)row * 4 * NH + gj] = g;
  }
#pragma unroll 1
  for (int it = gtid; it < RS * (2 * GW / 4); it += gsize) {
    const int j = (it % (2 * GW / 4)) * 4, row = it / (2 * GW / 4), pp = row % RPB;
    const int which = j / GW, c = j % GW, dd = c % HD, hb = c - dd;
    const bf16_t* pr = p.PROJ + (size_t)row * LDP + OFF_RT + which * GW;
    const f4 x = ldbf4(pr + c);
    f4 o;
    {
      const int t = pp >= CTX ? pp - CTX : 0, ri = t / GRIDW, ci = t % GRIDW;
      const int half = dd / 32, e = dd % 32, pi = e % 16;
      const bool first = e < 16;
      const int pos = pp >= CTX ? (half ? ci : ri) : 0;
      const f4 xo = ldbf4(pr + hb + (first ? dd + 16 : dd - 16));
      const f4 cs = ld4(p.ropec + pos * 16 + pi), sn = ld4(p.ropes + pos * 16 + pi);
      const float sg = first ? -1.0f : 1.0f;
      o.x = x.x * cs.x + sg * xo.x * sn.x;
      o.y = x.y * cs.y + sg * xo.y * sn.y;
      o.z = x.z * cs.z + sg * xo.z * sn.z;
      o.w = x.w * cs.w + sg * xo.w * sn.w;
    }
    if (which == 0) { o.x *= 0.125f; o.y *= 0.125f; o.z *= 0.125f; o.w *= 0.125f; }
    st4(p.RQK + (size_t)row * 2 * GW + j, o);
  }
  {
    float* zs = lds;
    float* part = lds + 8 * RWSH;
    const size_t AS = (size_t)RS * GW;
    for (int tile = blockIdx.x; tile < RS / 8; tile += gridDim.x) {
      const int row0 = tile * 8;
      __syncthreads();
      if (tid < RWSH / 4) {
        const int j4 = tid * 4;
        const f4 m0 = ld4(p.rw_mu + (size_t)(l * 2 + 0) * RWSH + j4), m1 = ld4(p.rw_mu + (size_t)(l * 2 + 1) * RWSH + j4);
        const int kind = (j4 >= 3 * GW && j4 < 3 * GW + 32) ? 1 : (j4 >= 3 * GW + 64 ? 2 : 0);
        const bf16_t* pr = p.PROJ + (size_t)row0 * LDP + OFF_RW + j4;
        f4 x[10];
#pragma unroll
        for (int r = 0; r < 10; ++r) {
          const int row = row0 - 1 + r;
          if (row >= 0 && row < RS) x[r] = ldbf4(pr + (ptrdiff_t)(r - 1) * LDP);
          else { x[r].x = 0.f; x[r].y = 0.f; x[r].z = 0.f; x[r].w = 0.f; }
        }
#pragma unroll
        for (int r = 0; r < 8; ++r) {
          const int pp = (row0 + r) % RPB;
          const float hp = has_prev(pp) ? 1.0f : 0.0f, hn = has_next(pp) ? 1.0f : 0.0f;
          const f4 c = x[r + 1];
          f4 z;
          z.x = c.x + m0.x * (hp * x[r].x - c.x) + m1.x * (hn * x[r + 2].x - c.x);
          z.y = c.y + m0.y * (hp * x[r].y - c.y) + m1.y * (hn * x[r + 2].y - c.y);
          z.z = c.z + m0.z * (hp * x[r].z - c.z) + m1.z * (hn * x[r + 2].z - c.z);
          z.w = c.w + m0.w * (hp * x[r].w - c.w) + m1.w * (hn * x[r + 2].w - c.w);
          if (kind == 1) { z.x = tanhf_(z.x); z.y = tanhf_(z.y); z.z = tanhf_(z.z); z.w = tanhf_(z.w); }
          else if (kind == 2) { z.x = sigmoidf_(z.x); z.y = sigmoidf_(z.y); z.z = sigmoidf_(z.z); z.w = sigmoidf_(z.w); }
          st4(zs + r * RWSH + j4, z);
        }
      }
      __syncthreads();
      {
        int pr = tid >> 3, sub = tid & 7;
        if (pr < 8 * NH) {
          int r = pr / NH, h = pr % NH;
          float ss = 0.f, bs = 0.f;
          for (int i = sub * 8; i < sub * 8 + 8; ++i) {
            float kv = zs[r * RWSH + GW + h * HD + i], rv = zs[r * RWSH + h * HD + i];
            float kk = kv * p.rw_kk[l * GW + h * HD + i];
            ss += kk * kk;
            bs += rv * kv * p.rw_rk[(l * NH + h) * HD + i];
          }
          part[pr * 8 + sub] = ss;
          part[256 + pr * 8 + sub] = bs;
        }
      }
      __syncthreads();
      for (int c = tid; c < GW; c += 256) {
        const int h = c / HD;
        float wa0[8], wa1[8], aa0[8], aa1[8], gg[8];
#pragma unroll
        for (int r = 0; r < 8; ++r) { wa0[r] = 0.f; wa1[r] = 0.f; aa0[r] = 0.f; aa1[r] = 0.f; gg[r] = 0.f; }
#pragma unroll 8
        for (int i = 0; i < 32; ++i) {
          float w20 = p.rw_w2[((size_t)(l * 2 + 0) * 32 + i) * GW + c], w21 = p.rw_w2[((size_t)(l * 2 + 1) * 32 + i) * GW + c];
          float a20 = p.rw_a2[((size_t)(l * 2 + 0) * 32 + i) * GW + c], a21 = p.rw_a2[((size_t)(l * 2 + 1) * 32 + i) * GW + c];
#pragma unroll
          for (int r = 0; r < 8; ++r) {
            float tw = zs[r * RWSH + 3 * GW + i], al = zs[r * RWSH + 3 * GW + 32 + i];
            wa0[r] = fmaf(tw, w20, wa0[r]); wa1[r] = fmaf(tw, w21, wa1[r]);
            aa0[r] = fmaf(al, a20, aa0[r]); aa1[r] = fmaf(al, a21, aa1[r]);
          }
        }
#pragma unroll 16
        for (int j = 0; j < 64; ++j) {
          float g2 = p.rw_g2[((size_t)l * 64 + j) * GW + c];
#pragma unroll
          for (int r = 0; r < 8; ++r) gg[r] = fmaf(zs[r * RWSH + 3 * GW + 64 + j], g2, gg[r]);
        }
        const float ka = p.rw_ka[l * GW + c], kks = p.rw_kk[l * GW + c];
        const float w00 = p.rw_w0[(l * 2 + 0) * GW + c], w01 = p.rw_w0[(l * 2 + 1) * GW + c];
        const float a00 = p.rw_a0[(l * 2 + 0) * GW + c], a01 = p.rw_a0[(l * 2 + 1) * GW + c];
#pragma unroll
        for (int r = 0; r < 8; ++r) {
          const int pr = r * NH + h;
          float ss = 0.f, bs = 0.f;
#pragma unroll
          for (int u = 0; u < 8; ++u) { ss += part[pr * 8 + u]; bs += part[256 + pr * 8 + u]; }
          const float rr = zs[r * RWSH + c], k = zs[r * RWSH + GW + c], v = zs[r * RWSH + 2 * GW + c];
          const float kkv = k * kks / sqrtf(ss + 1e-12f);
          const size_t o = (size_t)(row0 + r) * GW + c;
          p.RW[0 * AS + o] = rr;
          p.RW[1 * AS + o] = kkv;
          p.BON[o] = bs * v;
          p.GG[o] = gg[r];
#pragma unroll
          for (int d = 0; d < 2; ++d) {
            float wpre = (d ? w01 : w00) + (d ? wa1[r] : wa0[r]);
            float decay = expf(-expf(-softplusf_(-wpre) - 0.5f));
            float a = sigmoidf_((d ? a01 : a00) + (d ? aa1[r] : aa0[r]));
            p.RW[(2 + d) * AS + o] = decay;
            p.RW[(4 + d) * AS + o] = k * (1.0f + (a - 1.0f) * ka);
            p.RW[(6 + d) * AS + o] = kkv * a;
          }
        }
      }
    }
    __syncthreads();
  }
#if SB == 8
#else
  for (int it = gtid; it < hyena_items(l); it += gsize) hyena_conv_item<0>(p, l, it);
#endif
}

__device__ __forceinline__ int scan_pos(int dir, int step) {
  if (!dir) return step;
  return step < CTX ? CTX - 1 - step : RPB - 1 - (step - CTX);
}
#ifndef CPU_EMU
__device__ __forceinline__ float quad_sum(float v) {
  v += __int_as_float(__builtin_amdgcn_mov_dpp(__float_as_int(v), 0xB1, 0xF, 0xF, true));
  v += __int_as_float(__builtin_amdgcn_mov_dpp(__float_as_int(v), 0x4E, 0xF, 0xF, true));
  return v;
}
__device__ __forceinline__ float oct_sum(float v) {
  v = quad_sum(v);
  v += __int_as_float(__builtin_amdgcn_mov_dpp(__float_as_int(v), 0x141, 0xF, 0xF, true));
  return v;
}
#endif
#define SCT 16
#define NCHUNK (RPB / SCT)
__device__ __forceinline__ void bscan_rwkv(const P& p, int l, int bl, int h, int dir, int half, float* lds, int tid) {
  const int i = half * 32 + (tid >> 3), kq = tid & 7, st = tid >> 4, sp = tid & 15;
  float S[8];
#pragma unroll
  for (int d = 0; d < 8; ++d) S[d] = 0.f;
  float* H = dir ? p.HB : p.HF;
  const size_t AS = (size_t)RS * GW;
  const int vc = 2 * GW + h * HD + sp * 4;
  const f4 mu0 = ld4(p.rw_mu + (size_t)(l * 2 + 0) * RWSH + vc), mu1 = ld4(p.rw_mu + (size_t)(l * 2 + 1) * RWSH + vc);
  f4 rg[5], rv;
  auto load = [&](int c) {
    const int pp = scan_pos(dir, c * SCT + st), row = bl * RPB + pp;
    const size_t o = (size_t)row * GW + h * HD + sp * 4;
    rg[0] = ld4(p.RW + 0 * AS + o);
    rg[1] = ld4(p.RW + 1 * AS + o);
    rg[2] = ld4(p.RW + (size_t)(2 + dir) * AS + o);
    rg[3] = ld4(p.RW + (size_t)(4 + dir) * AS + o);
    rg[4] = ld4(p.RW + (size_t)(6 + dir) * AS + o);
    const bf16_t* pr = p.PROJ + (size_t)row * LDP + OFF_RW + vc;
    f4 x = ldbf4(pr), xm = x, xp = x;
    xm.x = xm.y = xm.z = xm.w = 0.f; xp = xm;
    if (has_prev(pp)) xm = ldbf4(pr - LDP);
    if (has_next(pp)) xp = ldbf4(pr + LDP);
    rv.x = x.x + mu0.x * (xm.x - x.x) + mu1.x * (xp.x - x.x);
    rv.y = x.y + mu0.y * (xm.y - x.y) + mu1.y * (xp.y - x.y);
    rv.z = x.z + mu0.z * (xm.z - x.z) + mu1.z * (xp.z - x.z);
    rv.w = x.w + mu0.w * (xm.w - x.w) + mu1.w * (xp.w - x.w);
  };
  load(0);
  for (int c = 0; c < NCHUNK; ++c) {
    __syncthreads();
#pragma unroll
    for (int a = 0; a < 5; ++a) st4(lds + (st * 6 + a) * 64 + sp * 4, rg[a]);
    st4(lds + (st * 6 + 5) * 64 + sp * 4, rv);
    __syncthreads();
    if (c + 1 < NCHUNK) load(c + 1);
    struct RwOps { float r[8], k[8], w[8], d[8], b[8], vv; };
    auto ldstep = [&](RwOps& o, int t) {
      const float* L = lds + t * 6 * 64 + kq * 8;
      o.vv = lds[(t * 6 + 5) * 64 + i];
      ld8(o.k, L + 1 * 64);
      ld8(o.w, L + 2 * 64);
      ld8(o.d, L + 3 * 64);
      ld8(o.b, L + 4 * 64);
      ld8(o.r, L + 0 * 64);
    };
    auto step = [&](const RwOps& o, int t) {
      float sa4[4] = {0.f, 0.f, 0.f, 0.f};
#pragma unroll
      for (int d = 0; d < 8; ++d) sa4[d & 3] = fmaf(S[d], o.k[d], sa4[d & 3]);
      const float sa = -oct_sum((sa4[0] + sa4[1]) + (sa4[2] + sa4[3]));
      float y4[4] = {0.f, 0.f, 0.f, 0.f};
#pragma unroll
      for (int d = 0; d < 8; ++d) {
        S[d] = fmaf(S[d], o.w[d], fmaf(sa, o.b[d], o.vv * o.d[d]));
        y4[d & 3] = fmaf(S[d], o.r[d], y4[d & 3]);
      }
      const float y = oct_sum((y4[0] + y4[1]) + (y4[2] + y4[3]));
      if (kq == 0) {
        const int row = bl * RPB + scan_pos(dir, c * SCT + t);
        H[(size_t)row * 3 * GW + 2 * GW + h * HD + i] = y;
      }
    };
    RwOps oa, ob;
    ldstep(oa, 0);
#pragma nounroll
    for (int t = 0; t < SCT; t += 2) {
      ldstep(ob, t + 1);
      step(oa, t);
      if (t + 2 < SCT) ldstep(oa, t + 2);
      step(ob, t + 1);
    }
  }
}
__device__ __forceinline__ void bscan_mlstm(const P& p, int bl, int h, int dir, int half, float* lds, int tid) {
  const int i = half * 32 + (tid >> 3), kq = tid & 7, st = tid >> 4, sp = tid & 15;
  float C[8], n[8];
#pragma unroll
  for (int d = 0; d < 8; ++d) { C[d] = 0.f; n[d] = 0.f; }
  float m = 0.f;
  float* H = dir ? p.HB : p.HF;
  f4 rq, rk, rv;
  float g0 = 0.f, g1 = 0.f;
  auto load = [&](int c) {
    const int pp = scan_pos(dir, c * SCT + st), row = bl * RPB + pp;
    const float* q = p.MQK + (size_t)row * 2 * GW + h * HD + sp * 4;
    rq = ld4(q);
    rk = ld4(q + GW);
    rv = ldbf4(p.PROJ + (size_t)row * LDP + OFF_ML + 2 * GW + h * HD + sp * 4);
    if (sp == 0) {
      const float* mg = p.MG + (size_t)row * 4 * NH;
      g0 = mg[(dir ? 2 : 0) * NH + h];
      g1 = mg[(dir ? 3 : 1) * NH + h];
    }
  };
  load(0);
  for (int c = 0; c < NCHUNK; ++c) {
    __syncthreads();
    st4(lds + (st * 4 + 0) * 64 + sp * 4, rq);
    st4(lds + (st * 4 + 1) * 64 + sp * 4, rk);
    st4(lds + (st * 4 + 2) * 64 + sp * 4, rv);
    if (sp == 0) { lds[(st * 4 + 3) * 64 + 0] = g0; lds[(st * 4 + 3) * 64 + 1] = g1; }
    __syncthreads();
    if (c + 1 < NCHUNK) load(c + 1);
    struct MlOps { float q[8], k[8], ig, lf, v; };
    auto ldstep = [&](MlOps& o, int t) {
      const float* L = lds + t * 4 * 64;
      o.ig = L[3 * 64 + 0]; o.lf = L[3 * 64 + 1]; o.v = L[2 * 64 + i];
      ld8(o.q, L + kq * 8);
      ld8(o.k, L + 64 + kq * 8);
    };
    auto step = [&](const MlOps& o, int t) {
      const float mn = fmaxf(o.lf + m, o.ig);
      const float f = fexp_(o.lf + m - mn), ii = fexp_(o.ig - mn), em = fexp_(-mn);
      m = mn;
      const float iv = ii * o.v;
      float num4[4] = {0.f, 0.f, 0.f, 0.f}, den4[4] = {0.f, 0.f, 0.f, 0.f};
#pragma unroll
      for (int d = 0; d < 8; ++d) {
        const float kd = o.k[d], qd = o.q[d];
        C[d] = fmaf(kd, iv, f * C[d]);
        n[d] = fmaf(kd, ii, f * n[d]);
        num4[d & 3] = fmaf(qd, C[d], num4[d & 3]);
        den4[d & 3] = fmaf(qd, n[d], den4[d & 3]);
      }
      const float num = oct_sum((num4[0] + num4[1]) + (num4[2] + num4[3]));
      const float den = oct_sum((den4[0] + den4[1]) + (den4[2] + den4[3]));
      if (kq == 0) {
        const int row = bl * RPB + scan_pos(dir, c * SCT + t);
        H[(size_t)row * 3 * GW + 0 * GW + h * HD + i] = num * frcp_(fmaxf(fabsf(den), em));
      }
    };
    MlOps oa, ob;
    ldstep(oa, 0);
#pragma nounroll
    for (int t = 0; t < SCT; t += 2) {
      ldstep(ob, t + 1);
      step(oa, t);
      if (t + 2 < SCT) ldstep(oa, t + 2);
      step(ob, t + 1);
    }
  }
}
__device__ __forceinline__ void bscan_ret(const P& p, int bl, int h, int dir, int half, float* lds, int tid) {
  const int i = half * 32 + (tid >> 3), kq = tid & 7, st = tid >> 4, sp = tid & 15;
  float S[8];
#pragma unroll
  for (int d = 0; d < 8; ++d) S[d] = 0.f;
  const int hh = dir ? NH - 1 - h : h;
  const float gamma = 1.0f - exp2f(-5.0f - (float)hh);
  float* H = dir ? p.HB : p.HF;
  f4 rq, rk, rv;
  auto load = [&](int c) {
    const int pp = scan_pos(dir, c * SCT + st), row = bl * RPB + pp;
    const float* q = p.RQK + (size_t)row * 2 * GW + h * HD + sp * 4;
    rq = ld4(q);
    rk = ld4(q + GW);
    rv = ldbf4(p.PROJ + (size_t)row * LDP + OFF_RT + 2 * GW + h * HD + sp * 4);
  };
  load(0);
  for (int c = 0; c < NCHUNK; ++c) {
    __syncthreads();
    st4(lds + (st * 4 + 0) * 64 + sp * 4, rq);
    st4(lds + (st * 4 + 1) * 64 + sp * 4, rk);
    st4(lds + (st * 4 + 2) * 64 + sp * 4, rv);
    __syncthreads();
    if (c + 1 < NCHUNK) load(c + 1);
    struct RtOps { float q[8], k[8], v; };
    auto ldstep = [&](RtOps& o, int t) {
      const float* L = lds + t * 4 * 64;
      o.v = L[2 * 64 + i];
      ld8(o.q, L + kq * 8);
      ld8(o.k, L + 64 + kq * 8);
    };
    auto step = [&](const RtOps& o, int t) {
      float o4[4] = {0.f, 0.f, 0.f, 0.f};
#pragma unroll
      for (int d = 0; d < 8; ++d) {
        S[d] = fmaf(S[d], gamma, o.k[d] * o.v);
        o4[d & 3] = fmaf(o.q[d], S[d], o4[d & 3]);
      }
      const float ov = oct_sum((o4[0] + o4[1]) + (o4[2] + o4[3]));
      if (kq == 0) {
        const int row = bl * RPB + scan_pos(dir, c * SCT + t);
        H[(size_t)row * 3 * GW + 1 * GW + h * HD + i] = ov;
      }
    };
    RtOps oa, ob;
    ldstep(oa, 0);
#pragma nounroll
    for (int t = 0; t < SCT; t += 2) {
      ldstep(ob, t + 1);
      step(oa, t);
      if (t + 2 < SCT) ldstep(oa, t + 2);
      step(ob, t + 1);
    }
  }
}
#define NSCAN (3 * SB * NH * 2 * 2)
__device__ __forceinline__ void ph_scan(const P& p, int l, int s, int gtid, int gsize, float* lds, int tid) {
  for (int w = blockIdx.x; w < NSCAN; w += gridDim.x) {
    int mixer = w / (SB * NH * 4), r = w % (SB * NH * 4);
    int half = r & 1, dir = (r >> 1) & 1, h = (r >> 2) % NH, bl = (r >> 2) / NH;
    if (mixer == 0) bscan_rwkv(p, l, bl, h, dir, half, lds, tid);
    else if (mixer == 1) bscan_mlstm(p, bl, h, dir, half, lds, tid);
    else bscan_ret(p, bl, h, dir, half, lds, tid);
    __syncthreads();
  }
#if SB == 8
  {
    int* sh = (int*)lds;
    const int nitem = hyena_mfma_items(l);
    for (;;) {
      __syncthreads();
      if (tid == 0) sh[0] = atomicAdd(p.ctr, 1);
      __syncthreads();
      const int it = sh[0];
      if (it >= nitem) break;
      hyena_mfma_item<0, true>(p, l, it, (bf16_t*)lds, tid);
      hyena_mfma_item<1, true>(p, l, it, (bf16_t*)lds, tid);
    }
  }
#else
  for (int it = gtid; it < hyena_items(l); it += gsize) hyena_conv_item<1>(p, l, it);
#endif
}

#define NE (HD / WL)
__device__ __forceinline__ void ph_fin(const P& p, int l, int s, int gtid, int gsize) {
  const bool last = (l == DEPTH - 1);
  const int lane = gtid % WL, gw = gtid / WL, nw = gsize / WL;
  for (int item = gw; item < (RS / 4) * 4 * NH; item += nw) {
    const int hg = item % (4 * NH), row0 = (item / (4 * NH)) * 4, pp0 = row0 % RPB;
    if (last && pp0 < CTX) continue;
    const int g = hg / NH, h = hg % NH;
    const int c0 = g * GW + h * HD;
    float val[4][NE];
#pragma unroll
    for (int r = 0; r < 4; ++r) {
      const int row = row0 + r;
#pragma unroll
      for (int e = 0; e < NE; ++e) {
        const int i = e * WL + lane;
        float v;
        if (g == 1) v = p.HY[(size_t)row * GW + h * HD + i];
        else {
          const int slot = (g == 0) ? 0 : (g == 2 ? 1 : 2);
          const size_t o = (size_t)row * 3 * GW + slot * GW + h * HD + i;
          v = p.HF[o] + p.HB[o];
        }
        val[r][e] = v;
      }
    }
    float mu[4], rs[4];
#pragma unroll
    for (int r = 0; r < 4; ++r) {
      float sm = 0.f;
#pragma unroll
      for (int e = 0; e < NE; ++e) sm += val[r][e];
      mu[r] = wave_sum(sm) * (1.0f / HD);
    }
#pragma unroll
    for (int r = 0; r < 4; ++r) {
      float q = 0.f;
#pragma unroll
      for (int e = 0; e < NE; ++e) { float d = val[r][e] - mu[r]; q += d * d; }
      rs[r] = 1.0f / sqrtf(wave_sum(q) * (1.0f / HD) + 1e-5f);
    }
#pragma unroll
    for (int r = 0; r < 4; ++r) {
      const int row = row0 + r;
#pragma unroll
      for (int e = 0; e < NE; ++e) {
        const int i = e * WL + lane;
        float v = (val[r][e] - mu[r]) * rs[r] * p.ng[l * DM + c0 + i] + p.nb[l * DM + c0 + i];
        if (g == 0) v *= sigmoidf_(PJ(row, OFF_ML + 3 * GW + h * HD + i));
        else if (g == 2) v *= siluf_(PJ(row, OFF_RT + 3 * GW + h * HD + i));
        else if (g == 3) v = p.GG[(size_t)row * GW + h * HD + i] * (v + p.BON[(size_t)row * GW + h * HD + i]);
        p.U[(size_t)row * DM + c0 + i] = f2bf(v);
      }
    }
  }
}

__device__ __forceinline__ void ph_act(const P& p, int l, int s, int gtid, int gsize) {
  const bool last = (l == DEPTH - 1);
  const float* cw = p.f_cw + (size_t)l * 3 * DFF;
  const float* cb = p.f_cb + (size_t)l * DFF;
#pragma unroll 2
  for (int it = gtid; it < RS * (DFF / 8); it += gsize) {
    const int j = (it % (DFF / 8)) * 8, row = it / (DFF / 8), pp = row % RPB;
    if (last && pp < CTX) continue;
    const bf16_t* hr = p.HFF + (size_t)row * 2 * DFF;
    const bf16_t* hm = row > 0 ? hr - 2 * DFF : hr;
    const bf16_t* hp = row < RS - 1 ? hr + 2 * DFF : hr;
    const unsigned mprev = has_prev(pp) ? 0xffffffffu : 0u, mnext = has_next(pp) ? 0xffffffffu : 0u;
    const u4 qa = ldu4(hr + j), qb = ldu4(hr + DFF + j), qm = ldu4(hm + j), qp = ldu4(hp + j);
    const unsigned a0[4] = {qa.x, qa.y, qa.z, qa.w}, bv[4] = {qb.x, qb.y, qb.z, qb.w};
    const unsigned am[4] = {qm.x & mprev, qm.y & mprev, qm.z & mprev, qm.w & mprev}, ap[4] = {qp.x & mnext, qp.y & mnext, qp.z & mnext, qp.w & mnext};
    float w0[8], w1[8], w2[8], wb[8];
    ld8(w0, cw + j); ld8(w1, cw + DFF + j); ld8(w2, cw + 2 * DFF + j); ld8(wb, cb + j);
    unsigned ov[4];
#pragma unroll
    for (int e = 0; e < 4; ++e) {
      float o[2];
#pragma unroll
      for (int hh = 0; hh < 2; ++hh) {
        const int jj = 2 * e + hh;
        float xm = bf2f((bf16_t)(am[e] >> (16 * hh))), x0 = bf2f((bf16_t)(a0[e] >> (16 * hh))), xp = bf2f((bf16_t)(ap[e] >> (16 * hh)));
        float v = w0[jj] * xm + w1[jj] * x0 + w2[jj] * xp + wb[jj];
        o[hh] = siluf_(v) * bf2f((bf16_t)(bv[e] >> (16 * hh)));
      }
      ov[e] = pack_bf16(o[0], o[1]);
    }
    u4 qo; qo.x = ov[0]; qo.y = ov[1]; qo.z = ov[2]; qo.w = ov[3];
    stu4(p.ACT + (size_t)row * DFF + j, qo);
  }
}

enum { PH_PRO_A = 0, PH_PRO_B, PH_PRO_C, PH_LN0, PH_GEMM_IN, PH_PREP, PH_SCAN, PH_FIN, PH_GEMM_OUT, PH_LN1, PH_GEMM_UP, PH_ACT, PH_GEMM_DN, PH_LN2, PH_COUNT };

__device__ __forceinline__ void run_phase(const P& p, int ph, int l, int s, bf16_t* lds) {
  int tid = threadIdx.x;
#ifndef CPU_EMU
  asm volatile("" : "+v"(tid));
#endif
  const int gtid = blockIdx.x * blockDim.x + tid;
  const int gsize = gridDim.x * blockDim.x;
  const bool last = (l == DEPTH - 1);
  switch (ph) {
    case PH_PRO_A: ph_pro_a(p, gtid, gsize); break;
    case PH_PRO_B: ph_pro_b(p, gtid, gsize); break;
    case PH_PRO_C: ph_pro_c(p, gtid, gsize); break;
    case PH_LN0: ph_ln0(p, l, s, gtid, gsize); break;
    case PH_GEMM_IN: gemm_phase<true>(p.U, p.wt_in + (size_t)l * LDP * DM, p.PROJ, RS, LDP, DM, LDP, false, lds, tid); break;
    case PH_PREP: ph_prep(p, l, s, gtid, gsize, (float*)lds, tid); break;
    case PH_SCAN: ph_scan(p, l, s, gtid, gsize, (float*)lds, tid); break;
    case PH_FIN: ph_fin(p, l, s, gtid, gsize); break;
    case PH_GEMM_OUT: gemm_phase<false>(p.U, p.wt_out + (size_t)l * DM * DM, p.OUTF, RS, DM, DM, DM, last, lds, tid); break;
    case PH_LN1: ph_ln1(p, l, s, gtid, gsize); break;
    case PH_GEMM_UP: gemm_phase<true>(p.U, p.wt_up + (size_t)l * 2 * DFF * DM, p.HFF, RS, 2 * DFF, DM, 2 * DFF, last, lds, tid); break;
    case PH_ACT: ph_act(p, l, s, gtid, gsize); break;
    case PH_GEMM_DN: gemm_phase<false>(p.ACT, p.wt_dn + (size_t)l * DM * DFF, p.OUTF, RS, DM, DFF, DM, last, lds, tid); break;
    case PH_LN2: ph_ln2(p, l, s, gtid, gsize); break;
  }
}

#ifndef CPU_EMU
#define XB_TMO      128
#define XB_XCNT(j)  (256  + 64 * (j))
#define XB_XSUB(j)  (1280 + 64 * (j))
#define XB_XGEN(j)  (2304 + 64 * (j))
#define XB_TOP      3328
#define XB_TOPGEN   3392
#define XCD_BAR_WORDS 3456
#define XB_SPIN_CAP (1u << 22)
#define LAS __attribute__((address_space(3)))

__device__ __forceinline__ unsigned xb_ld(unsigned* p)              { return __hip_atomic_load(p, __ATOMIC_RELAXED, __HIP_MEMORY_SCOPE_AGENT); }
__device__ __forceinline__ unsigned xb_add(unsigned* p, unsigned v) { return __hip_atomic_fetch_add(p, v, __ATOMIC_RELAXED, __HIP_MEMORY_SCOPE_AGENT); }
__device__ __forceinline__ unsigned xb_xcc_id() { return (unsigned)__builtin_amdgcn_s_getreg((3 << 11) | 20) & 0xFu; }
#define XB_SPIN(cond, bar) do { unsigned _sp = 0; while (cond) { __builtin_amdgcn_s_sleep(1); \
    if ((++_sp & 255u) == 0u) { if (xb_ld(&(bar)[XB_TMO])) break; if (_sp > XB_SPIN_CAP) { atomicAdd(&(bar)[XB_TMO], 1u); break; } } } } while (0)

struct XcdBarrier {
    unsigned* bar; unsigned x;
    volatile LAS unsigned* st;
};

__device__ __forceinline__ XcdBarrier xcd_barrier_post(unsigned* bar, volatile LAS unsigned* st) {
    XcdBarrier b; b.bar = bar; b.x = xb_xcc_id(); b.st = st;
    if (threadIdx.x == 0) (void)xb_add(&bar[XB_XCNT(b.x)], 1u);
    return b;
}
__device__ __forceinline__ void xcd_barrier_complete(unsigned* bar, unsigned x, unsigned& nloc, unsigned& nx) {
    const unsigned G = gridDim.x * gridDim.y * gridDim.z;
    unsigned sum, cnt, mine, sp = 0u;
    for (;;) {
        sum = 0u; cnt = 0u; mine = 0u;
#pragma unroll
        for (unsigned j = 0; j < 16; ++j) { const unsigned c = xb_ld(&bar[XB_XCNT(j)]); sum += c; cnt += (c > 0u) ? 1u : 0u; mine = (j == x) ? c : mine; }
        if (sum == G) break;
        __builtin_amdgcn_s_sleep(1);
        if ((++sp & 255u) == 0u) { if (xb_ld(&bar[XB_TMO])) break; if (sp > XB_SPIN_CAP) { atomicAdd(&bar[XB_TMO], 1u); break; } }
    }
    nloc = mine > 0u ? mine : 1u; nx = cnt > 0u ? cnt : 1u;
}

__device__ __forceinline__ void xcd_barrier(const XcdBarrier& b) {
    asm volatile("s_waitcnt vmcnt(0)" ::: "memory");
    __syncthreads();
    if (threadIdx.x == 0) {
        unsigned* bar = b.bar;
        __builtin_amdgcn_s_waitcnt(0);
        unsigned nloc = b.st[0], nx = b.st[1];
        if (nloc == 0u) { xcd_barrier_complete(bar, b.x, nloc, nx); b.st[0] = nloc; b.st[1] = nx; }
        const unsigned old = xb_add(&bar[XB_XSUB(b.x)], 1u);
        const unsigned gen = old / nloc;
        if (old + 1u == (gen + 1u) * nloc) {
            __builtin_amdgcn_fence(__ATOMIC_RELEASE, "agent");
            asm volatile("s_waitcnt vmcnt(0)" ::: "memory");
            const unsigned og = xb_add(&bar[XB_TOP], 1u);
            const unsigned tg = og / nx;
            if (og + 1u == (tg + 1u) * nx) xb_add(&bar[XB_TOPGEN], 1u);
            else XB_SPIN(xb_ld(&bar[XB_TOPGEN]) == tg, bar);
            __builtin_amdgcn_fence(__ATOMIC_ACQUIRE, "agent");
            xb_add(&bar[XB_XGEN(b.x)], 1u);
            asm volatile("s_waitcnt vmcnt(0)" ::: "memory");
        } else {
            XB_SPIN(xb_ld(&bar[XB_XGEN(b.x)]) == gen, bar);
            __builtin_amdgcn_fence(__ATOMIC_ACQUIRE, "agent");
            asm volatile("s_waitcnt vmcnt(0)" ::: "memory");
        }
    }
    __syncthreads();
}

#endif

#ifndef PROBE_MASK
#define PROBE_MASK 0
#endif
#if PROBE_MASK
#define RUNPH(ph) do { int reps_ = 1 + ((PROBE_MASK >> ph) & 1); asm volatile("" : "+s"(reps_)); for (int q_ = 0; q_ < reps_; ++q_) { run_phase(p, ph, l, s, lds); GSYNC(); } } while (0)
#else
#define RUNPH(ph) do { run_phase(p, ph, l, s, lds); GSYNC(); } while (0)
#endif
#ifndef CPU_EMU
__global__ void __launch_bounds__(256, 2) k_mega(P p) {
  __shared__ __attribute__((aligned(16))) bf16_t lds[24576];
  __shared__ uint4 xb_words;
  cg::grid_group grid = cg::this_grid();
  if (threadIdx.x == 0) xb_words = make_uint4(0u, 0u, 0u, 0u);
  __syncthreads();
  XcdBarrier xb = xcd_barrier_post(p.bar, (volatile LAS unsigned*)&xb_words);
#define GSYNC() xcd_barrier(xb)
  run_phase(p, PH_PRO_A, 0, 0, lds);
  grid.sync();
  run_phase(p, PH_PRO_B, 0, 0, lds);
  GSYNC();
  run_phase(p, PH_PRO_C, 0, 0, lds);
  GSYNC();
  for (int l = 0; l < DEPTH; ++l)
    for (int s = 0; s < NSLICE; ++s)
    {
      if (l == 0 && s == 0) RUNPH(PH_LN0);
      RUNPH(PH_GEMM_IN);
      RUNPH(PH_PREP);
      RUNPH(PH_SCAN);
      RUNPH(PH_FIN);
      RUNPH(PH_GEMM_OUT);
      RUNPH(PH_LN1);
      RUNPH(PH_GEMM_UP);
      RUNPH(PH_ACT);
      RUNPH(PH_GEMM_DN);
      {
        run_phase(p, PH_LN2, l, s, lds);
        const int ns = (s + 1 == NSLICE) ? 0 : s + 1, nl = (s + 1 == NSLICE) ? l + 1 : l;
        if (nl < DEPTH) { run_phase(p, PH_LN0, nl, ns, lds); GSYNC(); }
      }
    }
}
#endif

static size_t ws_take(size_t& off, size_t bytes) { size_t o = off; off += (bytes + 255) & ~(size_t)255; return o; }

static void build_params(P& p, void* const* d_in, void* d_out, void* d_ws) {
  const float** f = (const float**)&p;
  for (int i = 0; i < 39; ++i) f[i] = (const float*)d_in[i];
  p.out = (float*)d_out;
  char* w = (char*)d_ws;
  size_t off = 0;
  p.wt_in = (bf16_t*)(w + ws_take(off, (size_t)DEPTH * LDP * DM * 2));
  p.wt_out = (bf16_t*)(w + ws_take(off, (size_t)DEPTH * DM * DM * 2));
  p.wt_up = (bf16_t*)(w + ws_take(off, (size_t)DEPTH * 2 * DFF * DM * 2));
  p.wt_dn = (bf16_t*)(w + ws_take(off, (size_t)DEPTH * DM * DFF * 2));
  p.kf_lat = (float*)(w + ws_take(off, (size_t)DEPTH * 2 * 2 * SEQ * GW * 4));
  p.kf_ctx = (float*)(w + ws_take(off, (size_t)DEPTH * 2 * 2 * CTX * GW * 4));
  p.kt_lat = (bf16_t*)(w + ws_take(off, (size_t)DEPTH * 2 * 2 * SEQ * GW * 2));
  p.kt_ctx = (bf16_t*)(w + ws_take(off, (size_t)DEPTH * 2 * 2 * CTX * GW * 2));
  p.ropec = (float*)(w + ws_take(off, 64 * 16 * 4));
  p.ropes = (float*)(w + ws_take(off, 64 * 16 * 4));
  p.hyh1 = (float*)(w + ws_take(off, (size_t)DEPTH * 2 * SEQ * 64 * 4));
  p.hyh2 = (float*)(w + ws_take(off, (size_t)DEPTH * 2 * SEQ * 64 * 4));
  p.scv = (float*)(w + ws_take(off, (size_t)NMOD * DM * 4));
  p.modtab = (float*)(w + ws_take(off, (size_t)DEPTH * NMOD * 6 * DM * 4));
  p.xc = (float*)(w + ws_take(off, (size_t)NB * CTX * DM * 4));
  p.ctr = (int*)(w + ws_take(off, 256));
  p.bar = (unsigned*)(w + ws_take(off, 16384));
  p.U = (bf16_t*)(w + ws_take(off, (size_t)RS * DM * 2));
  size_t arena = off;
  p.PROJ = (bf16_t*)(w + ws_take(off, (size_t)RS * LDP * 2));
  p.MQK = (float*)(w + ws_take(off, (size_t)RS * 2 * GW * 4));
  p.MG = (float*)(w + ws_take(off, (size_t)RS * 4 * NH * 4));
  p.RQK = (float*)(w + ws_take(off, (size_t)RS * 2 * GW * 4));
  p.RW = (float*)(w + ws_take(off, (size_t)8 * RS * GW * 4));
  p.HF = (float*)(w + ws_take(off, (size_t)RS * 3 * GW * 4));
  p.HB = (float*)(w + ws_take(off, (size_t)RS * 3 * GW * 4));
  p.Z2 = (float*)(w + ws_take(off, (size_t)RS * GW * 4));
  p.HY = (float*)(w + ws_take(off, (size_t)RS * GW * 4));
  p.BON = (float*)(w + ws_take(off, (size_t)RS * GW * 4));
  p.GG = (float*)(w + ws_take(off, (size_t)RS * GW * 4));
  size_t off2 = arena;
  p.OUTF = (float*)(w + ws_take(off2, (size_t)RS * DM * 4));
  p.HFF = (bf16_t*)(w + ws_take(off2, (size_t)RS * 2 * DFF * 2));
  p.ACT = (bf16_t*)(w + ws_take(off2, (size_t)RS * DFF * 2));
}

#ifndef CPU_EMU
extern "C" void kernel_launch(void* const* d_in, const int* in_sizes, int n_in, void* d_out, int out_size, void* d_ws, size_t ws_size,
                              hipStream_t stream) {
  static int grid_blocks = 0;
  if (!grid_blocks) {
    int dev = 0, cus = 0, per_cu = 0;
    hipGetDevice(&dev);
    hipDeviceGetAttribute(&cus, hipDeviceAttributeMultiprocessorCount, dev);
    hipOccupancyMaxActiveBlocksPerMultiprocessor(&per_cu, k_mega, 256, 0);
    if (per_cu < 1) per_cu = 1;
    grid_blocks = cus * per_cu;
  }
  P p;
  memset(&p, 0, sizeof(p));
  build_params(p, d_in, d_out, d_ws);
  hipMemsetAsync(p.bar, 0, XCD_BAR_WORDS * sizeof(unsigned), stream);
  void* args[] = {&p};
  hipError_t e = hipLaunchCooperativeKernel((void*)k_mega, dim3(grid_blocks), dim3(256), args, 0, stream);
  if (e != hipSuccess) fprintf(stderr, "cooperative launch failed: %s (grid %d)\n", hipGetErrorString(e), grid_blocks);
}
#endif
```
